# Optimizing an MI355X kernel written in HIP

```python
import jax
import jax.numpy as jnp
from jax import lax
import numpy as np

D_MODEL = 2048
BATCH = 1
SEQ = 16384
DEPTH = 1

CTX_LEN = 256
GRID_W = 64
CHUNK = 128
CHUNK_ROWS = CHUNK // GRID_W
A_WIDTH = D_MODEL // 2
A_GROUPS = 8
A_GDIM = A_WIDTH // A_GROUPS
B_WIDTH = D_MODEL // 2
B_HEADS = 8
B_HDIM = B_WIDTH // B_HEADS
CONV_K = 3
N_GROUPS = 4
EXP_PER_GROUP = 8
N_EXPERTS = N_GROUPS * EXP_PER_GROUP
TOP_K = 2
D_EXPERT = D_MODEL // 2
MOE_BLOCK = 128
ALPHA = (2 * DEPTH) ** 0.25
BETA = (8 * DEPTH) ** -0.25
LN_EPS = 1e-5
NEG = -1e30
OFF_VA = A_WIDTH
OFF_XM = 2 * A_WIDTH
OFF_VB = OFF_XM + B_WIDTH
OFF_OB = OFF_VB + B_WIDTH
OFF_GA = OFF_OB + B_WIDTH
OFF_GB = OFF_GA + D_MODEL
OFF_GATES = OFF_GB + D_MODEL
D_IN = OFF_GATES + 4 * B_HEADS
SPLITS = (OFF_VA, OFF_XM, OFF_VB, OFF_OB, OFF_GA, OFF_GB, OFF_GATES)

kernel_name = 'hybrid_gmlp_mlstm_hmoe_dit'


def layer_norm(x, g=None, b=None):
    xf = x.astype(jnp.float32)
    mu = xf.mean(-1, keepdims=True)
    var = jnp.square(xf - mu).mean(-1, keepdims=True)
    y = (xf - mu) * lax.rsqrt(var + LN_EPS)
    if g is not None:
        y = y * g.astype(jnp.float32) + b.astype(jnp.float32)
    return y.astype(x.dtype)


def modulate(x, shift, scale):
    return layer_norm(x) * (1 + scale[:, None]) + shift[:, None]


def chunk_mlp(u, v, n_chunks, w_s, b_s, g, b):
    bsz, t, _ = v.shape
    vn = layer_norm(v, g, b).reshape(bsz, n_chunks, CHUNK, A_GROUPS, A_GDIM)
    mixed = jnp.einsum('gqp,bnpgc->bnqgc', w_s, vn) + b_s.T[None, None, :, :, None]
    return u * mixed.reshape(bsz, t, A_WIDTH)


def short_conv(x, w, b):
    y = lax.conv_general_dilated(x, w[:, None, :], window_strides=(1,),
                                 padding=((CONV_K // 2, CONV_K // 2),),
                                 dimension_numbers=('NWC', 'WIO', 'NWC'),
                                 feature_group_count=x.shape[-1])
    return y + b


def mlstm_qkv(xm, vb, gates, conv_w, conv_b, w_q, w_k):
    bsz, t, _ = xm.shape
    xc = jax.nn.silu(short_conv(xm, conv_w, conv_b))
    xh = xc.reshape(bsz, t, B_HEADS, B_HDIM)
    q = jnp.einsum('bthd,hde->bhte', xh, w_q).astype(jnp.float32)
    k = jnp.einsum('bthd,hde->bhte', xh, w_k).astype(jnp.float32) * (B_HDIM ** -0.5)
    v = vb.reshape(bsz, t, B_HEADS, B_HDIM).transpose(0, 2, 1, 3).astype(jnp.float32)
    g = gates.astype(jnp.float32).reshape(bsz, t, 4, B_HEADS).transpose(2, 0, 3, 1)
    fwd = (g[0], jax.nn.log_sigmoid(g[1]))
    bwd = (g[2], jax.nn.log_sigmoid(g[3]))
    return xc, q, k, v, fwd, bwd


def rev(*ts):
    return tuple(jnp.flip(t, axis=2) for t in ts)


def zero_state(bsz):
    return (jnp.zeros((bsz, B_HEADS, B_HDIM, B_HDIM), jnp.float32),
            jnp.zeros((bsz, B_HEADS, B_HDIM), jnp.float32),
            jnp.full((bsz, B_HEADS), NEG, jnp.float32))


def final_state(k, v, li, lf):
    f_cum = jnp.cumsum(lf, axis=-1)
    logw = f_cum[..., -1:] - f_cum + li
    m = logw.max(-1)
    w = jnp.exp(logw - m[..., None])
    c_mat = jnp.einsum('bhtd,bhte->bhde', k * w[..., None], v)
    n_vec = jnp.einsum('bht,bhtd->bhd', w, k)
    return (c_mat, n_vec, m)


def mlstm_chunkwise(q, k, v, li, lf, state):
    bsz, nh, t, dk = q.shape
    dv = v.shape[-1]
    nc = t // CHUNK
    causal = jnp.tril(jnp.ones((CHUNK, CHUNK), bool))

    def to_chunks(a):
        return jnp.moveaxis(a.reshape(bsz, nh, nc, CHUNK, *a.shape[3:]), 2, 0)

    def step(carry, inp):
        c_mat, n_vec, m = carry
        qc, kc, vc, lic, lfc = inp
        b = jnp.cumsum(lfc, axis=-1)
        d = jnp.where(causal, b[..., :, None] - b[..., None, :] + lic[..., None, :], NEG)
        inter = b + m[..., None]
        m_row = jnp.maximum(inter, d.max(-1))
        s = jnp.einsum('bhqd,bhkd->bhqk', qc, kc) * jnp.exp(d - m_row[..., None])
        a = jnp.exp(inter - m_row)
        num = a[..., None] * jnp.einsum('bhqd,bhde->bhqe', qc, c_mat) + jnp.einsum('bhqk,bhke->bhqe', s, vc)
        den = a * jnp.einsum('bhqd,bhd->bhq', qc, n_vec) + s.sum(-1)
        h = num / jnp.maximum(jnp.abs(den), jnp.exp(-m_row))[..., None]
        b_last = b[..., -1]
        logw = b_last[..., None] - b + lic
        m_new = jnp.maximum(b_last + m, logw.max(-1))
        wk = jnp.exp(logw - m_new[..., None])
        decay = jnp.exp(b_last + m - m_new)
        c_mat = decay[..., None, None] * c_mat + jnp.einsum('bhsd,bhse->bhde', kc * wk[..., None], vc)
        n_vec = decay[..., None] * n_vec + jnp.einsum('bhs,bhsd->bhd', wk, kc)
        return (c_mat, n_vec, m_new), h

    state, h = lax.scan(step, state, tuple(to_chunks(a) for a in (q, k, v, li, lf)))
    h = jnp.moveaxis(h, 0, 2).reshape(bsz, nh, t, dv)
    return h, state


def mlstm_out(h, xc, o_pre, mh_g, skip):
    bsz, nh, t, dv = h.shape
    mu = h.mean(-1, keepdims=True)
    var = jnp.square(h - mu).mean(-1, keepdims=True)
    hn = ((h - mu) * lax.rsqrt(var + LN_EPS)).transpose(0, 2, 1, 3).reshape(bsz, t, nh * dv).astype(xc.dtype)
    return jax.nn.sigmoid(o_pre) * (hn * mh_g + skip * xc)


def merge(a_pre, yb_pre, ga, gb, p_a, p_b, w_o):
    return (jax.nn.sigmoid(ga) * (a_pre @ p_a) + jax.nn.sigmoid(gb) * (yb_pre @ p_b)) @ w_o


def token_mixer(u, uc, n_lat_chunks, need_ctx, w_in, b_in, w_s, b_s, sgu_g, sgu_b,
                conv_w, conv_b, w_q, w_k, mh_g, skip, p_a, p_b, w_o):
    ua, va, xm, vb, ob, ga, gb, gates = jnp.split(u @ w_in + b_in, SPLITS, axis=-1)
    uac, vac, xmc, vbc, obc, gac, gbc, gatesc = jnp.split(uc @ w_in + b_in, SPLITS, axis=-1)
    xc, q, k, v, fw, bw = mlstm_qkv(xm, vb, gates, conv_w, conv_b, w_q, w_k)
    xcc, qc, kc, vc, fwc, bwc = mlstm_qkv(xmc, vbc, gatesc, conv_w, conv_b, w_q, w_k)
    yc = None
    if need_ctx:
        zero = zero_state(uc.shape[0])
        hcf, st_f = mlstm_chunkwise(qc, kc, vc, *fwc, zero)
        hcb, st_b = mlstm_chunkwise(*rev(qc, kc, vc, *bwc), zero)
        ac = chunk_mlp(jax.nn.gelu(uac), jax.nn.gelu(vac), uc.shape[1] // CHUNK, w_s, b_s, sgu_g, sgu_b)
        yc = merge(ac, mlstm_out(hcf + jnp.flip(hcb, 2), xcc, obc, mh_g, skip), gac, gbc, p_a, p_b, w_o)
    else:
        st_f = final_state(kc, vc, *fwc)
        st_b = final_state(*rev(kc, vc, *bwc))
    hf, _ = mlstm_chunkwise(q, k, v, *fw, st_f)
    hb, _ = mlstm_chunkwise(*rev(q, k, v, *bw), st_b)
    a = chunk_mlp(jax.nn.gelu(ua), jax.nn.gelu(va), n_lat_chunks, w_s, b_s, sgu_g, sgu_b)
    y = merge(a, mlstm_out(hf + jnp.flip(hb, 2), xc, ob, mh_g, skip), ga, gb, p_a, p_b, w_o)
    return y, yc


def moe(t, w_rg, b_rg, w_re, b_re, w1, w3, w2):
    n_tok, d = t.shape
    tok_ids = jnp.arange(n_tok)
    gl = (t @ w_rg + b_rg).astype(jnp.float32)
    g_sel = jnp.argmax(gl, axis=-1)
    p_g = jax.nn.softmax(gl, axis=-1)[tok_ids, g_sel]
    el = (t @ w_re + b_re).astype(jnp.float32).reshape(n_tok, N_GROUPS, EXP_PER_GROUP)
    ep = jax.nn.softmax(el[tok_ids, g_sel], axis=-1)
    top_p, top_i = lax.top_k(ep, TOP_K)
    weights = (p_g[:, None] * top_p / top_p.sum(-1, keepdims=True)).reshape(-1)
    expert = (g_sel[:, None] * EXP_PER_GROUP + top_i).reshape(-1)
    tok = jnp.repeat(tok_ids, TOP_K)
    n_asg = n_tok * TOP_K
    order = jnp.argsort(expert)
    e_sorted = expert[order]
    counts = jnp.bincount(expert, length=N_EXPERTS)
    padded = (counts + MOE_BLOCK - 1) // MOE_BLOCK * MOE_BLOCK
    pad_end = jnp.cumsum(padded)
    pad_start = pad_end - padded
    start = jnp.cumsum(counts) - counts
    dest = pad_start[e_sorted] + jnp.arange(n_asg) - start[e_sorted]
    n_blocks = -(-n_asg // MOE_BLOCK) + N_EXPERTS
    rows = n_blocks * MOE_BLOCK
    buf_tok = jnp.full((rows,), n_tok, jnp.int32).at[dest].set(tok[order].astype(jnp.int32))
    buf_w = jnp.zeros((rows,), jnp.float32).at[dest].set(weights[order])
    block_e = jnp.minimum(jnp.searchsorted(pad_end, jnp.arange(n_blocks) * MOE_BLOCK, side='right'), N_EXPERTS - 1)
    xs = jnp.concatenate([t, jnp.zeros((1, d), t.dtype)], axis=0)[buf_tok].reshape(n_blocks, MOE_BLOCK, d)

    def expert_block(args):
        xb, e = args
        return (jax.nn.silu(xb @ w1[e]) * (xb @ w3[e])) @ w2[e]

    ys = lax.map(expert_block, (xs, block_e)).reshape(rows, d)
    out = jnp.zeros((n_tok + 1, d), ys.dtype).at[buf_tok].add(ys * buf_w[:, None].astype(ys.dtype))
    return out[:n_tok]


def setup_inputs(seed: int = 0) -> dict:
    key = jax.random.key(seed)
    ks = jax.random.split(key, 32)

    def nrm(k, shape, scale):
        return jax.random.normal(k, shape, jnp.float32) * scale

    D, L = D_MODEL, DEPTH
    gate_bias = jnp.concatenate([jnp.zeros((B_HEADS,)), jnp.linspace(3.0, 6.0, B_HEADS),
                                 jnp.zeros((B_HEADS,)), jnp.linspace(3.0, 6.0, B_HEADS)]).astype(jnp.float32)
    return {
        'x': nrm(ks[0], (BATCH, SEQ, D), 1.0),
        'c': nrm(ks[1], (BATCH, D), 1.0),
        'ctx': nrm(ks[2], (BATCH, CTX_LEN, D), 1.0),
        'c_ctx': nrm(ks[3], (D,), 1.0),
        'w_ada': nrm(ks[4], (L, D, 6 * D), D ** -0.5),
        'b_ada': nrm(ks[5], (L, 6 * D), 0.02),
        'w_in': nrm(ks[6], (L, D, D_IN), D ** -0.5),
        'b_in': nrm(ks[7], (L, D_IN), 0.02).at[:, OFF_GATES:].add(gate_bias),
        'w_s': nrm(ks[8], (L, A_GROUPS, CHUNK, CHUNK), CHUNK ** -0.5),
        'b_s': 1.0 + nrm(ks[9], (L, A_GROUPS, CHUNK), 0.02),
        'sgu_g': 1.0 + nrm(ks[10], (L, A_WIDTH), 0.02),
        'sgu_b': nrm(ks[11], (L, A_WIDTH), 0.02),
        'conv_w': nrm(ks[12], (L, CONV_K, B_WIDTH), CONV_K ** -0.5),
        'conv_b': nrm(ks[13], (L, B_WIDTH), 0.02),
        'w_q': nrm(ks[14], (L, B_HEADS, B_HDIM, B_HDIM), B_HDIM ** -0.5),
        'w_k': nrm(ks[15], (L, B_HEADS, B_HDIM, B_HDIM), B_HDIM ** -0.5),
        'mh_g': 1.0 + nrm(ks[16], (L, B_WIDTH), 0.02),
        'skip': 1.0 + nrm(ks[17], (L, B_WIDTH), 0.02),
        'p_a': nrm(ks[18], (L, A_WIDTH, D), BETA * A_WIDTH ** -0.5),
        'p_b': nrm(ks[19], (L, B_WIDTH, D), BETA * B_WIDTH ** -0.5),
        'w_o': nrm(ks[20], (L, D, D), BETA * D ** -0.5),
        'ln1_g': 1.0 + nrm(ks[21], (L, D), 0.02),
        'ln1_b': nrm(ks[22], (L, D), 0.02),
        'w_rg': nrm(ks[23], (L, D, N_GROUPS), D ** -0.5),
        'b_rg': nrm(ks[24], (L, N_GROUPS), 0.01),
        'w_re': nrm(ks[25], (L, D, N_EXPERTS), D ** -0.5),
        'b_re': nrm(ks[26], (L, N_EXPERTS), 0.01),
        'w1': nrm(ks[27], (L, N_EXPERTS, D, D_EXPERT), D ** -0.5),
        'w3': nrm(ks[28], (L, N_EXPERTS, D, D_EXPERT), D ** -0.5),
        'w2': nrm(ks[29], (L, N_EXPERTS, D_EXPERT, D), BETA * D_EXPERT ** -0.5),
        'ln2_g': 1.0 + nrm(ks[30], (L, D), 0.02),
        'ln2_b': nrm(ks[31], (L, D), 0.02),
    }


def reference(x, c, ctx, c_ctx, w_ada, b_ada, w_in, b_in, w_s, b_s, sgu_g, sgu_b, conv_w, conv_b,
              w_q, w_k, mh_g, skip, p_a, p_b, w_o, ln1_g, ln1_b, w_rg, b_rg, w_re, b_re,
              w1, w3, w2, ln2_g, ln2_b):
    bsz, seq, d = x.shape
    rows = seq // GRID_W
    n_lat_chunks = rows // CHUNK_ROWS
    for l in range(DEPTH):
        need_ctx = l < DEPTH - 1
        mod = jax.nn.silu(c) @ w_ada[l] + b_ada[l]
        mod_c = jax.nn.silu(c_ctx)[None] @ w_ada[l] + b_ada[l]
        sh1, sc1, g1, sh2, sc2, g2 = jnp.split(mod, 6, axis=-1)
        sh1c, sc1c, g1c, sh2c, sc2c, g2c = jnp.split(mod_c, 6, axis=-1)
        y, yc = token_mixer(modulate(x, sh1, sc1), modulate(ctx, sh1c, sc1c), n_lat_chunks, need_ctx,
                            w_in[l], b_in[l], w_s[l], b_s[l], sgu_g[l], sgu_b[l], conv_w[l], conv_b[l],
                            w_q[l], w_k[l], mh_g[l], skip[l], p_a[l], p_b[l], w_o[l])
        x = layer_norm(ALPHA * x + g1[:, None] * y, ln1_g[l], ln1_b[l])
        u2 = modulate(x, sh2, sc2).reshape(bsz * seq, d)
        if need_ctx:
            ctx = layer_norm(ALPHA * ctx + g1c[:, None] * yc, ln1_g[l], ln1_b[l])
            u2c = modulate(ctx, sh2c, sc2c).reshape(-1, d)
            n_c = u2c.shape[0]
            f_all = moe(jnp.concatenate([u2c, u2], axis=0), w_rg[l], b_rg[l], w_re[l], b_re[l], w1[l], w3[l], w2[l])
            fc, f = f_all[:n_c], f_all[n_c:]
            ctx = layer_norm(ALPHA * ctx + g2c[:, None] * fc.reshape(ctx.shape), ln2_g[l], ln2_b[l])
        else:
            f = moe(u2, w_rg[l], b_rg[l], w_re[l], b_re[l], w1[l], w3[l], w2[l])
        x = layer_norm(ALPHA * x + g2[:, None] * f.reshape(bsz, seq, d), ln2_g[l], ln2_b[l])
    return x
```

```cpp
#include <hip/hip_runtime.h>
#include <cstdio>
#include <cstdint>

#ifndef MK_N_LAUNCHES
#define MK_N_LAUNCHES 1
#endif

#define GAS __attribute__((address_space(1)))
#define LAS __attribute__((address_space(3)))
#define DI __device__ __forceinline__
typedef unsigned short u16;
typedef short bf16x8 __attribute__((ext_vector_type(8)));
typedef float f32x4 __attribute__((ext_vector_type(4)));
typedef float f32x2 __attribute__((ext_vector_type(2)));
typedef unsigned u32x4 __attribute__((ext_vector_type(4)));
typedef unsigned u32x2 __attribute__((ext_vector_type(2)));

constexpr int T = 16384, TC = 256, TR = T + TC, D = 2048, DIN = 9248, NPJ = 9216, NPAD = 9472;
constexpr int OFF_UA = 0, OFF_VA = 1024, OFF_XM = 2048, OFF_VB = 3072, OFF_OB = 4096, OFF_GA = 5120, OFF_GB = 7168, OFF_GATES = 9216;
constexpr int NCH = 130;
constexpr int NE = 32, DE = 1024;
constexpr int XS_TILES = 160;
constexpr float LN_EPS = 1e-5f, NEGF = -1e30f, ALPHA = 1.189207115002721f;
constexpr int NPHASE = 13;

constexpr size_t MiB = 1u << 20;
constexpr size_t WS_CTL = 0, CTL_ZERO_BYTES = 1 * MiB;
constexpr size_t WS_MOD = 1 * MiB;
constexpr size_t WS_WRT = 1 * MiB + 512 * 1024;
constexpr size_t WS_WQK = 2 * MiB;
constexpr size_t WS_WSB = 2 * MiB + 512 * 1024;
constexpr size_t WS_GB = 3 * MiB;
constexpr size_t WS_NL = 6 * MiB;
constexpr size_t WS_SC = 7 * MiB + 512 * 1024;
constexpr size_t WS_TOKE = 8 * MiB;
constexpr size_t WS_TOKW = 8 * MiB + 128 * 1024;
constexpr size_t WS_TOKS = 8 * MiB + 256 * 1024;
constexpr size_t WS_TOKP = 8 * MiB + 384 * 1024;
constexpr size_t WS_GATES = 9 * MiB;
constexpr size_t WS_WIN = 16 * MiB;
constexpr size_t WS_PAB = 53 * MiB;
constexpr size_t WS_WO = 61 * MiB;
constexpr size_t WS_W13 = 69 * MiB;
constexpr size_t WS_W2 = 325 * MiB;
constexpr size_t WS_R1 = 453 * MiB;
constexpr size_t WS_XS = WS_R1, WS_H = WS_R1 + 160 * MiB;
constexpr size_t WS_R2 = 746 * MiB;
constexpr size_t WS_R3 = 811 * MiB;
constexpr size_t WS_R4 = 875 * MiB;
constexpr size_t WS_R5 = 940 * MiB;
constexpr size_t WS_YS = WS_R2;
constexpr size_t WS_END = 1004 * MiB;
static_assert(WS_R1 + (size_t)TR * NPJ * 2 <= WS_R2 && WS_H + (size_t)XS_TILES * 256 * 1024 * 2 <= WS_R2, "R1");
static_assert(WS_R2 + (size_t)TR * 2048 * 2 <= WS_R3 && WS_R3 + (size_t)T * 2048 * 2 <= WS_R4 && WS_R4 + (size_t)16 * NCH * 16384 * 2 <= WS_R5 && WS_R5 + (size_t)T * 2048 * 2 <= WS_END, "R2-5");
static_assert(WS_YS + (size_t)XS_TILES * 256 * 2048 * 2 <= WS_R5, "YS");
static_assert(WS_WIN + (size_t)NPAD * 2048 * 2 <= WS_PAB && WS_W13 + (size_t)32 * 2048 * 2048 * 2 <= WS_W2 && WS_W2 + (size_t)32 * 2048 * 1024 * 2 <= WS_R1, "weights");
static_assert(WS_GB + (size_t)8 * TR * 16 <= WS_NL && WS_NL + (size_t)16 * NCH * 128 * 4 <= WS_SC && WS_GATES + (size_t)TR * 32 * 4 <= WS_WIN, "small");
constexpr int CW_CNT = 64;
constexpr int CW_BAR = 4096;

constexpr int RING_BYTES = 131072;
constexpr int LDSCTL_OFF = RING_BYTES;
constexpr int MISC_OFF = LDSCTL_OFF + 64;
constexpr int TILEE_OFF = LDSCTL_OFF + 256;
constexpr int LDS_BYTES = 147456;

DI unsigned cvt_pk_bf16(float lo, float hi) { unsigned r; asm volatile("v_cvt_pk_bf16_f32 %0, %1, %2" : "=v"(r) : "v"(lo), "v"(hi)); return r; }
DI unsigned f2bf(float f) { return cvt_pk_bf16(f, 0.f) & 0xffffu; }
DI float bflo(unsigned w) { return __uint_as_float(w << 16); }
DI float bfhi(unsigned w) { return __uint_as_float(w & 0xffff0000u); }
DI u32x2 pack4(f32x4 v) { u32x2 o; o.x = cvt_pk_bf16(v[0], v[1]); o.y = cvt_pk_bf16(v[2], v[3]); return o; }
DI f32x4 unpack4(u32x2 w) { return (f32x4){bflo(w.x), bfhi(w.x), bflo(w.y), bfhi(w.y)}; }
DI float sigmoid_fast(float x) { return __builtin_amdgcn_rcpf(1.f + __builtin_amdgcn_exp2f(-1.4426950408889634f * x)); }
DI float gelu_tanh_fast(float x) { const float y = 1.5957691216057308f * (x + 0.044715f * x * x * x); return x * sigmoid_fast(y); }
DI float logsig(float x) { return x < 0.f ? x - log1pf(expf(x)) : -log1pf(expf(-x)); }
DI float wave_sum(float v) {
#pragma unroll
    for (int o = 1; o < 64; o <<= 1) v += __shfl_xor(v, o);
    return v;
}
DI float wave_max(float v) {
#pragma unroll
    for (int o = 1; o < 64; o <<= 1) v = fmaxf(v, __shfl_xor(v, o));
    return v;
}
#define LDS_WAIT() asm volatile("s_waitcnt lgkmcnt(0)" ::: "memory")

namespace pg8 {
constexpr int BM = 256, BK = 64, HALF = 128, HTB = HALF * BK * 2, STAGE_BYTES = 8 * HTB, NXCD = 8, WGM = 8;
__host__ __device__ __forceinline__ int lds_byte(int r, int c) { const int st = (r >> 4) * 2 + (c >> 5), rr = r & 15, cc = c & 31, ob = rr * 64 + cc * 2; return st * 1024 + (ob ^ (((ob >> 9) & 1) << 5)); }
__host__ __device__ __forceinline__ void stage_rc(int b, int& R, int& C) { const int st = b / 1024, sb = b % 1024, swz = sb ^ (((sb >> 9) & 1) << 5); R = (st >> 1) * 16 + swz / 64; C = (st & 1) * 32 + (swz % 64) / 2; }
__host__ __device__ __forceinline__ int perm32(int rho) { const int n = rho >> 4, i = rho & 15; return 8 * (i >> 2) + 4 * n + (i & 3); }
struct Unit { int pm, pn, ex; };
DI int xcd_remap(int wgid, int nwg) { const int q = nwg / NXCD, r = nwg % NXCD, xcd = wgid % NXCD, off = wgid / NXCD; return (xcd < r ? xcd * (q + 1) : r * (q + 1) + (xcd - r) * q) + off; }

template <int SPLIT> struct SchedGrid {
    int nM, nN, nwg, G, c; const char* A; const char* B; size_t a_tile, b_tile, a_split, b_split;
    DI bool next(int i, Unit& u) const {
        const int j = SPLIT ? (i >> 1) : i; u.ex = SPLIT ? (i & 1) : 0;
        const long L = (long)j * G + c; if (L >= nwg) return false;
        const int wgid = xcd_remap((int)L, nwg);
        const int nig = WGM * nN, gid = wgid / nig, fm = gid * WGM, gsz = (nM - fm) < WGM ? (nM - fm) : WGM;
        u.pm = fm + ((wgid % nig) % gsz); u.pn = (wgid % nig) / gsz; return true;
    }
    DI const char* a_base(const Unit& u) const { return A + (size_t)u.pm * a_tile + (size_t)u.ex * a_split; }
    DI const char* b_base(const Unit& u) const { return B + (size_t)u.pn * b_tile + (size_t)u.ex * b_split; }
    DI void a_ready(const Unit&) const {}
    DI void done(const Unit&) const {}
};
struct SchedMoe {
    int nwg, G, c; const LAS int* tile_e; const char* A; const char* B; size_t a_tile, b_exp, b_tile;
    DI bool next(int i, Unit& u) const {
        const long L = (long)i * G + c; if (L >= nwg) return false;
        const int w = xcd_remap((int)L, nwg); u.pm = w >> 3; u.pn = w & 7; u.ex = tile_e[u.pm]; return true;
    }
    DI const char* a_base(const Unit& u) const { return A + (size_t)u.pm * a_tile; }
    DI const char* b_base(const Unit& u) const { return B + (size_t)u.ex * b_exp + (size_t)u.pn * b_tile; }
    DI void a_ready(const Unit&) const {}
    DI void done(const Unit&) const {}
};

template <class Epi, class Sched, bool ALIGN_EPI>
DI void gemm_phase(LAS unsigned char* lds, const int K, const int lda, const int ldb, const Sched& S, const Epi& E) {
    const int tid = threadIdx.x, wid = __builtin_amdgcn_readfirstlane(tid >> 6), lane = tid & 63, wr = wid >> 2, wc = wid & 3, fr = lane & 15, fq = lane >> 4;
    const int nt = K / BK;
    unsigned voffA[2], voffB[2];
#pragma unroll
    for (int i = 0; i < 2; ++i) { int R, C; stage_rc(tid * 16 + i * 8192, R, C); const int Rb = Epi::PERM ? ((R & ~31) + perm32(R & 31)) : R;
        voffA[i] = (unsigned)(R * lda + C) * 2u; voffB[i] = (unsigned)(Rb * ldb + C) * 2u; }
    const size_t kstep = (size_t)(BK * 2);
    const size_t hstepA = (size_t)HALF * lda * 2, hstepB = (size_t)HALF * ldb * 2;
    const unsigned ldsw = (unsigned)wid * 1024u;
    const int aoff = lds_byte(wr * 64 + fr, fq * 8), boff = lds_byte(wc * 32 + fr, fq * 8);
#define PG8_SA(b, h) (((b) * 2 + (h)) * HTB)
#define PG8_SB(b, h) ((4 + (b) * 2 + (h)) * HTB)
#define PG8_STAGE(bufoff, gbase, voff) do { _Pragma("unroll") for (int _i = 0; _i < 2; ++_i) \
        __builtin_amdgcn_global_load_lds((const unsigned*)((const char*)(gbase) + (voff)[_i]), (LAS unsigned*)(lds + (bufoff) + ldsw + _i * 8192), 16, 0, 0); } while (0)
#define PG8_LDA(dst, b, h) do { _Pragma("unroll") for (int m = 0; m < 4; ++m) _Pragma("unroll") for (int k = 0; k < 2; ++k) dst[m][k] = *(const LAS bf16x8*)(lds + PG8_SA(b, h) + aoff + m * 2048 + k * 1024); } while (0)
#define PG8_LDB(dst, b, h) do { _Pragma("unroll") for (int n = 0; n < 2; ++n) _Pragma("unroll") for (int k = 0; k < 2; ++k) dst[n][k] = *(const LAS bf16x8*)(lds + PG8_SB(b, h) + boff + n * 2048 + k * 1024); } while (0)
#define PG8_MMA(ai, bj, At, Bt) do { __builtin_amdgcn_s_setprio(1); _Pragma("unroll") for (int m = 0; m < 4; ++m) _Pragma("unroll") for (int n = 0; n < 2; ++n) _Pragma("unroll") for (int k = 0; k < 2; ++k) \
        acc[ai][bj][m][n] = __builtin_amdgcn_mfma_f32_16x16x32_bf16(Bt[n][k], At[m][k], acc[ai][bj][m][n], 0, 0, 0); __builtin_amdgcn_s_setprio(0); } while (0)
#define PG8_WAIT_V(n) asm volatile("s_waitcnt vmcnt(" #n ")" ::: "memory")
#define PG8_WAIT_L(n) asm volatile("s_waitcnt lgkmcnt(" #n ")" ::: "memory")
#define PG8_BAR __builtin_amdgcn_s_barrier()
#define PG8_SCHED __builtin_amdgcn_sched_barrier(0)
    Unit cur, nxt; int ui = 0;
    if (!S.next(0, cur)) return;
    f32x4 acc[2][2][4][2];
#pragma unroll
    for (int a = 0; a < 2; ++a)
#pragma unroll
        for (int b = 0; b < 2; ++b)
#pragma unroll
            for (int m = 0; m < 4; ++m)
#pragma unroll
                for (int n = 0; n < 2; ++n) acc[a][b][m][n] = (f32x4){0.f, 0.f, 0.f, 0.f};
    bf16x8 At[4][2], B0[2][2], B1[2][2];
    const char* cA = S.a_base(cur); const char* cB = S.b_base(cur);
    S.a_ready(cur);
    PG8_STAGE(PG8_SB(0, 0), cB, voffB); PG8_STAGE(PG8_SB(0, 1), cB + hstepB, voffB); PG8_STAGE(PG8_SA(0, 0), cA, voffA); PG8_STAGE(PG8_SA(0, 1), cA + hstepA, voffA);
    if (wr == 1) PG8_BAR;
    PG8_WAIT_V(2); PG8_BAR;
    PG8_STAGE(PG8_SB(1, 0), cB + kstep, voffB); PG8_STAGE(PG8_SA(1, 0), cA + kstep, voffA); PG8_STAGE(PG8_SB(1, 1), cB + hstepB + kstep, voffB);
    PG8_WAIT_V(6); PG8_BAR;
    for (;;) {
        const bool has_next = S.next(ui + 1, nxt);
        const char* nA = has_next ? S.a_base(nxt) : cA; const char* nB = has_next ? S.b_base(nxt) : cB;
        for (int t = 0; t < nt; t += 2) {
            const bool last = (t == nt - 2);
            const char* a1 = cA + (size_t)(t + 1) * kstep;
            const char* a2 = last ? nA : cA + (size_t)(t + 2) * kstep; const char* b2 = last ? nB : cB + (size_t)(t + 2) * kstep;
            const char* a3 = a2 + kstep; const char* b3 = b2 + kstep;
            if (last && has_next) S.a_ready(nxt);
            PG8_LDB(B0, 0, 0); PG8_LDB(B1, 0, 1); PG8_SCHED; PG8_LDA(At, 0, 0); PG8_STAGE(PG8_SA(1, 1), a1 + hstepA, voffA);
            PG8_WAIT_V(8); PG8_WAIT_L(0); PG8_BAR; PG8_MMA(0, 0, At, B0); PG8_MMA(0, 1, At, B1); PG8_BAR; PG8_SCHED;
            PG8_LDA(At, 0, 1); PG8_STAGE(PG8_SB(0, 0), b2, voffB); PG8_STAGE(PG8_SB(0, 1), b2 + hstepB, voffB); PG8_STAGE(PG8_SA(0, 0), a2, voffA);
            PG8_WAIT_V(8); PG8_WAIT_L(0); PG8_BAR; PG8_MMA(1, 0, At, B0); PG8_MMA(1, 1, At, B1); PG8_BAR; PG8_SCHED;
            PG8_LDB(B0, 1, 0); PG8_LDB(B1, 1, 1); PG8_SCHED; PG8_LDA(At, 1, 0); PG8_STAGE(PG8_SA(0, 1), a2 + hstepA, voffA);
            PG8_WAIT_V(8); PG8_WAIT_L(0); PG8_BAR; PG8_MMA(0, 0, At, B0); PG8_MMA(0, 1, At, B1); PG8_BAR; PG8_SCHED;
            PG8_LDA(At, 1, 1); PG8_STAGE(PG8_SB(1, 0), b3, voffB); PG8_STAGE(PG8_SB(1, 1), b3 + hstepB, voffB); PG8_STAGE(PG8_SA(1, 0), a3, voffA);
            PG8_WAIT_V(8); PG8_WAIT_L(0); PG8_BAR; PG8_MMA(1, 0, At, B0); PG8_MMA(1, 1, At, B1); PG8_BAR; PG8_SCHED;
        }
        if constexpr (ALIGN_EPI) { if (wr == 0) PG8_BAR; }
        E(acc, cur, wr, wc, fr, fq); S.done(cur);
        if (!has_next) break;
#pragma unroll
        for (int a = 0; a < 2; ++a)
#pragma unroll
            for (int b = 0; b < 2; ++b)
#pragma unroll
                for (int m = 0; m < 4; ++m)
#pragma unroll
                    for (int n = 0; n < 2; ++n) acc[a][b][m][n] = (f32x4){0.f, 0.f, 0.f, 0.f};
        cur = nxt; cA = nA; cB = nB; ++ui;
        if constexpr (ALIGN_EPI) { if (wr == 1) PG8_BAR; }
    }
    PG8_WAIT_V(0);
    if constexpr (!ALIGN_EPI) { if (wr == 0) PG8_BAR; }
    PG8_BAR;
#undef PG8_SA
#undef PG8_SB
#undef PG8_STAGE
#undef PG8_LDA
#undef PG8_LDB
#undef PG8_MMA
#undef PG8_WAIT_V
#undef PG8_WAIT_L
#undef PG8_BAR
#undef PG8_SCHED
}

struct EpiProj {
    static constexpr bool PERM = true;
    u16* P; float* gates; const float* bias;
    DI void operator()(const f32x4 (&acc)[2][2][4][2], const Unit& u, int wr, int wc, int fr, int fq) const {
        const int row0 = u.pm * BM + wr * 64 + fr;
        if (u.pn == 36) {
            if (wc == 0) {
                const int c0 = 8 * fq; const f32x4 b0 = *(const f32x4*)(bias + OFF_GATES + c0), b1 = *(const f32x4*)(bias + OFF_GATES + c0 + 4);
#pragma unroll
                for (int ai = 0; ai < 2; ++ai)
#pragma unroll
                    for (int m = 0; m < 4; ++m) { float* g = gates + (size_t)(row0 + ai * HALF + m * 16) * 32 + c0;
                        *(f32x4*)g = acc[ai][0][m][0] + b0; *(f32x4*)(g + 4) = acc[ai][0][m][1] + b1; }
            }
            return;
        }
        const int seg = u.pn >> 2; const int mode = (seg <= 1) ? 1 : ((seg <= 3) ? 0 : 2);
        const int col0 = u.pn * BM + wc * 32 + 8 * fq;
        f32x4 bv[2][2];
#pragma unroll
        for (int bj = 0; bj < 2; ++bj)
#pragma unroll
            for (int n = 0; n < 2; ++n) bv[bj][n] = *(const f32x4*)(bias + col0 + bj * HALF + 4 * n);
#pragma unroll
        for (int ai = 0; ai < 2; ++ai)
#pragma unroll
            for (int m = 0; m < 4; ++m) { u16* rowp = P + (size_t)(row0 + ai * HALF + m * 16) * NPJ + col0;
#pragma unroll
                for (int bj = 0; bj < 2; ++bj) { f32x4 v0 = acc[ai][bj][m][0] + bv[bj][0], v1 = acc[ai][bj][m][1] + bv[bj][1];
                    if (mode == 1) {
#pragma unroll
                        for (int j = 0; j < 4; ++j) { v0[j] = gelu_tanh_fast(v0[j]); v1[j] = gelu_tanh_fast(v1[j]); } }
                    else if (mode == 2) {
#pragma unroll
                        for (int j = 0; j < 4; ++j) { v0[j] = sigmoid_fast(v0[j]); v1[j] = sigmoid_fast(v1[j]); } }
                    u32x4 w; w.x = cvt_pk_bf16(v0[0], v0[1]); w.y = cvt_pk_bf16(v0[2], v0[3]); w.z = cvt_pk_bf16(v1[0], v1[1]); w.w = cvt_pk_bf16(v1[2], v1[3]);
                    *(u32x4*)(rowp + bj * HALF) = w; } }
    }
};
struct EpiMerge {
    static constexpr bool PERM = true;
    u16* Z; const u16* P;
    DI void operator()(const f32x4 (&acc)[2][2][4][2], const Unit& u, int wr, int wc, int fr, int fq) const {
        const int row0 = u.pm * BM + wr * 64 + fr, col0 = u.pn * BM + wc * 32 + 8 * fq, goff = u.ex ? OFF_GB : OFF_GA;
#pragma unroll
        for (int ai = 0; ai < 2; ++ai)
#pragma unroll
            for (int m = 0; m < 4; ++m) { const size_t row = (size_t)(row0 + ai * HALF + m * 16); u16* zp = Z + row * 2048 + col0; const u16* gp = P + row * NPJ + goff + col0;
#pragma unroll
                for (int bj = 0; bj < 2; ++bj) { const u32x4 g = *(const u32x4*)(gp + bj * HALF);
                    f32x4 v0 = acc[ai][bj][m][0] * (f32x4){bflo(g.x), bfhi(g.x), bflo(g.y), bfhi(g.y)}, v1 = acc[ai][bj][m][1] * (f32x4){bflo(g.z), bfhi(g.z), bflo(g.w), bfhi(g.w)};
                    if (u.ex) { const u32x4 z = *(const u32x4*)(zp + bj * HALF); v0 += (f32x4){bflo(z.x), bfhi(z.x), bflo(z.y), bfhi(z.y)}; v1 += (f32x4){bflo(z.z), bfhi(z.z), bflo(z.w), bfhi(z.w)}; }
                    u32x4 w; w.x = cvt_pk_bf16(v0[0], v0[1]); w.y = cvt_pk_bf16(v0[2], v0[3]); w.z = cvt_pk_bf16(v1[0], v1[1]); w.w = cvt_pk_bf16(v1[2], v1[3]);
                    *(u32x4*)(zp + bj * HALF) = w; } }
    }
};
struct EpiWo {
    static constexpr bool PERM = false;
    const float* x; float* R; const float* g1;
    DI void operator()(const f32x4 (&acc)[2][2][4][2], const Unit& u, int wr, int wc, int fr, int fq) const {
        const int row0 = u.pm * BM + wr * 64 + fr, col0 = u.pn * BM + wc * 32 + 4 * fq;
        f32x4 gv[2][2];
#pragma unroll
        for (int bj = 0; bj < 2; ++bj)
#pragma unroll
            for (int n = 0; n < 2; ++n) gv[bj][n] = *(const f32x4*)(g1 + col0 + bj * HALF + n * 16);
#pragma unroll
        for (int ai = 0; ai < 2; ++ai)
#pragma unroll
            for (int m = 0; m < 4; ++m) { const size_t off = (size_t)(row0 + ai * HALF + m * 16) * 2048 + col0;
#pragma unroll
                for (int bj = 0; bj < 2; ++bj)
#pragma unroll
                    for (int n = 0; n < 2; ++n) { const f32x4 xs = *(const f32x4*)(x + off + bj * HALF + n * 16); *(f32x4*)(R + off + bj * HALF + n * 16) = xs * ALPHA + gv[bj][n] * acc[ai][bj][m][n]; } }
    }
};
struct EpiMoeUp {
    static constexpr bool PERM = true;
    u16* H;
    DI void operator()(const f32x4 (&acc)[2][2][4][2], const Unit& u, int wr, int wc, int fr, int fq) const {
        const int row0 = u.pm * BM + wr * 64 + fr, col0 = u.pn * HALF + wc * 32 + 8 * fq;
#pragma unroll
        for (int ai = 0; ai < 2; ++ai)
#pragma unroll
            for (int m = 0; m < 4; ++m) { u16* hp = H + (size_t)(row0 + ai * HALF + m * 16) * DE + col0; f32x4 o[2];
#pragma unroll
                for (int n = 0; n < 2; ++n)
#pragma unroll
                    for (int j = 0; j < 4; ++j) { const float a = acc[ai][0][m][n][j]; o[n][j] = a * sigmoid_fast(a) * acc[ai][1][m][n][j]; }
                u32x4 w; w.x = cvt_pk_bf16(o[0][0], o[0][1]); w.y = cvt_pk_bf16(o[0][2], o[0][3]); w.z = cvt_pk_bf16(o[1][0], o[1][1]); w.w = cvt_pk_bf16(o[1][2], o[1][3]);
                *(u32x4*)hp = w; }
    }
};
struct EpiMoeDown {
    static constexpr bool PERM = true;
    u16* Y;
    DI void operator()(const f32x4 (&acc)[2][2][4][2], const Unit& u, int wr, int wc, int fr, int fq) const {
        const int row0 = u.pm * BM + wr * 64 + fr, col0 = u.pn * BM + wc * 32 + 8 * fq;
#pragma unroll
        for (int ai = 0; ai < 2; ++ai)
#pragma unroll
            for (int m = 0; m < 4; ++m) { u16* yp = Y + (size_t)(row0 + ai * HALF + m * 16) * 2048 + col0;
#pragma unroll
                for (int bj = 0; bj < 2; ++bj) { const f32x4 v0 = acc[ai][bj][m][0], v1 = acc[ai][bj][m][1];
                    u32x4 w; w.x = cvt_pk_bf16(v0[0], v0[1]); w.y = cvt_pk_bf16(v0[2], v0[3]); w.z = cvt_pk_bf16(v1[0], v1[1]); w.w = cvt_pk_bf16(v1[2], v1[3]);
                    *(u32x4*)(yp + bj * HALF) = w; } }
    }
};
}

#define XB_TMO      128
#define XB_XCNT(j)  (256  + 64 * (j))
#define XB_XSUB(j)  (1280 + 64 * (j))
#define XB_XGEN(j)  (2304 + 64 * (j))
#define XB_TOP      3328
#define XB_TOPGEN   3392
#define XCD_BAR_WORDS 3456
#define XB_SPIN_CAP (1u << 18)
__device__ __forceinline__ unsigned xb_ld(unsigned* p)              { return __hip_atomic_load(p, __ATOMIC_RELAXED, __HIP_MEMORY_SCOPE_AGENT); }
__device__ __forceinline__ unsigned xb_add(unsigned* p, unsigned v) { return __hip_atomic_fetch_add(p, v, __ATOMIC_RELAXED, __HIP_MEMORY_SCOPE_AGENT); }
__device__ __forceinline__ unsigned xb_xcc_id() { return (unsigned)__builtin_amdgcn_s_getreg((3 << 11) | 20) & 0xFu; }
#define XB_SPIN(cond, bar) do { unsigned _sp = 0; while (cond) { __builtin_amdgcn_s_sleep(1); \
    if ((++_sp & 255u) == 0u) { if (xb_ld(&(bar)[XB_TMO])) break; if (_sp > XB_SPIN_CAP) { atomicAdd(&(bar)[XB_TMO], 1u); break; } } } } while (0)
struct XcdBarrier { unsigned* bar; unsigned x; volatile LAS unsigned* st; };
__device__ __forceinline__ XcdBarrier xcd_barrier_post(unsigned* bar, volatile LAS unsigned* st) {
    XcdBarrier b; b.bar = bar; b.x = xb_xcc_id(); b.st = st;
    if (threadIdx.x == 0) (void)xb_add(&bar[XB_XCNT(b.x)], 1u);
    return b;
}
__device__ __forceinline__ void xcd_barrier_complete(unsigned* bar, unsigned x, unsigned& nloc, unsigned& nx) {
    const unsigned G = gridDim.x * gridDim.y * gridDim.z;
    unsigned sum, cnt, mine, sp = 0u;
    for (;;) {
        sum = 0u; cnt = 0u; mine = 0u;
#pragma unroll
        for (unsigned j = 0; j < 16; ++j) { const unsigned c = xb_ld(&bar[XB_XCNT(j)]); sum += c; cnt += (c > 0u) ? 1u : 0u; mine = (j == x) ? c : mine; }
        if (sum == G) break;
        __builtin_amdgcn_s_sleep(1);
        if ((++sp & 255u) == 0u) { if (xb_ld(&bar[XB_TMO])) break; if (sp > XB_SPIN_CAP) { atomicAdd(&bar[XB_TMO], 1u); break; } }
    }
    nloc = mine > 0u ? mine : 1u; nx = cnt > 0u ? cnt : 1u;
}
__device__ __forceinline__ void xcd_barrier(const XcdBarrier& b) {
    asm volatile("s_waitcnt vmcnt(0)" ::: "memory");
    __syncthreads();
    if (threadIdx.x == 0) {
        unsigned* bar = b.bar;
        __builtin_amdgcn_s_waitcnt(0);
        unsigned nloc = b.st[0], nx = b.st[1];
        if (nloc == 0u) { xcd_barrier_complete(bar, b.x, nloc, nx); b.st[0] = nloc; b.st[1] = nx; }
        const unsigned old = xb_add(&bar[XB_XSUB(b.x)], 1u);
        const unsigned gen = old / nloc;
        if (old + 1u == (gen + 1u) * nloc) {
            __builtin_amdgcn_fence(__ATOMIC_RELEASE, "agent");
            asm volatile("s_waitcnt vmcnt(0)" ::: "memory");
            const unsigned og = xb_add(&bar[XB_TOP], 1u);
            const unsigned tg = og / nx;
            if (og + 1u == (tg + 1u) * nx) xb_add(&bar[XB_TOPGEN], 1u);
            else XB_SPIN(xb_ld(&bar[XB_TOPGEN]) == tg, bar);
            __builtin_amdgcn_fence(__ATOMIC_ACQUIRE, "agent");
            xb_add(&bar[XB_XGEN(b.x)], 1u);
            asm volatile("s_waitcnt vmcnt(0)" ::: "memory");
        } else {
            XB_SPIN(xb_ld(&bar[XB_XGEN(b.x)]) == gen, bar);
            __builtin_amdgcn_fence(__ATOMIC_ACQUIRE, "agent");
            asm volatile("s_waitcnt vmcnt(0)" ::: "memory");
        }
    }
    __syncthreads();
}

struct Args { const float* in[32]; float* outp; unsigned char* ws; int ph_lo, ph_hi; };
struct Frame {
    LAS unsigned char* lds;
    int tid, lane, wave, bid, G;
    const Args* a; unsigned char* ws;
    DI const float* in(int i) const { asm volatile("" : "+s"(i)); return a->in[i]; }
    DI const float* x() const { return in(0); }
    DI const float* c() const { return in(1); }
    DI const float* ctx() const { return in(2); }
    DI const float* c_ctx() const { return in(3); }
    DI const float* w_ada() const { return in(4); }
    DI const float* b_ada() const { return in(5); }
    DI const float* w_in() const { return in(6); }
    DI const float* b_in() const { return in(7); }
    DI const float* w_s() const { return in(8); }
    DI const float* b_s() const { return in(9); }
    DI const float* sgu_g() const { return in(10); }
    DI const float* sgu_b() const { return in(11); }
    DI const float* conv_w() const { return in(12); }
    DI const float* conv_b() const { return in(13); }
    DI const float* w_q() const { return in(14); }
    DI const float* w_k() const { return in(15); }
    DI const float* mh_g() const { return in(16); }
    DI const float* skip() const { return in(17); }
    DI const float* p_a() const { return in(18); }
    DI const float* p_b() const { return in(19); }
    DI const float* w_o() const { return in(20); }
    DI const float* ln1_g() const { return in(21); }
    DI const float* ln1_b() const { return in(22); }
    DI const float* w_rg() const { return in(23); }
    DI const float* b_rg() const { return in(24); }
    DI const float* w_re() const { return in(25); }
    DI const float* b_re() const { return in(26); }
    DI const float* w1() const { return in(27); }
    DI const float* w3() const { return in(28); }
    DI const float* w2() const { return in(29); }
    DI const float* ln2_g() const { return in(30); }
    DI const float* ln2_b() const { return in(31); }
    DI unsigned* ctl() const { return (unsigned*)(ws + WS_CTL); }
    DI float* MOD() const { return (float*)(ws + WS_MOD); }
    DI float* WRT() const { return (float*)(ws + WS_WRT); }
    DI float* GB() const { return (float*)(ws + WS_GB); }
    DI float* NL() const { return (float*)(ws + WS_NL); }
    DI float* SC() const { return (float*)(ws + WS_SC); }
    DI float* TOKW() const { return (float*)(ws + WS_TOKW); }
    DI float* GATES() const { return (float*)(ws + WS_GATES); }
    DI int* TOKE() const { return (int*)(ws + WS_TOKE); }
    DI int* TOKS() const { return (int*)(ws + WS_TOKS); }
    DI int* TOKP() const { return (int*)(ws + WS_TOKP); }
    DI u16* WQK() const { return (u16*)(ws + WS_WQK); }
    DI u16* WSB() const { return (u16*)(ws + WS_WSB); }
    DI u16* WIN() const { return (u16*)(ws + WS_WIN); }
    DI u16* PAB() const { return (u16*)(ws + WS_PAB); }
    DI u16* WO() const { return (u16*)(ws + WS_WO); }
    DI u16* W13() const { return (u16*)(ws + WS_W13); }
    DI u16* W2() const { return (u16*)(ws + WS_W2); }
    DI u16* PROJ() const { return (u16*)(ws + WS_R1); }
    DI u16* XS() const { return (u16*)(ws + WS_XS); }
    DI u16* H() const { return (u16*)(ws + WS_H); }
    DI u16* U() const { return (u16*)(ws + WS_R2); }
    DI u16* Q() const { return (u16*)(ws + WS_R2); }
    DI u16* K() const { return (u16*)(ws + WS_R2) + (size_t)TR * 1024; }
    DI u16* U2() const { return (u16*)(ws + WS_R2); }
    DI u16* XC() const { return (u16*)(ws + WS_R3); }
    DI u16* Z() const { return (u16*)(ws + WS_R3); }
    DI u16* ST() const { return (u16*)(ws + WS_R4); }
    DI u16* AB() const { return (u16*)(ws + WS_R5); }
    DI u16* YS() const { return (u16*)(ws + WS_YS); }
    DI float* out() const { return a->outp; }
};

DI bf16x8 ld8(const LAS u16* p) { return *(const LAS bf16x8*)p; }
DI bf16x8 ld8(const GAS u16* p) { return *(const GAS bf16x8*)p; }
template <int NT, class PA, class PB>
DI void wave_mm(f32x4 (&acc)[NT], PA A, int lda, PB B, int ldb, int K, int lane) {
    const int fr = lane & 15, fq = lane >> 4;
#pragma unroll 1
    for (int k0 = 0; k0 < K; k0 += 32) {
        const bf16x8 a = ld8(A + fr * lda + k0 + 8 * fq);
#pragma unroll
        for (int t = 0; t < NT; ++t) { const bf16x8 b = ld8(B + (16 * t + fr) * ldb + k0 + 8 * fq); acc[t] = __builtin_amdgcn_mfma_f32_16x16x32_bf16(b, a, acc[t], 0, 0, 0); }
    }
}
template <int NT> DI void zero_acc(f32x4 (&acc)[NT]) {
#pragma unroll
    for (int t = 0; t < NT; ++t) acc[t] = (f32x4){0.f, 0.f, 0.f, 0.f};
}

DI void p0_gemv(Frame& F, int cb) {
    LAS float* sv = (LAS float*)F.lds;
    LAS float* red = sv + 4096;
    for (int i = F.tid; i < 2048; i += 512) { const float a = F.c()[i], b = F.c_ctx()[i]; sv[i] = a / (1.f + expf(-a)); sv[2048 + i] = b / (1.f + expf(-b)); }
    __syncthreads();
    const int l16 = F.tid & 15, rl = F.tid >> 4;
    f32x4 a1 = (f32x4){0.f, 0.f, 0.f, 0.f}, a2 = a1;
    const float* wp = F.w_ada() + (size_t)rl * 12288 + 64 * cb + 4 * l16;
#pragma unroll 8
    for (int it = 0; it < 64; ++it) { const f32x4 w = *(const GAS f32x4*)(wp + (size_t)it * 32 * 12288); const float s1 = sv[rl + 32 * it], s2 = sv[2048 + rl + 32 * it]; a1 += w * s1; a2 += w * s2; }
    *(LAS f32x4*)(red + (rl * 16 + l16) * 8) = a1; *(LAS f32x4*)(red + (rl * 16 + l16) * 8 + 4) = a2;
    __syncthreads();
    if (F.tid < 128) { const int v = F.tid >> 6, col = F.tid & 63, q16 = col >> 2, j = col & 3; float s = 0.f;
        for (int r = 0; r < 32; ++r) s += red[(r * 16 + q16) * 8 + v * 4 + j];
        F.MOD()[v * 12288 + 64 * cb + col] = s + F.b_ada()[64 * cb + col]; }
    __syncthreads();
}
DI void tr_item(const float* src, int ldn, int k0, int n0, int nvalid, u16* dst, int ldk, int drow0, int dk0, LAS float* scr, int lane) {
    const int n = n0 + (lane & 31); const bool ok = n < nvalid;
#pragma unroll 8
    for (int i = 0; i < 32; ++i) { const int kk = 2 * i + (lane >> 5); scr[kk * 33 + (lane & 31)] = ok ? src[(size_t)(k0 + kk) * ldn + n] : 0.f; }
    LDS_WAIT(); asm volatile("" ::: "memory");
    const int c = lane & 7;
#pragma unroll
    for (int j = 0; j < 4; ++j) { const int nn = (lane >> 3) + 8 * j; const LAS float* s = scr + (8 * c) * 33 + nn;
        u32x4 o; o.x = cvt_pk_bf16(s[0 * 33], s[1 * 33]); o.y = cvt_pk_bf16(s[2 * 33], s[3 * 33]); o.z = cvt_pk_bf16(s[4 * 33], s[5 * 33]); o.w = cvt_pk_bf16(s[6 * 33], s[7 * 33]);
        *(GAS u32x4*)(dst + (size_t)(drow0 + nn) * ldk + dk0 + 8 * c) = o; }
    LDS_WAIT(); asm volatile("" ::: "memory");
}
DI void p0_prologue(Frame& F) {
    for (int cb = F.bid; cb < 192; cb += F.G) p0_gemv(F, cb);
    LAS float* scr = (LAS float*)(F.lds + F.wave * 16384);
    const int gw = F.bid * 8 + F.wave, NGW = F.G * 8;
    constexpr int I_IN = 32 * (NPAD / 32), I_PA = 16 * 64, I_WO = 32 * 64, I_W1 = 32 * 1024, I_W2 = 32 * 1024, I_QK = 8 * 8;
    constexpr int NITEMS = I_IN + 2 * I_PA + I_WO + 2 * I_W1 + I_W2 + 2 * I_QK;
    for (int it = gw; it < NITEMS; it += NGW) {
        int r = it;
        if (r < I_IN) { const int nb = r % (NPAD / 32), kb = r / (NPAD / 32); tr_item(F.w_in(), DIN, 64 * kb, 32 * nb, DIN, F.WIN(), 2048, 32 * nb, 64 * kb, scr, F.lane); continue; } r -= I_IN;
        if (r < I_PA) { const int nb = r % 64, kb = r / 64; tr_item(F.p_a(), 2048, 64 * kb, 32 * nb, 2048, F.PAB(), 2048, 32 * nb, 64 * kb, scr, F.lane); continue; } r -= I_PA;
        if (r < I_PA) { const int nb = r % 64, kb = r / 64; tr_item(F.p_b(), 2048, 64 * kb, 32 * nb, 2048, F.PAB(), 2048, 32 * nb, 1024 + 64 * kb, scr, F.lane); continue; } r -= I_PA;
        if (r < I_WO) { const int nb = r % 64, kb = r / 64; tr_item(F.w_o(), 2048, 64 * kb, 32 * nb, 2048, F.WO(), 2048, 32 * nb, 64 * kb, scr, F.lane); continue; } r -= I_WO;
        if (r < I_W1) { const int e = r >> 10, rr = r & 1023, nb = rr & 31, kb = rr >> 5, n0 = 32 * nb;
            tr_item(F.w1() + (size_t)e * 2048 * 1024, 1024, 64 * kb, n0, 1024, F.W13() + (size_t)e * 2048 * 2048, 2048, 256 * (n0 >> 7) + (n0 & 127), 64 * kb, scr, F.lane); continue; } r -= I_W1;
        if (r < I_W1) { const int e = r >> 10, rr = r & 1023, nb = rr & 31, kb = rr >> 5, n0 = 32 * nb;
            tr_item(F.w3() + (size_t)e * 2048 * 1024, 1024, 64 * kb, n0, 1024, F.W13() + (size_t)e * 2048 * 2048, 2048, 256 * (n0 >> 7) + 128 + (n0 & 127), 64 * kb, scr, F.lane); continue; } r -= I_W1;
        if (r < I_W2) { const int e = r >> 10, rr = r & 1023, nb = rr & 63, kb = rr >> 6;
            tr_item(F.w2() + (size_t)e * 1024 * 2048, 2048, 64 * kb, 32 * nb, 2048, F.W2() + (size_t)e * 2048 * 1024, 1024, 32 * nb, 64 * kb, scr, F.lane); continue; } r -= I_W2;
        if (r < I_QK) { const int h = r >> 3, rr = r & 7, nb = rr & 3, kb = rr >> 2;
            tr_item(F.w_q() + (size_t)h * 16384, 128, 64 * kb, 32 * nb, 128, F.WQK() + (size_t)h * 32768, 128, 32 * nb, 64 * kb, scr, F.lane); continue; } r -= I_QK;
        { const int h = r >> 3, rr = r & 7, nb = rr & 3, kb = rr >> 2;
            tr_item(F.w_k() + (size_t)h * 16384, 128, 64 * kb, 32 * nb, 128, F.WQK() + (size_t)h * 32768, 128, 128 + 32 * nb, 64 * kb, scr, F.lane); }
    }
    const int gt = F.bid * 512 + F.tid, NGT = F.G * 512;
    for (int i = gt; i < 36 * 2048; i += NGT) { const int j = i >> 11, k = i & 2047; F.WRT()[i] = (j < 4) ? F.w_rg()[k * 4 + j] : F.w_re()[k * 32 + (j - 4)]; }
    for (int i = gt; i < 8 * 16384; i += NGT) F.WSB()[i] = (u16)f2bf(F.w_s()[i]);
}

DI void p1_rows(Frame& F) {
    const int gw = F.bid * 8 + F.wave, NGW = F.G * 8;
    for (int r = gw; r < TR; r += NGW) {
        const float* src = r < T ? F.x() + (size_t)r * D : F.ctx() + (size_t)(r - T) * D; const float* mod = F.MOD() + (r < T ? 0 : 12288);
        const GAS f32x4* xr = (const GAS f32x4*)src + F.lane;
        f32x4 v[8]; float s = 0.f;
#pragma unroll
        for (int j = 0; j < 8; ++j) { v[j] = xr[64 * j]; s += (v[j][0] + v[j][1]) + (v[j][2] + v[j][3]); }
        const float mean = wave_sum(s) * (1.f / D); float s2 = 0.f;
#pragma unroll
        for (int j = 0; j < 8; ++j) { v[j] = v[j] - mean; s2 += (v[j][0] * v[j][0] + v[j][1] * v[j][1]) + (v[j][2] * v[j][2] + v[j][3] * v[j][3]); }
        const float rstd = 1.f / sqrtf(wave_sum(s2) * (1.f / D) + LN_EPS);
        GAS u32x2* o = (GAS u32x2*)(F.U() + (size_t)r * D) + F.lane;
#pragma unroll
        for (int j = 0; j < 8; ++j) { const f32x4 sh = *(const f32x4*)(mod + 4 * F.lane + 256 * j), sc = *(const f32x4*)(mod + 2048 + 4 * F.lane + 256 * j);
            o[64 * j] = pack4(v[j] * rstd * (sc + 1.f) + sh); }
    }
}

DI void gmlp_unit(Frame& F, int c) {
    LAS float* MU = (LAS float*)F.lds; LAS float* RS = MU + 128;
    LAS u16* VNT = (LAS u16*)(F.lds + 1024);
    const int r0 = 128 * c, fr = F.lane & 15, fq = F.lane >> 4;
    for (int i = 0; i < 16; ++i) { const int rl = 16 * F.wave + i; const GAS u16* p = (const GAS u16*)(F.PROJ() + (size_t)(r0 + rl) * NPJ + OFF_VA + 16 * F.lane);
        const u32x4 a = *(const GAS u32x4*)p, b = *(const GAS u32x4*)(p + 8);
        float v[16] = {bflo(a.x), bfhi(a.x), bflo(a.y), bfhi(a.y), bflo(a.z), bfhi(a.z), bflo(a.w), bfhi(a.w), bflo(b.x), bfhi(b.x), bflo(b.y), bfhi(b.y), bflo(b.z), bfhi(b.z), bflo(b.w), bfhi(b.w)};
        float s = 0.f;
#pragma unroll
        for (int j = 0; j < 16; ++j) s += v[j];
        const float mean = wave_sum(s) * (1.f / 1024.f); float q = 0.f;
#pragma unroll
        for (int j = 0; j < 16; ++j) { const float d = v[j] - mean; q += d * d; }
        const float var = wave_sum(q) * (1.f / 1024.f);
        if (F.lane == 0) { MU[rl] = mean; RS[rl] = 1.f / sqrtf(var + LN_EPS); } }
    for (int g = 0; g < 8; ++g) {
        __syncthreads();
#pragma unroll
        for (int i = 0; i < 4; ++i) { const int idx = F.tid + 512 * i, p = idx >> 4, c8 = idx & 15;
            const u32x4 v = *(const GAS u32x4*)(F.PROJ() + (size_t)(r0 + p) * NPJ + OFF_VA + 128 * g + 8 * c8);
            const float mu = MU[p], rs = RS[p];
            const f32x4 g0 = *(const f32x4*)(F.sgu_g() + 128 * g + 8 * c8), g1 = *(const f32x4*)(F.sgu_g() + 128 * g + 8 * c8 + 4), b0 = *(const f32x4*)(F.sgu_b() + 128 * g + 8 * c8), b1 = *(const f32x4*)(F.sgu_b() + 128 * g + 8 * c8 + 4);
            const float x[8] = {bflo(v.x), bfhi(v.x), bflo(v.y), bfhi(v.y), bflo(v.z), bfhi(v.z), bflo(v.w), bfhi(v.w)};
            const float gg[8] = {g0[0], g0[1], g0[2], g0[3], g1[0], g1[1], g1[2], g1[3]}, bb[8] = {b0[0], b0[1], b0[2], b0[3], b1[0], b1[1], b1[2], b1[3]};
#pragma unroll
            for (int j = 0; j < 8; ++j) VNT[(8 * c8 + j) * 136 + p] = (u16)f2bf((x[j] - mu) * rs * gg[j] + bb[j]); }
        __syncthreads();
        f32x4 acc[8]; zero_acc<8>(acc);
        wave_mm<8>(acc, (const GAS u16*)(F.WSB() + g * 16384 + 16 * F.wave * 128), 128, (const LAS u16*)VNT, 136, 128, F.lane);
        const int q = 16 * F.wave + fr; const float bsq = F.b_s()[g * 128 + q];
#pragma unroll
        for (int t = 0; t < 8; ++t) { const int ch0 = 128 * g + 16 * t + 4 * fq;
            const f32x4 ua = unpack4(*(const GAS u32x2*)(F.PROJ() + (size_t)(r0 + q) * NPJ + OFF_UA + ch0));
            *(GAS u32x2*)(F.AB() + (size_t)(r0 + q) * 2048 + ch0) = pack4(ua * (acc[t] + bsq)); }
    }
    __syncthreads();
}

DI void mprep_unit(Frame& F, int c, int h) {
    const int r0 = (c < 2) ? T + 128 * c : 128 * (c - 2);
    const int seq_lo = (c < 2) ? T : 0, seq_hi = (c < 2) ? TR - 1 : T - 1;
    LAS u16* XCs = (LAS u16*)F.lds;
    LAS u16* KTF = (LAS u16*)(F.lds + 34816);
    LAS u16* KTB = (LAS u16*)(F.lds + 2 * 34816);
    LAS float* GS = (LAS float*)(F.lds + 3 * 34816);
    const int fr = F.lane & 15, fq = F.lane >> 4;
    if (F.tid < 128) { const float* g = F.GATES() + (size_t)(r0 + F.tid) * 32;
        GS[F.tid] = g[h]; GS[128 + F.tid] = logsig(g[8 + h]); GS[256 + F.tid] = g[16 + h]; GS[384 + F.tid] = logsig(g[24 + h]); }
    __syncthreads();
    if (F.tid == 0) { float s = 0.f; for (int i = 0; i < 128; ++i) { s += GS[128 + i]; GS[512 + i] = s; } }
    if (F.tid == 64) { float s = 0.f; for (int i = 127; i >= 0; --i) { s += GS[384 + i]; GS[640 + i] = s; } }
    __syncthreads();
    if (F.wave < 2) { const int bli = F.wave ? 256 : 0, bb = F.wave ? 640 : 512; const float bs = F.wave ? GS[640] : GS[512 + 127];
        const float l0 = bs - GS[bb + F.lane] + GS[bli + F.lane], l1 = bs - GS[bb + 64 + F.lane] + GS[bli + 64 + F.lane];
        const float ml = wave_max(fmaxf(l0, l1));
        GS[768 + F.wave * 128 + F.lane] = expf(l0 - ml); GS[768 + F.wave * 128 + 64 + F.lane] = expf(l1 - ml);
        if (F.lane == 0) { float* sc = F.SC() + (size_t)((F.wave * 8 + h) * NCH + c) * 4; sc[0] = ml; sc[1] = bs; } }
    else if (F.tid >= 128 && F.tid < 256) { const int s = F.tid - 128; *(f32x4*)(F.GB() + ((size_t)h * TR + r0 + s) * 4) = (f32x4){GS[s], GS[512 + s], GS[256 + s], GS[640 + s]}; }
#pragma unroll
    for (int i = 0; i < 4; ++i) { const int idx = F.tid + 512 * i, s = idx >> 4, c8 = idx & 15, row = r0 + s, ch = 128 * h + 8 * c8;
        const GAS u16* p = (const GAS u16*)(F.PROJ() + (size_t)row * NPJ + OFF_XM + ch);
        const u32x4 z4 = (u32x4){0u, 0u, 0u, 0u};
        const u32x4 xm = *(const GAS u32x4*)p, xp = (row > seq_lo) ? *(const GAS u32x4*)(p - NPJ) : z4, xn = (row < seq_hi) ? *(const GAS u32x4*)(p + NPJ) : z4;
        float y[8];
#pragma unroll
        for (int hh = 0; hh < 2; ++hh) { const f32x4 w0 = *(const f32x4*)(F.conv_w() + ch + 4 * hh), w1 = *(const f32x4*)(F.conv_w() + 1024 + ch + 4 * hh), w2 = *(const f32x4*)(F.conv_w() + 2048 + ch + 4 * hh), cb = *(const f32x4*)(F.conv_b() + ch + 4 * hh);
            const unsigned a0 = hh ? xp.z : xp.x, a1 = hh ? xp.w : xp.y, m0 = hh ? xm.z : xm.x, m1 = hh ? xm.w : xm.y, n0 = hh ? xn.z : xn.x, n1 = hh ? xn.w : xn.y;
            y[4 * hh + 0] = w0[0] * bflo(a0) + w1[0] * bflo(m0) + w2[0] * bflo(n0) + cb[0];
            y[4 * hh + 1] = w0[1] * bfhi(a0) + w1[1] * bfhi(m0) + w2[1] * bfhi(n0) + cb[1];
            y[4 * hh + 2] = w0[2] * bflo(a1) + w1[2] * bflo(m1) + w2[2] * bflo(n1) + cb[2];
            y[4 * hh + 3] = w0[3] * bfhi(a1) + w1[3] * bfhi(m1) + w2[3] * bfhi(n1) + cb[3]; }
#pragma unroll
        for (int j = 0; j < 8; ++j) y[j] = y[j] * sigmoid_fast(y[j]);
        u32x4 o; o.x = cvt_pk_bf16(y[0], y[1]); o.y = cvt_pk_bf16(y[2], y[3]); o.z = cvt_pk_bf16(y[4], y[5]); o.w = cvt_pk_bf16(y[6], y[7]);
        *(LAS u32x4*)(XCs + s * 136 + 8 * c8) = o; *(GAS u32x4*)(F.XC() + (size_t)row * 1024 + ch) = o; }
    __syncthreads();
    {
        f32x4 aq[8], ak[8]; zero_acc<8>(aq); zero_acc<8>(ak);
        wave_mm<8>(aq, (const LAS u16*)(XCs + 16 * F.wave * 136), 136, (const GAS u16*)(F.WQK() + (size_t)h * 32768), 128, 128, F.lane);
        wave_mm<8>(ak, (const LAS u16*)(XCs + 16 * F.wave * 136), 136, (const GAS u16*)(F.WQK() + (size_t)h * 32768 + 16384), 128, 128, F.lane);
        const int s = 16 * F.wave + fr; const float wf = GS[768 + s], wb = GS[896 + s];
#pragma unroll
        for (int t = 0; t < 8; ++t) { const int e0 = 16 * t + 4 * fq; const f32x4 kv = ak[t] * 0.08838834764831845f;
            *(GAS u32x2*)(F.Q() + (size_t)(r0 + s) * 1024 + 128 * h + e0) = pack4(aq[t]);
            *(GAS u32x2*)(F.K() + (size_t)(r0 + s) * 1024 + 128 * h + e0) = pack4(kv);
#pragma unroll
            for (int r = 0; r < 4; ++r) { KTF[(e0 + r) * 136 + s] = (u16)f2bf(kv[r] * wf); KTB[(e0 + r) * 136 + s] = (u16)f2bf(kv[r] * wb); } }
    }
    __syncthreads();
#pragma unroll
    for (int i = 0; i < 4; ++i) { const int idx = F.tid + 512 * i, s = idx >> 4, c8 = idx & 15;
        const u32x4 v = *(const GAS u32x4*)(F.PROJ() + (size_t)(r0 + s) * NPJ + OFF_VB + 128 * h + 8 * c8);
        const unsigned w[4] = {v.x, v.y, v.z, v.w};
#pragma unroll
        for (int j = 0; j < 4; ++j) { XCs[(8 * c8 + 2 * j) * 136 + s] = (u16)(w[j] & 0xffffu); XCs[(8 * c8 + 2 * j + 1) * 136 + s] = (u16)(w[j] >> 16); } }
    __syncthreads();
    {
        f32x4 cf[8], cb[8]; zero_acc<8>(cf); zero_acc<8>(cb);
        wave_mm<8>(cf, (const LAS u16*)(XCs + 16 * F.wave * 136), 136, (const LAS u16*)KTF, 136, 128, F.lane);
        wave_mm<8>(cb, (const LAS u16*)(XCs + 16 * F.wave * 136), 136, (const LAS u16*)KTB, 136, 128, F.lane);
        const int e = 16 * F.wave + fr;
        u16* sf = F.ST() + ((size_t)(h * NCH + c) * 16384) + e * 128; u16* sb = F.ST() + ((size_t)((8 + h) * NCH + c) * 16384) + e * 128;
#pragma unroll
        for (int t = 0; t < 8; ++t) { const int d0 = 16 * t + 4 * fq; *(GAS u32x2*)(sf + d0) = pack4(cf[t]); *(GAS u32x2*)(sb + d0) = pack4(cb[t]); }
    }
    if (F.tid < 256) { const int dir = F.tid >> 7, d = F.tid & 127; const LAS u16* kt = (dir ? KTB : KTF) + d * 136; float s = 0.f;
#pragma unroll
        for (int i = 0; i < 16; ++i) { const u32x4 v = *(const LAS u32x4*)(kt + 8 * i); s += ((bflo(v.x) + bfhi(v.x)) + (bflo(v.y) + bfhi(v.y))) + ((bflo(v.z) + bfhi(v.z)) + (bflo(v.w) + bfhi(v.w))); }
        F.NL()[(size_t)((dir * 8 + h) * NCH + c) * 128 + d] = s; }
    __syncthreads();
}

DI int scan_order(int dir, int j) { return dir == 0 ? j : (j == 0 ? 1 : (j == 1 ? 0 : 131 - j)); }
DI void scan_item(Frame& F, int dh, int blk) {
    const int dir = dh >> 3;
    LAS float* ML = (LAS float*)F.lds; LAS float* BS = ML + 136; LAS float* DEC = ML + 272; LAS float* SCL = ML + 408; LAS float* MB = ML + 544;
    if (F.tid < NCH) { const int cj = scan_order(dir, F.tid); const float* sc = F.SC() + (size_t)(dh * NCH + cj) * 4; ML[F.tid] = sc[0]; BS[F.tid] = sc[1]; }
    __syncthreads();
    if (F.tid == 0) { float m = NEGF; for (int j = 0; j < NCH; ++j) { MB[j] = m; const float mn = fmaxf(BS[j] + m, ML[j]); DEC[j] = expf(BS[j] + m - mn); SCL[j] = expf(ML[j] - mn); m = mn; } }
    __syncthreads();
    GAS unsigned* base = (GAS unsigned*)(F.ST() + (size_t)dh * NCH * 16384) + blk * 512 + F.tid;
    float c0 = 0.f, c1 = 0.f;
    for (int j0 = 0; j0 < NCH; j0 += 10) {
        unsigned kv[10];
#pragma unroll
        for (int jj = 0; jj < 10; ++jj) kv[jj] = base[(size_t)scan_order(dir, j0 + jj) * 8192];
#pragma unroll
        for (int jj = 0; jj < 10; ++jj) { base[(size_t)scan_order(dir, j0 + jj) * 8192] = cvt_pk_bf16(c0, c1);
            const float de = DEC[j0 + jj], sc = SCL[j0 + jj]; c0 = de * c0 + sc * bflo(kv[jj]); c1 = de * c1 + sc * bfhi(kv[jj]); }
    }
    if (blk == 0) {
        if (F.tid < 128) { float n = 0.f; float* nl = F.NL() + (size_t)dh * NCH * 128 + F.tid;
            for (int j = 0; j < NCH; ++j) { const int cj = scan_order(dir, j); const float v = nl[cj * 128]; nl[cj * 128] = n; n = DEC[j] * n + SCL[j] * v; } }
        if (F.tid >= 256 && F.tid < 256 + NCH) { const int j = F.tid - 256; F.SC()[(size_t)(dh * NCH + scan_order(dir, j)) * 4 + 2] = MB[j]; }
    }
    __syncthreads();
}

DI void x3_unit(Frame& F, int lc, int h) {
    const int c = lc + 2, r0 = 128 * lc, fr = F.lane & 15, fq = F.lane >> 4;
    LAS u16* VT = (LAS u16*)F.lds;
    LAS u16* PW = (LAS u16*)(F.lds + 34816) + F.wave * 16 * 136;
    LAS float* GS = (LAS float*)(F.lds + 2 * 34816);
    if (F.tid < 128) { const f32x4 g = *(const GAS f32x4*)(F.GB() + ((size_t)h * TR + r0 + F.tid) * 4); GS[F.tid] = g[0]; GS[128 + F.tid] = g[1]; GS[256 + F.tid] = g[2]; GS[384 + F.tid] = g[3]; }
    else if (F.tid < 384) { const int i = F.tid - 128, dir = i >> 7, d = i & 127; GS[512 + i] = F.NL()[(size_t)((dir * 8 + h) * NCH + c) * 128 + d]; }
    const float mf = F.SC()[(size_t)(h * NCH + c) * 4 + 2], mb = F.SC()[(size_t)((8 + h) * NCH + c) * 4 + 2];
#pragma unroll
    for (int i = 0; i < 4; ++i) { const int idx = F.tid + 512 * i, s = idx >> 4, c8 = idx & 15;
        const u32x4 v = *(const GAS u32x4*)(F.PROJ() + (size_t)(r0 + s) * NPJ + OFF_VB + 128 * h + 8 * c8);
        const unsigned w[4] = {v.x, v.y, v.z, v.w};
#pragma unroll
        for (int j = 0; j < 4; ++j) { VT[(8 * c8 + 2 * j) * 136 + s] = (u16)(w[j] & 0xffffu); VT[(8 * c8 + 2 * j + 1) * 136 + s] = (u16)(w[j] >> 16); } }
    __syncthreads();
    const int ql = 16 * F.wave + fr;
    const GAS u16* Qrows = (const GAS u16*)(F.Q() + (size_t)(r0 + 16 * F.wave) * 1024 + 128 * h);
    f32x4 sf[8], sb[8]; zero_acc<8>(sf);
    wave_mm<8>(sf, Qrows, 1024, (const GAS u16*)(F.K() + (size_t)r0 * 1024 + 128 * h), 1024, 128, F.lane);
    const float bqf = GS[128 + ql], bqb = GS[384 + ql];
    float mxf = -3.0e38f, mxb = -3.0e38f;
#pragma unroll
    for (int t = 0; t < 8; ++t)
#pragma unroll
        for (int r = 0; r < 4; ++r) { const int s = 16 * t + 4 * fq + r; const float df = bqf - GS[128 + s] + GS[s], db = bqb - GS[384 + s] + GS[256 + s];
            mxf = (s <= ql) ? fmaxf(mxf, df) : mxf; mxb = (s >= ql) ? fmaxf(mxb, db) : mxb; }
    mxf = fmaxf(mxf, __shfl_xor(mxf, 16)); mxf = fmaxf(mxf, __shfl_xor(mxf, 32)); mxb = fmaxf(mxb, __shfl_xor(mxb, 16)); mxb = fmaxf(mxb, __shfl_xor(mxb, 32));
    const float mrf = fmaxf(bqf + mf, mxf), mrb = fmaxf(bqb + mb, mxb);
    float rsf = 0.f, rsb = 0.f;
#pragma unroll
    for (int t = 0; t < 8; ++t)
#pragma unroll
        for (int r = 0; r < 4; ++r) { const int s = 16 * t + 4 * fq + r; const float df = bqf - GS[128 + s] + GS[s], db = bqb - GS[384 + s] + GS[256 + s];
            const float ef = (s <= ql) ? expf(df - mrf) : 0.f, eb = (s >= ql) ? expf(db - mrb) : 0.f; const float s0 = sf[t][r];
            sf[t][r] = s0 * ef; sb[t][r] = s0 * eb; rsf += sf[t][r]; rsb += sb[t][r]; }
    rsf += __shfl_xor(rsf, 16); rsf += __shfl_xor(rsf, 32); rsb += __shfl_xor(rsb, 16); rsb += __shfl_xor(rsb, 32);
    float qnf = 0.f, qnb = 0.f;
#pragma unroll
    for (int i = 0; i < 4; ++i) { const u32x4 qv = *(const GAS u32x4*)(F.Q() + (size_t)(r0 + ql) * 1024 + 128 * h + 32 * fq + 8 * i); const int d0 = 32 * fq + 8 * i;
        const float qq[8] = {bflo(qv.x), bfhi(qv.x), bflo(qv.y), bfhi(qv.y), bflo(qv.z), bfhi(qv.z), bflo(qv.w), bfhi(qv.w)};
#pragma unroll
        for (int j = 0; j < 8; ++j) { qnf += qq[j] * GS[512 + d0 + j]; qnb += qq[j] * GS[640 + d0 + j]; } }
    qnf += __shfl_xor(qnf, 16); qnf += __shfl_xor(qnf, 32); qnb += __shfl_xor(qnb, 16); qnb += __shfl_xor(qnb, 32);
    const float af = expf(bqf + mf - mrf), ab = expf(bqb + mb - mrb);
    const float dnf = fmaxf(fabsf(af * qnf + rsf), expf(-mrf)), dnb = fmaxf(fabsf(ab * qnb + rsb), expf(-mrb));
    const float ivf = 1.f / dnf, ivb = 1.f / dnb, rf = af * ivf, rb = ab * ivb;
#pragma unroll
    for (int t = 0; t < 8; ++t) *(LAS u32x2*)(PW + fr * 136 + 16 * t + 4 * fq) = pack4(sf[t] * ivf + sb[t] * ivb);
    __syncthreads();
    f32x4 hv[8]; zero_acc<8>(hv);
    wave_mm<8>(hv, (const LAS u16*)PW, 136, (const LAS u16*)VT, 136, 128, F.lane);
    zero_acc<8>(sf);
    wave_mm<8>(sf, Qrows, 1024, (const GAS u16*)(F.ST() + (size_t)(h * NCH + c) * 16384), 128, 128, F.lane);
#pragma unroll
    for (int t = 0; t < 8; ++t) hv[t] += sf[t] * rf;
    zero_acc<8>(sb);
    wave_mm<8>(sb, Qrows, 1024, (const GAS u16*)(F.ST() + (size_t)((8 + h) * NCH + c) * 16384), 128, 128, F.lane);
    float s1 = 0.f;
#pragma unroll
    for (int t = 0; t < 8; ++t) { hv[t] += sb[t] * rb; s1 += (hv[t][0] + hv[t][1]) + (hv[t][2] + hv[t][3]); }
    s1 += __shfl_xor(s1, 16); s1 += __shfl_xor(s1, 32);
    const float mean = s1 * (1.f / 128.f); float s2 = 0.f;
#pragma unroll
    for (int t = 0; t < 8; ++t) { hv[t] = hv[t] - mean; s2 += (hv[t][0] * hv[t][0] + hv[t][1] * hv[t][1]) + (hv[t][2] * hv[t][2] + hv[t][3] * hv[t][3]); }
    s2 += __shfl_xor(s2, 16); s2 += __shfl_xor(s2, 32);
    const float rstd = 1.f / sqrtf(s2 * (1.f / 128.f) + LN_EPS);
    const size_t row = (size_t)(r0 + ql);
#pragma unroll
    for (int t = 0; t < 8; ++t) { const int e0 = 128 * h + 16 * t + 4 * fq;
        const f32x4 mg = *(const f32x4*)(F.mh_g() + e0), sk = *(const f32x4*)(F.skip() + e0);
        const f32x4 xc = unpack4(*(const GAS u32x2*)(F.XC() + row * 1024 + e0)), so = unpack4(*(const GAS u32x2*)(F.PROJ() + row * NPJ + OFF_OB + e0));
        *(GAS u32x2*)(F.AB() + row * 2048 + 1024 + e0) = pack4(so * (hv[t] * rstd * mg + sk * xc)); }
    __syncthreads();
}

DI void p8_rows(Frame& F) {
    LAS int* HC = (LAS int*)F.lds; LAS int* HB = HC + 32;
    const float* mod = F.MOD();
    for (int rb = F.bid; rb < T / 64; rb += F.G) {
        if (F.tid < 32) HC[F.tid] = 0;
        __syncthreads();
        for (int i = 0; i < 8; ++i) {
            const int r = 64 * rb + 8 * F.wave + i;
            GAS f32x4* xr = (GAS f32x4*)(F.out() + (size_t)r * D) + F.lane;
            f32x4 v[8]; float s = 0.f;
#pragma unroll
            for (int j = 0; j < 8; ++j) { v[j] = xr[64 * j]; s += (v[j][0] + v[j][1]) + (v[j][2] + v[j][3]); }
            float mean = wave_sum(s) * (1.f / D), s2 = 0.f;
#pragma unroll
            for (int j = 0; j < 8; ++j) { v[j] = v[j] - mean; s2 += (v[j][0] * v[j][0] + v[j][1] * v[j][1]) + (v[j][2] * v[j][2] + v[j][3] * v[j][3]); }
            float rstd = 1.f / sqrtf(wave_sum(s2) * (1.f / D) + LN_EPS);
            s = 0.f;
#pragma unroll
            for (int j = 0; j < 8; ++j) { const f32x4 g = *(const f32x4*)(F.ln1_g() + 4 * F.lane + 256 * j), b = *(const f32x4*)(F.ln1_b() + 4 * F.lane + 256 * j);
                v[j] = v[j] * rstd * g + b; xr[64 * j] = v[j]; s += (v[j][0] + v[j][1]) + (v[j][2] + v[j][3]); }
            mean = wave_sum(s) * (1.f / D); s2 = 0.f;
#pragma unroll
            for (int j = 0; j < 8; ++j) { v[j] = v[j] - mean; s2 += (v[j][0] * v[j][0] + v[j][1] * v[j][1]) + (v[j][2] * v[j][2] + v[j][3] * v[j][3]); }
            rstd = 1.f / sqrtf(wave_sum(s2) * (1.f / D) + LN_EPS);
            GAS u32x2* o = (GAS u32x2*)(F.U2() + (size_t)r * D) + F.lane;
#pragma unroll
            for (int j = 0; j < 8; ++j) { const f32x4 sh = *(const f32x4*)(mod + 3 * 2048 + 4 * F.lane + 256 * j), sc = *(const f32x4*)(mod + 4 * 2048 + 4 * F.lane + 256 * j);
                v[j] = v[j] * rstd * (sc + 1.f) + sh; o[64 * j] = pack4(v[j]); }
            LAS float* LG = (LAS float*)(F.lds + 1024) + F.wave * 64;
#pragma unroll 1
            for (int e = 0; e < 36; ++e) { float p = 0.f;
#pragma unroll
                for (int j = 0; j < 8; ++j) { const f32x4 w = *(const GAS f32x4*)(F.WRT() + e * 2048 + 4 * F.lane + 256 * j); p += (v[j][0] * w[0] + v[j][1] * w[1]) + (v[j][2] * w[2] + v[j][3] * w[3]); }
                p = wave_sum(p) + (e < 4 ? F.b_rg()[e] : F.b_re()[e - 4]);
                if (F.lane == 0) LG[e] = p; }
            LDS_WAIT(); asm volatile("" ::: "memory");
            float lg[4];
#pragma unroll
            for (int g = 0; g < 4; ++g) lg[g] = LG[g];
            int gs = 0; float gm = lg[0];
#pragma unroll
            for (int g = 1; g < 4; ++g) if (lg[g] > gm) { gm = lg[g]; gs = g; }
            float gsum = 0.f;
#pragma unroll
            for (int g = 0; g < 4; ++g) gsum += expf(lg[g] - gm);
            const float pg = 1.f / gsum;
            float el[8];
#pragma unroll
            for (int j = 0; j < 8; ++j) el[j] = LG[4 + 8 * gs + j];
            int i0 = 0; float m0 = el[0];
#pragma unroll
            for (int j = 1; j < 8; ++j) if (el[j] > m0) { m0 = el[j]; i0 = j; }
            int i1 = -1; float m1 = -3.0e38f;
#pragma unroll
            for (int j = 0; j < 8; ++j) if (j != i0 && el[j] > m1) { m1 = el[j]; i1 = j; }
            const float x1 = expf(m1 - m0), w0 = pg / (1.f + x1), w1 = pg * x1 / (1.f + x1);
            if (F.lane == 0) { const int e0 = gs * 8 + i0, e1 = gs * 8 + i1;
                const int sl0 = __hip_atomic_fetch_add(&HC[e0], 1, __ATOMIC_RELAXED, __HIP_MEMORY_SCOPE_WORKGROUP), sl1 = __hip_atomic_fetch_add(&HC[e1], 1, __ATOMIC_RELAXED, __HIP_MEMORY_SCOPE_WORKGROUP);
                F.TOKE()[2 * r] = e0; F.TOKE()[2 * r + 1] = e1; F.TOKW()[2 * r] = w0; F.TOKW()[2 * r + 1] = w1; F.TOKS()[2 * r] = sl0; F.TOKS()[2 * r + 1] = sl1; }
        }
        __syncthreads();
        if (F.tid < 32) HB[F.tid] = (int)__hip_atomic_fetch_add(F.ctl() + CW_CNT + F.tid, (unsigned)HC[F.tid], __ATOMIC_RELAXED, __HIP_MEMORY_SCOPE_AGENT);
        __syncthreads();
        if (F.lane == 0) for (int i = 0; i < 8; ++i) { const int r = 64 * rb + 8 * F.wave + i; F.TOKS()[2 * r] += HB[F.TOKE()[2 * r]]; F.TOKS()[2 * r + 1] += HB[F.TOKE()[2 * r + 1]]; }
        __syncthreads();
    }
}

DI int moe_tables(Frame& F) {
    LAS int* TE = (LAS int*)(F.lds + TILEE_OFF); LAS int* RB = TE + XS_TILES; LAS int* NTp = RB + 32;
    __syncthreads();
    if (F.tid == 0) { int tb = 0; for (int e = 0; e < NE; ++e) { const int cnt = (int)__hip_atomic_load(F.ctl() + CW_CNT + e, __ATOMIC_RELAXED, __HIP_MEMORY_SCOPE_AGENT); int nt = (cnt + 255) >> 8; if (tb + nt > XS_TILES) nt = XS_TILES - tb;
            RB[e] = tb * 256; for (int i = 0; i < nt; ++i) TE[tb + i] = e; tb += nt; } NTp[0] = tb; }
    __syncthreads();
    return NTp[0];
}
DI void p9_gather(Frame& F) {
    (void)moe_tables(F);
    const LAS int* RB = (const LAS int*)(F.lds + TILEE_OFF) + XS_TILES;
    const int gw = F.bid * 8 + F.wave, NGW = F.G * 8;
    for (int a = gw; a < 2 * T; a += NGW) { const int r = a >> 1; const int e = F.TOKE()[a]; const int pos = RB[e] + F.TOKS()[a];
        if (F.lane == 0) F.TOKP()[a] = pos;
        const GAS u32x4* src = (const GAS u32x4*)(F.U2() + (size_t)r * D) + F.lane; GAS u32x4* dst = (GAS u32x4*)(F.XS() + (size_t)pos * D) + F.lane;
#pragma unroll
        for (int j = 0; j < 4; ++j) dst[64 * j] = src[64 * j]; }
}
DI void p12_rows(Frame& F) {
    const int gw = F.bid * 8 + F.wave, NGW = F.G * 8; const float* g2 = F.MOD() + 5 * 2048;
    for (int r = gw; r < T; r += NGW) {
        GAS f32x4* xr = (GAS f32x4*)(F.out() + (size_t)r * D) + F.lane;
        const int p0 = F.TOKP()[2 * r], p1 = F.TOKP()[2 * r + 1]; const float w0 = F.TOKW()[2 * r], w1 = F.TOKW()[2 * r + 1];
        const GAS u32x2* y0 = (const GAS u32x2*)(F.YS() + (size_t)p0 * D) + F.lane; const GAS u32x2* y1 = (const GAS u32x2*)(F.YS() + (size_t)p1 * D) + F.lane;
        f32x4 v[8]; float s = 0.f;
#pragma unroll
        for (int j = 0; j < 8; ++j) { const f32x4 f = unpack4(y0[64 * j]) * w0 + unpack4(y1[64 * j]) * w1; const f32x4 g = *(const f32x4*)(g2 + 4 * F.lane + 256 * j);
            v[j] = xr[64 * j] * ALPHA + g * f; s += (v[j][0] + v[j][1]) + (v[j][2] + v[j][3]); }
        const float mean = wave_sum(s) * (1.f / D); float s2 = 0.f;
#pragma unroll
        for (int j = 0; j < 8; ++j) { v[j] = v[j] - mean; s2 += (v[j][0] * v[j][0] + v[j][1] * v[j][1]) + (v[j][2] * v[j][2] + v[j][3] * v[j][3]); }
        const float rstd = 1.f / sqrtf(wave_sum(s2) * (1.f / D) + LN_EPS);
#pragma unroll
        for (int j = 0; j < 8; ++j) { const f32x4 g = *(const f32x4*)(F.ln2_g() + 4 * F.lane + 256 * j), b = *(const f32x4*)(F.ln2_b() + 4 * F.lane + 256 * j); xr[64 * j] = v[j] * rstd * g + b; }
    }
}

__global__ void __launch_bounds__(512, 2) mk_fwd(Args args) {
    extern __shared__ __attribute__((aligned(16))) unsigned char lds[];
    Frame F;
    F.lds = (LAS unsigned char*)lds;
    F.tid = threadIdx.x; F.lane = F.tid & 63; F.wave = __builtin_amdgcn_readfirstlane(F.tid >> 6); F.bid = blockIdx.x; F.G = gridDim.x;
    F.a = &args; F.ws = args.ws;
    for (int u = F.tid; u < (LDS_BYTES - LDSCTL_OFF) / 4; u += 512) ((LAS unsigned*)(F.lds + LDSCTL_OFF))[u] = 0u;
    __syncthreads();
    const int lo = args.ph_lo, hi = args.ph_hi;
    const bool fused = (hi - lo) > 1;
    XcdBarrier bar; bar.bar = F.ctl() + CW_BAR; bar.x = 0; bar.st = nullptr;
    if (fused) bar = xcd_barrier_post(F.ctl() + CW_BAR, (volatile LAS unsigned*)(F.lds + MISC_OFF));
#ifndef PH_MASK
#define PH_MASK 0x1fff
#endif
#define IN(k) (((PH_MASK >> (k)) & 1) && lo <= (k) && (k) < hi)
#define SEAM(k) do { if (IN(k) && IN((k) + 1)) xcd_barrier(bar); } while (0)

    if (IN(0)) { p0_prologue(F); } SEAM(0);
    if (IN(1)) { p1_rows(F); } SEAM(1);
    if (IN(2)) {
        pg8::SchedGrid<0> S; S.nM = TR / 256; S.nN = NPAD / 256; S.nwg = S.nM * S.nN; S.G = F.G; S.c = F.bid; S.A = (const char*)F.U(); S.B = (const char*)F.WIN(); S.a_tile = (size_t)256 * 2048 * 2; S.b_tile = (size_t)256 * 2048 * 2; S.a_split = 0; S.b_split = 0;
        pg8::EpiProj E{F.PROJ(), F.GATES(), F.b_in()};
        pg8::gemm_phase<pg8::EpiProj, pg8::SchedGrid<0>, true>(F.lds, 2048, 2048, 2048, S, E);
    } SEAM(2);
    if (IN(3)) {
        for (int u = F.bid; u < 128 + NCH * 8; u += F.G) { if (u < 128) gmlp_unit(F, u); else { const int v = u - 128; mprep_unit(F, v >> 3, v & 7); } }
    } SEAM(3);
    if (IN(4)) { for (int u = F.bid; u < 256; u += F.G) scan_item(F, u >> 4, u & 15); } SEAM(4);
    if (IN(5)) { for (int u = F.bid; u < 1024; u += F.G) x3_unit(F, u >> 3, u & 7); } SEAM(5);
    if (IN(6)) {
        pg8::SchedGrid<1> S; S.nM = T / 256; S.nN = 8; S.nwg = S.nM * S.nN; S.G = F.G; S.c = F.bid; S.A = (const char*)F.AB(); S.B = (const char*)F.PAB(); S.a_tile = (size_t)256 * 2048 * 2; S.b_tile = (size_t)256 * 2048 * 2; S.a_split = 2048; S.b_split = 2048;
        pg8::EpiMerge E{F.Z(), F.PROJ()};
        pg8::gemm_phase<pg8::EpiMerge, pg8::SchedGrid<1>, true>(F.lds, 1024, 2048, 2048, S, E);
    } SEAM(6);
    if (IN(7)) {
        pg8::SchedGrid<0> S; S.nM = T / 256; S.nN = 8; S.nwg = S.nM * S.nN; S.G = F.G; S.c = F.bid; S.A = (const char*)F.Z(); S.B = (const char*)F.WO(); S.a_tile = (size_t)256 * 2048 * 2; S.b_tile = (size_t)256 * 2048 * 2; S.a_split = 0; S.b_split = 0;
        pg8::EpiWo E{F.x(), F.out(), F.MOD() + 2 * 2048};
        pg8::gemm_phase<pg8::EpiWo, pg8::SchedGrid<0>, true>(F.lds, 2048, 2048, 2048, S, E);
    } SEAM(7);
    if (IN(8)) { p8_rows(F); } SEAM(8);
    if (IN(9)) { p9_gather(F); } SEAM(9);
    if (IN(10)) {
        const int NT = moe_tables(F);
        pg8::SchedMoe S; S.nwg = NT * 8; S.G = F.G; S.c = F.bid; S.tile_e = (const LAS int*)(F.lds + TILEE_OFF); S.A = (const char*)F.XS(); S.B = (const char*)F.W13(); S.a_tile = (size_t)256 * 2048 * 2; S.b_exp = (size_t)2048 * 2048 * 2; S.b_tile = (size_t)256 * 2048 * 2;
        pg8::EpiMoeUp E{F.H()};
        pg8::gemm_phase<pg8::EpiMoeUp, pg8::SchedMoe, true>(F.lds, 2048, 2048, 2048, S, E);
    } SEAM(10);
    if (IN(11)) {
        const int NT = moe_tables(F);
        pg8::SchedMoe S; S.nwg = NT * 8; S.G = F.G; S.c = F.bid; S.tile_e = (const LAS int*)(F.lds + TILEE_OFF); S.A = (const char*)F.H(); S.B = (const char*)F.W2(); S.a_tile = (size_t)256 * 1024 * 2; S.b_exp = (size_t)2048 * 1024 * 2; S.b_tile = (size_t)256 * 1024 * 2;
        pg8::EpiMoeDown E{F.YS()};
        pg8::gemm_phase<pg8::EpiMoeDown, pg8::SchedMoe, true>(F.lds, 1024, 1024, 1024, S, E);
    } SEAM(11);
    if (IN(12)) { p12_rows(F); }
#undef IN
#undef SEAM
}

extern "C" void kernel_launch(void* const* d_in, const int* in_sizes, int n_in, void* d_out, int out_size, void* d_ws, size_t ws_size, hipStream_t stream) {
    static int grid = 0;
    if (grid == 0) {
        if (n_in != 32 || out_size != T * D || ws_size < WS_END) { fprintf(stderr, "kernel_launch: unexpected shapes (n_in %d, out %d, ws %zu; need ws >= %zu); nothing launched\n", n_in, out_size, ws_size, (size_t)WS_END); grid = -1; return; }
        int dev = 0, cus = 0, per_cu = 0;
        if (hipGetDevice(&dev) != hipSuccess || hipDeviceGetAttribute(&cus, hipDeviceAttributeMultiprocessorCount, dev) != hipSuccess) { grid = -1; return; }
        if (hipFuncSetAttribute((const void*)mk_fwd, hipFuncAttributeMaxDynamicSharedMemorySize, LDS_BYTES) != hipSuccess) { fprintf(stderr, "kernel_launch: hipFuncSetAttribute failed\n"); grid = -1; return; }
        if (hipOccupancyMaxActiveBlocksPerMultiprocessor(&per_cu, (const void*)mk_fwd, 512, LDS_BYTES) != hipSuccess || per_cu < 1) { fprintf(stderr, "kernel_launch: occupancy query reports %d\n", per_cu); }
        (void)hipGetLastError();
        grid = cus;
    }
    if (grid < 0) return;
    (void)hipMemsetAsync((char*)d_ws + WS_CTL, 0, CTL_ZERO_BYTES, stream);
    Args a{};
    for (int i = 0; i < 32; ++i) a.in[i] = (const float*)d_in[i];
    a.outp = (float*)d_out; a.ws = (unsigned char*)d_ws;
    if (MK_N_LAUNCHES == 1) { a.ph_lo = 0; a.ph_hi = NPHASE; hipLaunchKernelGGL(mk_fwd, dim3(grid), dim3(512), LDS_BYTES, stream, a); }
    else for (int p = 0; p < NPHASE; ++p) { a.ph_lo = p; a.ph_hi = p + 1; hipLaunchKernelGGL(mk_fwd, dim3(grid), dim3(512), LDS_BYTES, stream, a); }
}
```

```cpp
#include <hip/hip_runtime.h>
#include <cstdio>
#include <cstdint>

#ifndef MK_N_LAUNCHES
#define MK_N_LAUNCHES 1
#endif

#define GAS __attribute__((address_space(1)))
#define LAS __attribute__((address_space(3)))
#define DI __device__ __forceinline__
typedef unsigned short u16;
typedef short bf16x8 __attribute__((ext_vector_type(8)));
typedef float f32x4 __attribute__((ext_vector_type(4)));
typedef float f32x2 __attribute__((ext_vector_type(2)));
typedef unsigned u32x4 __attribute__((ext_vector_type(4)));
typedef unsigned u32x2 __attribute__((ext_vector_type(2)));

constexpr int T = 16384, TC = 256, TR = T + TC, D = 2048, DIN = 9248, NPJ = 9216, NPAD = 9472;
constexpr int OFF_UA = 0, OFF_VA = 1024, OFF_XM = 2048, OFF_VB = 3072, OFF_OB = 4096, OFF_GA = 5120, OFF_GB = 7168, OFF_GATES = 9216;
constexpr int NCH = 130;
constexpr int NE = 32, DE = 1024;
constexpr int XS_TILES = 160;
constexpr float LN_EPS = 1e-5f, NEGF = -1e30f, ALPHA = 1.189207115002721f;
constexpr int NPHASE = 13;

constexpr size_t MiB = 1u << 20;
constexpr size_t WS_CTL = 0, CTL_ZERO_BYTES = 1 * MiB;
constexpr size_t WS_MOD = 1 * MiB;
constexpr size_t WS_WRT = 1 * MiB + 512 * 1024;
constexpr size_t WS_WQK = 2 * MiB;
constexpr size_t WS_WSB = 2 * MiB + 512 * 1024;
constexpr size_t WS_GB = 3 * MiB;
constexpr size_t WS_NL = 6 * MiB;
constexpr size_t WS_SC = 7 * MiB + 512 * 1024;
constexpr size_t WS_TOKE = 8 * MiB;
constexpr size_t WS_TOKW = 8 * MiB + 128 * 1024;
constexpr size_t WS_TOKS = 8 * MiB + 256 * 1024;
constexpr size_t WS_TOKP = 8 * MiB + 384 * 1024;
constexpr size_t WS_GATES = 9 * MiB;
constexpr size_t WS_WIN = 16 * MiB;
constexpr size_t WS_PAB = 53 * MiB;
constexpr size_t WS_WO = 61 * MiB;
constexpr size_t WS_W13 = 69 * MiB;
constexpr size_t WS_W2 = 325 * MiB;
constexpr size_t WS_R1 = 453 * MiB;
constexpr size_t WS_XS = WS_R1, WS_H = WS_R1 + 160 * MiB;
constexpr size_t WS_R2 = 746 * MiB;
constexpr size_t WS_R3 = 811 * MiB;
constexpr size_t WS_R4 = 875 * MiB;
constexpr size_t WS_R5 = 940 * MiB;
constexpr size_t WS_YS = WS_R2;
constexpr size_t WS_END = 1004 * MiB;
static_assert(WS_R1 + (size_t)TR * NPJ * 2 <= WS_R2 && WS_H + (size_t)XS_TILES * 256 * 1024 * 2 <= WS_R2, "R1");
static_assert(WS_R2 + (size_t)TR * 2048 * 2 <= WS_R3 && WS_R3 + (size_t)T * 2048 * 2 <= WS_R4 && WS_R4 + (size_t)16 * NCH * 16384 * 2 <= WS_R5 && WS_R5 + (size_t)T * 2048 * 2 <= WS_END, "R2-5");
static_assert(WS_YS + (size_t)XS_TILES * 256 * 2048 * 2 <= WS_R5, "YS");
static_assert(WS_WIN + (size_t)NPAD * 2048 * 2 <= WS_PAB && WS_W13 + (size_t)32 * 2048 * 2048 * 2 <= WS_W2 && WS_W2 + (size_t)32 * 2048 * 1024 * 2 <= WS_R1, "weights");
static_assert(WS_GB + (size_t)8 * TR * 16 <= WS_NL && WS_NL + (size_t)16 * NCH * 128 * 4 <= WS_SC && WS_GATES + (size_t)TR * 32 * 4 <= WS_WIN, "small");
constexpr int CW_CNT = 64;
constexpr int CW_BAR = 4096;

constexpr int RING_BYTES = 131072;
constexpr int LDSCTL_OFF = 147456;
constexpr int MISC_OFF = LDSCTL_OFF + 64;
constexpr int TILEE_OFF = LDSCTL_OFF + 256;
constexpr int LDS_BYTES = 149504;

DI unsigned cvt_pk_bf16(float lo, float hi) { unsigned r; asm volatile("v_cvt_pk_bf16_f32 %0, %1, %2" : "=v"(r) : "v"(lo), "v"(hi)); return r; }
DI unsigned f2bf(float f) { return cvt_pk_bf16(f, 0.f) & 0xffffu; }
DI float bflo(unsigned w) { return __uint_as_float(w << 16); }
DI float bfhi(unsigned w) { return __uint_as_float(w & 0xffff0000u); }
DI u32x2 pack4(f32x4 v) { u32x2 o; o.x = cvt_pk_bf16(v[0], v[1]); o.y = cvt_pk_bf16(v[2], v[3]); return o; }
DI f32x4 unpack4(u32x2 w) { return (f32x4){bflo(w.x), bfhi(w.x), bflo(w.y), bfhi(w.y)}; }
DI float sigmoid_fast(float x) { return __builtin_amdgcn_rcpf(1.f + __builtin_amdgcn_exp2f(-1.4426950408889634f * x)); }
DI float gelu_tanh_fast(float x) { const float y = 1.5957691216057308f * (x + 0.044715f * x * x * x); return x * sigmoid_fast(y); }
DI float logsig(float x) { return x < 0.f ? x - log1pf(expf(x)) : -log1pf(expf(-x)); }
DI float wave_sum(float v) {
#pragma unroll
    for (int o = 1; o < 64; o <<= 1) v += __shfl_xor(v, o);
    return v;
}
DI float wave_max(float v) {
#pragma unroll
    for (int o = 1; o < 64; o <<= 1) v = fmaxf(v, __shfl_xor(v, o));
    return v;
}
#define LDS_WAIT() asm volatile("s_waitcnt lgkmcnt(0)" ::: "memory")

namespace pg8 {
constexpr int BM = 256, BK = 64, HALF = 128, HTB = HALF * BK * 2, STAGE_BYTES = 8 * HTB, NXCD = 8, WGM = 8;
__host__ __device__ __forceinline__ int lds_byte(int r, int c) { const int st = (r >> 4) * 2 + (c >> 5), rr = r & 15, cc = c & 31, ob = rr * 64 + cc * 2; return st * 1024 + (ob ^ (((ob >> 9) & 1) << 5)); }
__host__ __device__ __forceinline__ void stage_rc(int b, int& R, int& C) { const int st = b / 1024, sb = b % 1024, swz = sb ^ (((sb >> 9) & 1) << 5); R = (st >> 1) * 16 + swz / 64; C = (st & 1) * 32 + (swz % 64) / 2; }
__host__ __device__ __forceinline__ int perm32(int rho) { const int n = rho >> 4, i = rho & 15; return 8 * (i >> 2) + 4 * n + (i & 3); }
struct Unit { int pm, pn, ex; };
DI int xcd_remap(int wgid, int nwg) { const int q = nwg / NXCD, r = nwg % NXCD, xcd = wgid % NXCD, off = wgid / NXCD; return (xcd < r ? xcd * (q + 1) : r * (q + 1) + (xcd - r) * q) + off; }

template <int SPLIT> struct SchedGrid {
    int nM, nN, nwg, G, c; const char* A; const char* B; size_t a_tile, b_tile, a_split, b_split;
    DI bool next(int i, Unit& u) const {
        const int j = SPLIT ? (i >> 1) : i; u.ex = SPLIT ? (i & 1) : 0;
        const long L = (long)j * G + c; if (L >= nwg) return false;
        const int wgid = xcd_remap((int)L, nwg);
        const int nig = WGM * nN, gid = wgid / nig, fm = gid * WGM, gsz = (nM - fm) < WGM ? (nM - fm) : WGM;
        u.pm = fm + ((wgid % nig) % gsz); u.pn = (wgid % nig) / gsz; return true;
    }
    DI const char* a_base(const Unit& u) const { return A + (size_t)u.pm * a_tile + (size_t)u.ex * a_split; }
    DI const char* b_base(const Unit& u) const { return B + (size_t)u.pn * b_tile + (size_t)u.ex * b_split; }
    DI void a_ready(const Unit&) const {}
    DI void done(const Unit&) const {}
};
struct SchedMoe {
    int nwg, G, c; const LAS int* tile_e; const char* A; const char* B; size_t a_tile, b_exp, b_tile;
    DI bool next(int i, Unit& u) const {
        const long L = (long)i * G + c; if (L >= nwg) return false;
        const int w = xcd_remap((int)L, nwg); u.pm = w >> 3; u.pn = w & 7; u.ex = tile_e[u.pm]; return true;
    }
    DI const char* a_base(const Unit& u) const { return A + (size_t)u.pm * a_tile; }
    DI const char* b_base(const Unit& u) const { return B + (size_t)u.ex * b_exp + (size_t)u.pn * b_tile; }
    DI void a_ready(const Unit&) const {}
    DI void done(const Unit&) const {}
};

template <class Epi, class Sched, bool ALIGN_EPI>
DI void gemm_phase(LAS unsigned char* lds, const int K, const int lda, const int ldb, const Sched& S, const Epi& E) {
    const int tid = threadIdx.x, wid = __builtin_amdgcn_readfirstlane(tid >> 6), lane = tid & 63, wr = wid >> 2, wc = wid & 3, fr = lane & 15, fq = lane >> 4;
    const int nt = K / BK;
    unsigned voffA[2], voffB[2];
#pragma unroll
    for (int i = 0; i < 2; ++i) { int R, C; stage_rc(tid * 16 + i * 8192, R, C); const int Rb = Epi::PERM ? ((R & ~31) + perm32(R & 31)) : R;
        voffA[i] = (unsigned)(R * lda + C) * 2u; voffB[i] = (unsigned)(Rb * ldb + C) * 2u; }
    const size_t kstep = (size_t)(BK * 2);
    const size_t hstepA = (size_t)HALF * lda * 2, hstepB = (size_t)HALF * ldb * 2;
    const unsigned ldsw = (unsigned)wid * 1024u;
    const int aoff = lds_byte(wr * 64 + fr, fq * 8), boff = lds_byte(wc * 32 + fr, fq * 8);
#define PG8_SA(b, h) (((b) * 2 + (h)) * HTB)
#define PG8_SB(b, h) ((4 + (b) * 2 + (h)) * HTB)
#define PG8_STAGE(bufoff, gbase, voff) do { _Pragma("unroll") for (int _i = 0; _i < 2; ++_i) \
        __builtin_amdgcn_global_load_lds((const unsigned*)((const char*)(gbase) + (voff)[_i]), (LAS unsigned*)(lds + (bufoff) + ldsw + _i * 8192), 16, 0, 0); } while (0)
#define PG8_LDA(dst, b, h) do { _Pragma("unroll") for (int m = 0; m < 4; ++m) _Pragma("unroll") for (int k = 0; k < 2; ++k) dst[m][k] = *(const LAS bf16x8*)(lds + PG8_SA(b, h) + aoff + m * 2048 + k * 1024); } while (0)
#define PG8_LDB(dst, b, h) do { _Pragma("unroll") for (int n = 0; n < 2; ++n) _Pragma("unroll") for (int k = 0; k < 2; ++k) dst[n][k] = *(const LAS bf16x8*)(lds + PG8_SB(b, h) + boff + n * 2048 + k * 1024); } while (0)
#define PG8_MMA(ai, bj, At, Bt) do { __builtin_amdgcn_s_setprio(1); _Pragma("unroll") for (int m = 0; m < 4; ++m) _Pragma("unroll") for (int n = 0; n < 2; ++n) _Pragma("unroll") for (int k = 0; k < 2; ++k) \
        acc[ai][bj][m][n] = __builtin_amdgcn_mfma_f32_16x16x32_bf16(Bt[n][k], At[m][k], acc[ai][bj][m][n], 0, 0, 0); __builtin_amdgcn_s_setprio(0); } while (0)
#define PG8_WAIT_V(n) asm volatile("s_waitcnt vmcnt(" #n ")" ::: "memory")
#define PG8_WAIT_L(n) asm volatile("s_waitcnt lgkmcnt(" #n ")" ::: "memory")
#define PG8_BAR __builtin_amdgcn_s_barrier()
#define PG8_SCHED __builtin_amdgcn_sched_barrier(0)
    Unit cur, nxt; int ui = 0;
    if (!S.next(0, cur)) return;
    f32x4 acc[2][2][4][2];
#pragma unroll
    for (int a = 0; a < 2; ++a)
#pragma unroll
        for (int b = 0; b < 2; ++b)
#pragma unroll
            for (int m = 0; m < 4; ++m)
#pragma unroll
                for (int n = 0; n < 2; ++n) acc[a][b][m][n] = (f32x4){0.f, 0.f, 0.f, 0.f};
    bf16x8 At[4][2], B0[2][2], B1[2][2];
    const char* cA = S.a_base(cur); const char* cB = S.b_base(cur);
    S.a_ready(cur);
    PG8_STAGE(PG8_SB(0, 0), cB, voffB); PG8_STAGE(PG8_SB(0, 1), cB + hstepB, voffB); PG8_STAGE(PG8_SA(0, 0), cA, voffA); PG8_STAGE(PG8_SA(0, 1), cA + hstepA, voffA);
    if (wr == 1) PG8_BAR;
    PG8_WAIT_V(2); PG8_BAR;
    PG8_STAGE(PG8_SB(1, 0), cB + kstep, voffB); PG8_STAGE(PG8_SA(1, 0), cA + kstep, voffA); PG8_STAGE(PG8_SB(1, 1), cB + hstepB + kstep, voffB);
    PG8_WAIT_V(6); PG8_BAR;
    for (;;) {
        const bool has_next = S.next(ui + 1, nxt);
        const char* nA = has_next ? S.a_base(nxt) : cA; const char* nB = has_next ? S.b_base(nxt) : cB;
        for (int t = 0; t < nt; t += 2) {
            const bool last = (t == nt - 2);
            const char* a1 = cA + (size_t)(t + 1) * kstep;
            const char* a2 = last ? nA : cA + (size_t)(t + 2) * kstep; const char* b2 = last ? nB : cB + (size_t)(t + 2) * kstep;
            const char* a3 = a2 + kstep; const char* b3 = b2 + kstep;
            if (last && has_next) S.a_ready(nxt);
            PG8_LDB(B0, 0, 0); PG8_LDB(B1, 0, 1); PG8_SCHED; PG8_LDA(At, 0, 0); PG8_STAGE(PG8_SA(1, 1), a1 + hstepA, voffA);
            PG8_WAIT_V(8); PG8_WAIT_L(0); PG8_BAR; PG8_MMA(0, 0, At, B0); PG8_MMA(0, 1, At, B1); PG8_BAR; PG8_SCHED;
            PG8_LDA(At, 0, 1); PG8_STAGE(PG8_SB(0, 0), b2, voffB); PG8_STAGE(PG8_SB(0, 1), b2 + hstepB, voffB); PG8_STAGE(PG8_SA(0, 0), a2, voffA);
            PG8_WAIT_V(8); PG8_WAIT_L(0); PG8_BAR; PG8_MMA(1, 0, At, B0); PG8_MMA(1, 1, At, B1); PG8_BAR; PG8_SCHED;
            PG8_LDB(B0, 1, 0); PG8_LDB(B1, 1, 1); PG8_SCHED; PG8_LDA(At, 1, 0); PG8_STAGE(PG8_SA(0, 1), a2 + hstepA, voffA);
            PG8_WAIT_V(8); PG8_WAIT_L(0); PG8_BAR; PG8_MMA(0, 0, At, B0); PG8_MMA(0, 1, At, B1); PG8_BAR; PG8_SCHED;
            PG8_LDA(At, 1, 1); PG8_STAGE(PG8_SB(1, 0), b3, voffB); PG8_STAGE(PG8_SB(1, 1), b3 + hstepB, voffB); PG8_STAGE(PG8_SA(1, 0), a3, voffA);
            PG8_WAIT_V(8); PG8_WAIT_L(0); PG8_BAR; PG8_MMA(1, 0, At, B0); PG8_MMA(1, 1, At, B1); PG8_BAR; PG8_SCHED;
        }
        if constexpr (ALIGN_EPI) { if (wr == 0) PG8_BAR; }
        E(acc, cur, wr, wc, fr, fq); S.done(cur);
        if (!has_next) break;
#pragma unroll
        for (int a = 0; a < 2; ++a)
#pragma unroll
            for (int b = 0; b < 2; ++b)
#pragma unroll
                for (int m = 0; m < 4; ++m)
#pragma unroll
                    for (int n = 0; n < 2; ++n) acc[a][b][m][n] = (f32x4){0.f, 0.f, 0.f, 0.f};
        cur = nxt; cA = nA; cB = nB; ++ui;
        if constexpr (ALIGN_EPI) { if (wr == 1) PG8_BAR; }
    }
    PG8_WAIT_V(0);
    if constexpr (!ALIGN_EPI) { if (wr == 0) PG8_BAR; }
    PG8_BAR;
#undef PG8_SA
#undef PG8_SB
#undef PG8_STAGE
#undef PG8_LDA
#undef PG8_LDB
#undef PG8_MMA
#undef PG8_WAIT_V
#undef PG8_WAIT_L
#undef PG8_BAR
#undef PG8_SCHED
}

struct EpiProj {
    static constexpr bool PERM = true;
    u16* P; float* gates; const float* bias;
    DI void operator()(const f32x4 (&acc)[2][2][4][2], const Unit& u, int wr, int wc, int fr, int fq) const {
        const int row0 = u.pm * BM + wr * 64 + fr;
        if (u.pn == 36) {
            if (wc == 0) {
                const int c0 = 8 * fq; const f32x4 b0 = *(const f32x4*)(bias + OFF_GATES + c0), b1 = *(const f32x4*)(bias + OFF_GATES + c0 + 4);
#pragma unroll
                for (int ai = 0; ai < 2; ++ai)
#pragma unroll
                    for (int m = 0; m < 4; ++m) { float* g = gates + (size_t)(row0 + ai * HALF + m * 16) * 32 + c0;
                        *(f32x4*)g = acc[ai][0][m][0] + b0; *(f32x4*)(g + 4) = acc[ai][0][m][1] + b1; }
            }
            return;
        }
        const int seg = u.pn >> 2; const int mode = (seg <= 1) ? 1 : ((seg <= 3) ? 0 : 2);
        const int col0 = u.pn * BM + wc * 32 + 8 * fq;
        f32x4 bv[2][2];
#pragma unroll
        for (int bj = 0; bj < 2; ++bj)
#pragma unroll
            for (int n = 0; n < 2; ++n) bv[bj][n] = *(const f32x4*)(bias + col0 + bj * HALF + 4 * n);
#pragma unroll
        for (int ai = 0; ai < 2; ++ai)
#pragma unroll
            for (int m = 0; m < 4; ++m) { u16* rowp = P + (size_t)(row0 + ai * HALF + m * 16) * NPJ + col0;
#pragma unroll
                for (int bj = 0; bj < 2; ++bj) { f32x4 v0 = acc[ai][bj][m][0] + bv[bj][0], v1 = acc[ai][bj][m][1] + bv[bj][1];
                    if (mode == 1) {
#pragma unroll
                        for (int j = 0; j < 4; ++j) { v0[j] = gelu_tanh_fast(v0[j]); v1[j] = gelu_tanh_fast(v1[j]); } }
                    else if (mode == 2) {
#pragma unroll
                        for (int j = 0; j < 4; ++j) { v0[j] = sigmoid_fast(v0[j]); v1[j] = sigmoid_fast(v1[j]); } }
                    u32x4 w; w.x = cvt_pk_bf16(v0[0], v0[1]); w.y = cvt_pk_bf16(v0[2], v0[3]); w.z = cvt_pk_bf16(v1[0], v1[1]); w.w = cvt_pk_bf16(v1[2], v1[3]);
                    *(u32x4*)(rowp + bj * HALF) = w; } }
    }
};
struct EpiMerge {
    static constexpr bool PERM = true;
    u16* Z; const u16* P;
    DI void operator()(const f32x4 (&acc)[2][2][4][2], const Unit& u, int wr, int wc, int fr, int fq) const {
        const int row0 = u.pm * BM + wr * 64 + fr, col0 = u.pn * BM + wc * 32 + 8 * fq, goff = u.ex ? OFF_GB : OFF_GA;
#pragma unroll
        for (int ai = 0; ai < 2; ++ai) {
            u32x4 gq[4][2], zq[4][2];
#pragma unroll
            for (int m = 0; m < 4; ++m) { const size_t row = (size_t)(row0 + ai * HALF + m * 16); const u16* zp = Z + row * 2048 + col0; const u16* gp = P + row * NPJ + goff + col0;
#pragma unroll
                for (int bj = 0; bj < 2; ++bj) { gq[m][bj] = *(const u32x4*)(gp + bj * HALF); zq[m][bj] = u.ex ? *(const u32x4*)(zp + bj * HALF) : (u32x4){0u, 0u, 0u, 0u}; } }
#pragma unroll
            for (int m = 0; m < 4; ++m) { const size_t row = (size_t)(row0 + ai * HALF + m * 16); u16* zp = Z + row * 2048 + col0;
#pragma unroll
                for (int bj = 0; bj < 2; ++bj) { const u32x4 g = gq[m][bj], z = zq[m][bj];
                    const f32x4 v0 = acc[ai][bj][m][0] * (f32x4){bflo(g.x), bfhi(g.x), bflo(g.y), bfhi(g.y)} + (f32x4){bflo(z.x), bfhi(z.x), bflo(z.y), bfhi(z.y)};
                    const f32x4 v1 = acc[ai][bj][m][1] * (f32x4){bflo(g.z), bfhi(g.z), bflo(g.w), bfhi(g.w)} + (f32x4){bflo(z.z), bfhi(z.z), bflo(z.w), bfhi(z.w)};
                    u32x4 w; w.x = cvt_pk_bf16(v0[0], v0[1]); w.y = cvt_pk_bf16(v0[2], v0[3]); w.z = cvt_pk_bf16(v1[0], v1[1]); w.w = cvt_pk_bf16(v1[2], v1[3]);
                    *(u32x4*)(zp + bj * HALF) = w; } }
        }
    }
};
struct EpiWo {
    static constexpr bool PERM = false;
    const float* x; float* R; const float* g1;
    DI void operator()(const f32x4 (&acc)[2][2][4][2], const Unit& u, int wr, int wc, int fr, int fq) const {
        const int row0 = u.pm * BM + wr * 64 + fr, col0 = u.pn * BM + wc * 32 + 4 * fq;
        f32x4 gv[2][2];
#pragma unroll
        for (int bj = 0; bj < 2; ++bj)
#pragma unroll
            for (int n = 0; n < 2; ++n) gv[bj][n] = *(const f32x4*)(g1 + col0 + bj * HALF + n * 16);
#pragma unroll
        for (int ai = 0; ai < 2; ++ai) {
            f32x4 xs[4][2][2];
#pragma unroll
            for (int m = 0; m < 4; ++m) { const size_t off = (size_t)(row0 + ai * HALF + m * 16) * 2048 + col0;
#pragma unroll
                for (int bj = 0; bj < 2; ++bj)
#pragma unroll
                    for (int n = 0; n < 2; ++n) xs[m][bj][n] = *(const f32x4*)(x + off + bj * HALF + n * 16); }
#pragma unroll
            for (int m = 0; m < 4; ++m) { const size_t off = (size_t)(row0 + ai * HALF + m * 16) * 2048 + col0;
#pragma unroll
                for (int bj = 0; bj < 2; ++bj)
#pragma unroll
                    for (int n = 0; n < 2; ++n) *(f32x4*)(R + off + bj * HALF + n * 16) = xs[m][bj][n] * ALPHA + gv[bj][n] * acc[ai][bj][m][n]; }
        }
    }
};
struct EpiMoeUp {
    static constexpr bool PERM = true;
    u16* H;
    DI void operator()(const f32x4 (&acc)[2][2][4][2], const Unit& u, int wr, int wc, int fr, int fq) const {
        const int row0 = u.pm * BM + wr * 64 + fr, col0 = u.pn * HALF + wc * 32 + 8 * fq;
#pragma unroll
        for (int ai = 0; ai < 2; ++ai)
#pragma unroll
            for (int m = 0; m < 4; ++m) { u16* hp = H + (size_t)(row0 + ai * HALF + m * 16) * DE + col0; f32x4 o[2];
#pragma unroll
                for (int n = 0; n < 2; ++n)
#pragma unroll
                    for (int j = 0; j < 4; ++j) { const float a = acc[ai][0][m][n][j]; o[n][j] = a * sigmoid_fast(a) * acc[ai][1][m][n][j]; }
                u32x4 w; w.x = cvt_pk_bf16(o[0][0], o[0][1]); w.y = cvt_pk_bf16(o[0][2], o[0][3]); w.z = cvt_pk_bf16(o[1][0], o[1][1]); w.w = cvt_pk_bf16(o[1][2], o[1][3]);
                *(u32x4*)hp = w; }
    }
};
struct EpiMoeDown {
    static constexpr bool PERM = true;
    u16* Y;
    DI void operator()(const f32x4 (&acc)[2][2][4][2], const Unit& u, int wr, int wc, int fr, int fq) const {
        const int row0 = u.pm * BM + wr * 64 + fr, col0 = u.pn * BM + wc * 32 + 8 * fq;
#pragma unroll
        for (int ai = 0; ai < 2; ++ai)
#pragma unroll
            for (int m = 0; m < 4; ++m) { u16* yp = Y + (size_t)(row0 + ai * HALF + m * 16) * 2048 + col0;
#pragma unroll
                for (int bj = 0; bj < 2; ++bj) { const f32x4 v0 = acc[ai][bj][m][0], v1 = acc[ai][bj][m][1];
                    u32x4 w; w.x = cvt_pk_bf16(v0[0], v0[1]); w.y = cvt_pk_bf16(v0[2], v0[3]); w.z = cvt_pk_bf16(v1[0], v1[1]); w.w = cvt_pk_bf16(v1[2], v1[3]);
                    *(u32x4*)(yp + bj * HALF) = w; } }
    }
};
}

#define XB_TMO      128
#define XB_XCNT(j)  (256  + 64 * (j))
#define XB_XSUB(j)  (1280 + 64 * (j))
#define XB_XGEN(j)  (2304 + 64 * (j))
#define XB_TOP      3328
#define XB_TOPGEN   3392
#define XCD_BAR_WORDS 3456
#define XB_SPIN_CAP (1u << 18)
__device__ __forceinline__ unsigned xb_ld(unsigned* p)              { return __hip_atomic_load(p, __ATOMIC_RELAXED, __HIP_MEMORY_SCOPE_AGENT); }
__device__ __forceinline__ unsigned xb_add(unsigned* p, unsigned v) { return __hip_atomic_fetch_add(p, v, __ATOMIC_RELAXED, __HIP_MEMORY_SCOPE_AGENT); }
__device__ __forceinline__ unsigned xb_xcc_id() { return (unsigned)__builtin_amdgcn_s_getreg((3 << 11) | 20) & 0xFu; }
#define XB_SPIN(cond, bar) do { unsigned _sp = 0; while (cond) { __builtin_amdgcn_s_sleep(1); \
    if ((++_sp & 255u) == 0u) { if (xb_ld(&(bar)[XB_TMO])) break; if (_sp > XB_SPIN_CAP) { atomicAdd(&(bar)[XB_TMO], 1u); break; } } } } while (0)
struct XcdBarrier { unsigned* bar; unsigned x; volatile LAS unsigned* st; };
__device__ __forceinline__ XcdBarrier xcd_barrier_post(unsigned* bar, volatile LAS unsigned* st) {
    XcdBarrier b; b.bar = bar; b.x = xb_xcc_id(); b.st = st;
    if (threadIdx.x == 0) (void)xb_add(&bar[XB_XCNT(b.x)], 1u);
    return b;
}
__device__ __forceinline__ void xcd_barrier_complete(unsigned* bar, unsigned x, unsigned& nloc, unsigned& nx) {
    const unsigned G = gridDim.x * gridDim.y * gridDim.z;
    unsigned sum, cnt, mine, sp = 0u;
    for (;;) {
        sum = 0u; cnt = 0u; mine = 0u;
#pragma unroll
        for (unsigned j = 0; j < 16; ++j) { const unsigned c = xb_ld(&bar[XB_XCNT(j)]); sum += c; cnt += (c > 0u) ? 1u : 0u; mine = (j == x) ? c : mine; }
        if (sum == G) break;
        __builtin_amdgcn_s_sleep(1);
        if ((++sp & 255u) == 0u) { if (xb_ld(&bar[XB_TMO])) break; if (sp > XB_SPIN_CAP) { atomicAdd(&bar[XB_TMO], 1u); break; } }
    }
    nloc = mine > 0u ? mine : 1u; nx = cnt > 0u ? cnt : 1u;
}
__device__ __forceinline__ void xcd_barrier(const XcdBarrier& b) {
    asm volatile("s_waitcnt vmcnt(0)" ::: "memory");
    __syncthreads();
    if (threadIdx.x == 0) {
        unsigned* bar = b.bar;
        __builtin_amdgcn_s_waitcnt(0);
        unsigned nloc = b.st[0], nx = b.st[1];
        if (nloc == 0u) { xcd_barrier_complete(bar, b.x, nloc, nx); b.st[0] = nloc; b.st[1] = nx; }
        const unsigned old = xb_add(&bar[XB_XSUB(b.x)], 1u);
        const unsigned gen = old / nloc;
        if (old + 1u == (gen + 1u) * nloc) {
            __builtin_amdgcn_fence(__ATOMIC_RELEASE, "agent");
            asm volatile("s_waitcnt vmcnt(0)" ::: "memory");
            const unsigned og = xb_add(&bar[XB_TOP], 1u);
            const unsigned tg = og / nx;
            if (og + 1u == (tg + 1u) * nx) xb_add(&bar[XB_TOPGEN], 1u);
            else XB_SPIN(xb_ld(&bar[XB_TOPGEN]) == tg, bar);
            __builtin_amdgcn_fence(__ATOMIC_ACQUIRE, "agent");
            xb_add(&bar[XB_XGEN(b.x)], 1u);
            asm volatile("s_waitcnt vmcnt(0)" ::: "memory");
        } else {
            XB_SPIN(xb_ld(&bar[XB_XGEN(b.x)]) == gen, bar);
            __builtin_amdgcn_fence(__ATOMIC_ACQUIRE, "agent");
            asm volatile("s_waitcnt vmcnt(0)" ::: "memory");
        }
    }
    __syncthreads();
}

struct Args { const float* in[32]; float* outp; unsigned char* ws; int ph_lo, ph_hi; };
struct Frame {
    LAS unsigned char* lds;
    int tid, lane, wave, bid, G;
    const Args* a; unsigned char* ws;
    DI const float* in(int i) const { asm("" : "+s"(i)); return a->in[i]; }
    DI const float* x() const { return in(0); }
    DI const float* c() const { return in(1); }
    DI const float* ctx() const { return in(2); }
    DI const float* c_ctx() const { return in(3); }
    DI const float* w_ada() const { return in(4); }
    DI const float* b_ada() const { return in(5); }
    DI const float* w_in() const { return in(6); }
    DI const float* b_in() const { return in(7); }
    DI const float* w_s() const { return in(8); }
    DI const float* b_s() const { return in(9); }
    DI const float* sgu_g() const { return in(10); }
    DI const float* sgu_b() const { return in(11); }
    DI const float* conv_w() const { return in(12); }
    DI const float* conv_b() const { return in(13); }
    DI const float* w_q() const { return in(14); }
    DI const float* w_k() const { return in(15); }
    DI const float* mh_g() const { return in(16); }
    DI const float* skip() const { return in(17); }
    DI const float* p_a() const { return in(18); }
    DI const float* p_b() const { return in(19); }
    DI const float* w_o() const { return in(20); }
    DI const float* ln1_g() const { return in(21); }
    DI const float* ln1_b() const { return in(22); }
    DI const float* w_rg() const { return in(23); }
    DI const float* b_rg() const { return in(24); }
    DI const float* w_re() const { return in(25); }
    DI const float* b_re() const { return in(26); }
    DI const float* w1() const { return in(27); }
    DI const float* w3() const { return in(28); }
    DI const float* w2() const { return in(29); }
    DI const float* ln2_g() const { return in(30); }
    DI const float* ln2_b() const { return in(31); }
    DI unsigned* ctl() const { return (unsigned*)(ws + WS_CTL); }
    DI float* MOD() const { return (float*)(ws + WS_MOD); }
    DI float* WRT() const { return (float*)(ws + WS_WRT); }
    DI float* GB() const { return (float*)(ws + WS_GB); }
    DI float* NL() const { return (float*)(ws + WS_NL); }
    DI float* SC() const { return (float*)(ws + WS_SC); }
    DI float* TOKW() const { return (float*)(ws + WS_TOKW); }
    DI float* GATES() const { return (float*)(ws + WS_GATES); }
    DI int* TOKE() const { return (int*)(ws + WS_TOKE); }
    DI int* TOKS() const { return (int*)(ws + WS_TOKS); }
    DI int* TOKP() const { return (int*)(ws + WS_TOKP); }
    DI u16* WQK() const { return (u16*)(ws + WS_WQK); }
    DI u16* WSB() const { return (u16*)(ws + WS_WSB); }
    DI u16* WIN() const { return (u16*)(ws + WS_WIN); }
    DI u16* PAB() const { return (u16*)(ws + WS_PAB); }
    DI u16* WO() const { return (u16*)(ws + WS_WO); }
    DI u16* W13() const { return (u16*)(ws + WS_W13); }
    DI u16* W2() const { return (u16*)(ws + WS_W2); }
    DI u16* PROJ() const { return (u16*)(ws + WS_R1); }
    DI u16* XS() const { return (u16*)(ws + WS_XS); }
    DI u16* H() const { return (u16*)(ws + WS_H); }
    DI u16* U() const { return (u16*)(ws + WS_R2); }
    DI u16* Q() const { return (u16*)(ws + WS_R2); }
    DI u16* K() const { return (u16*)(ws + WS_R2) + (size_t)TR * 1024; }
    DI u16* U2() const { return (u16*)(ws + WS_R2); }
    DI u16* XC() const { return (u16*)(ws + WS_R3); }
    DI u16* Z() const { return (u16*)(ws + WS_R3); }
    DI u16* ST() const { return (u16*)(ws + WS_R4); }
    DI u16* AB() const { return (u16*)(ws + WS_R5); }
    DI u16* YS() const { return (u16*)(ws + WS_YS); }
    DI float* out() const { return a->outp; }
};

DI bf16x8 ld8(const LAS u16* p) { return *(const LAS bf16x8*)p; }
DI bf16x8 ld8(const GAS u16* p) { return *(const GAS bf16x8*)p; }
template <int NT, class PA, class PB>
DI void wave_mm(f32x4 (&acc)[NT], PA A, int lda, PB B, int ldb, int K, int lane) {
    const int fr = lane & 15, fq = lane >> 4;
#pragma unroll 1
    for (int k0 = 0; k0 < K; k0 += 32) {
        const bf16x8 a = ld8(A + fr * lda + k0 + 8 * fq);
#pragma unroll
        for (int t = 0; t < NT; ++t) { const bf16x8 b = ld8(B + (16 * t + fr) * ldb + k0 + 8 * fq); acc[t] = __builtin_amdgcn_mfma_f32_16x16x32_bf16(b, a, acc[t], 0, 0, 0); }
    }
}
template <int NT> DI void zero_acc(f32x4 (&acc)[NT]) {
#pragma unroll
    for (int t = 0; t < NT; ++t) acc[t] = (f32x4){0.f, 0.f, 0.f, 0.f};
}

DI void p0_gemv(Frame& F, int cb) {
    LAS float* sv = (LAS float*)F.lds;
    LAS float* red = sv + 4096;
    for (int i = F.tid; i < 2048; i += 512) { const float a = F.c()[i], b = F.c_ctx()[i]; sv[i] = a / (1.f + expf(-a)); sv[2048 + i] = b / (1.f + expf(-b)); }
    __syncthreads();
    const int l16 = F.tid & 15, rl = F.tid >> 4;
    f32x4 a1 = (f32x4){0.f, 0.f, 0.f, 0.f}, a2 = a1;
    const float* wp = F.w_ada() + (size_t)rl * 12288 + 64 * cb + 4 * l16;
#pragma unroll 8
    for (int it = 0; it < 64; ++it) { const f32x4 w = *(const GAS f32x4*)(wp + (size_t)it * 32 * 12288); const float s1 = sv[rl + 32 * it], s2 = sv[2048 + rl + 32 * it]; a1 += w * s1; a2 += w * s2; }
    *(LAS f32x4*)(red + (rl * 16 + l16) * 8) = a1; *(LAS f32x4*)(red + (rl * 16 + l16) * 8 + 4) = a2;
    __syncthreads();
    if (F.tid < 128) { const int v = F.tid >> 6, col = F.tid & 63, q16 = col >> 2, j = col & 3; float s = 0.f;
        for (int r = 0; r < 32; ++r) s += red[(r * 16 + q16) * 8 + v * 4 + j];
        F.MOD()[v * 12288 + 64 * cb + col] = s + F.b_ada()[64 * cb + col]; }
    __syncthreads();
}
DI void tr_item(const float* src, int ldn, int k0, int n0, int nvalid, u16* dst, int ldk, int drow0, int dk0, LAS float* scr, int lane) {
    const int n = n0 + (lane & 31); const bool ok = n < nvalid;
#pragma unroll 8
    for (int i = 0; i < 32; ++i) { const int kk = 2 * i + (lane >> 5); scr[kk * 33 + (lane & 31)] = ok ? src[(size_t)(k0 + kk) * ldn + n] : 0.f; }
    LDS_WAIT(); asm volatile("" ::: "memory");
    const int c = lane & 7;
#pragma unroll
    for (int j = 0; j < 4; ++j) { const int nn = (lane >> 3) + 8 * j; const LAS float* s = scr + (8 * c) * 33 + nn;
        u32x4 o; o.x = cvt_pk_bf16(s[0 * 33], s[1 * 33]); o.y = cvt_pk_bf16(s[2 * 33], s[3 * 33]); o.z = cvt_pk_bf16(s[4 * 33], s[5 * 33]); o.w = cvt_pk_bf16(s[6 * 33], s[7 * 33]);
        *(GAS u32x4*)(dst + (size_t)(drow0 + nn) * ldk + dk0 + 8 * c) = o; }
    LDS_WAIT(); asm volatile("" ::: "memory");
}
DI void p0_prologue(Frame& F) {
    for (int cb = F.bid; cb < 192; cb += F.G) p0_gemv(F, cb);
    LAS float* scr = (LAS float*)(F.lds + F.wave * 16384);
    const int gw = F.bid * 8 + F.wave, NGW = F.G * 8;
    constexpr int I_IN = 32 * (NPAD / 32), I_PA = 16 * 64, I_WO = 32 * 64, I_W1 = 32 * 1024, I_W2 = 32 * 1024, I_QK = 8 * 8;
    constexpr int NITEMS = I_IN + 2 * I_PA + I_WO + 2 * I_W1 + I_W2 + 2 * I_QK;
    for (int it = gw; it < NITEMS; it += NGW) {
        int r = it;
        if (r < I_IN) { const int nb = r % (NPAD / 32), kb = r / (NPAD / 32); tr_item(F.w_in(), DIN, 64 * kb, 32 * nb, DIN, F.WIN(), 2048, 32 * nb, 64 * kb, scr, F.lane); continue; } r -= I_IN;
        if (r < I_PA) { const int nb = r % 64, kb = r / 64; tr_item(F.p_a(), 2048, 64 * kb, 32 * nb, 2048, F.PAB(), 2048, 32 * nb, 64 * kb, scr, F.lane); continue; } r -= I_PA;
        if (r < I_PA) { const int nb = r % 64, kb = r / 64; tr_item(F.p_b(), 2048, 64 * kb, 32 * nb, 2048, F.PAB(), 2048, 32 * nb, 1024 + 64 * kb, scr, F.lane); continue; } r -= I_PA;
        if (r < I_WO) { const int nb = r % 64, kb = r / 64; tr_item(F.w_o(), 2048, 64 * kb, 32 * nb, 2048, F.WO(), 2048, 32 * nb, 64 * kb, scr, F.lane); continue; } r -= I_WO;
        if (r < I_W1) { const int e = r >> 10, rr = r & 1023, nb = rr & 31, kb = rr >> 5, n0 = 32 * nb;
            tr_item(F.w1() + (size_t)e * 2048 * 1024, 1024, 64 * kb, n0, 1024, F.W13() + (size_t)e * 2048 * 2048, 2048, 256 * (n0 >> 7) + (n0 & 127), 64 * kb, scr, F.lane); continue; } r -= I_W1;
        if (r < I_W1) { const int e = r >> 10, rr = r & 1023, nb = rr & 31, kb = rr >> 5, n0 = 32 * nb;
            tr_item(F.w3() + (size_t)e * 2048 * 1024, 1024, 64 * kb, n0, 1024, F.W13() + (size_t)e * 2048 * 2048, 2048, 256 * (n0 >> 7) + 128 + (n0 & 127), 64 * kb, scr, F.lane); continue; } r -= I_W1;
        if (r < I_W2) { const int e = r >> 10, rr = r & 1023, nb = rr & 63, kb = rr >> 6;
            tr_item(F.w2() + (size_t)e * 1024 * 2048, 2048, 64 * kb, 32 * nb, 2048, F.W2() + (size_t)e * 2048 * 1024, 1024, 32 * nb, 64 * kb, scr, F.lane); continue; } r -= I_W2;
        if (r < I_QK) { const int h = r >> 3, rr = r & 7, nb = rr & 3, kb = rr >> 2;
            tr_item(F.w_q() + (size_t)h * 16384, 128, 64 * kb, 32 * nb, 128, F.WQK() + (size_t)h * 32768, 128, 32 * nb, 64 * kb, scr, F.lane); continue; } r -= I_QK;
        { const int h = r >> 3, rr = r & 7, nb = rr & 3, kb = rr >> 2;
            tr_item(F.w_k() + (size_t)h * 16384, 128, 64 * kb, 32 * nb, 128, F.WQK() + (size_t)h * 32768, 128, 128 + 32 * nb, 64 * kb, scr, F.lane); }
    }
    const int gt = F.bid * 512 + F.tid, NGT = F.G * 512;
    for (int i = gt; i < 48 * 2048; i += NGT) { const int j = i >> 11, k = i & 2047; const float w = (j < 4) ? F.w_rg()[k * 4 + j] : (j < 36 ? F.w_re()[k * 32 + (j - 4)] : 0.f);
        const unsigned hi = f2bf(w); const unsigned lo = f2bf(w - __uint_as_float(hi << 16)); u16* wr = (u16*)F.WRT(); wr[i] = (u16)hi; wr[48 * 2048 + i] = (u16)lo; }
    for (int i = gt; i < 8 * 16384; i += NGT) F.WSB()[i] = (u16)f2bf(F.w_s()[i]);
}

DI void p1_rows(Frame& F) {
    const int gw = F.bid * 8 + F.wave, NGW = F.G * 8;
    for (int r = gw; r < TR; r += NGW) {
        const float* src = r < T ? F.x() + (size_t)r * D : F.ctx() + (size_t)(r - T) * D; const float* mod = F.MOD() + (r < T ? 0 : 12288);
        const GAS f32x4* xr = (const GAS f32x4*)src + F.lane;
        f32x4 v[8]; float s = 0.f;
#pragma unroll
        for (int j = 0; j < 8; ++j) { v[j] = xr[64 * j]; s += (v[j][0] + v[j][1]) + (v[j][2] + v[j][3]); }
        const float mean = wave_sum(s) * (1.f / D); float s2 = 0.f;
#pragma unroll
        for (int j = 0; j < 8; ++j) { v[j] = v[j] - mean; s2 += (v[j][0] * v[j][0] + v[j][1] * v[j][1]) + (v[j][2] * v[j][2] + v[j][3] * v[j][3]); }
        const float rstd = 1.f / sqrtf(wave_sum(s2) * (1.f / D) + LN_EPS);
        GAS u32x2* o = (GAS u32x2*)(F.U() + (size_t)r * D) + F.lane;
#pragma unroll
        for (int j = 0; j < 8; ++j) { const f32x4 sh = *(const f32x4*)(mod + 4 * F.lane + 256 * j), sc = *(const f32x4*)(mod + 2048 + 4 * F.lane + 256 * j);
            o[64 * j] = pack4(v[j] * rstd * (sc + 1.f) + sh); }
    }
}

template <int NT, class PA, class PB>
DI void wave_mm128(f32x4 (&acc)[NT], PA A, int lda, PB B, int ldb, int lane) {
    const int fr = lane & 15, fq = lane >> 4;
    bf16x8 a[4];
#pragma unroll
    for (int ks = 0; ks < 4; ++ks) a[ks] = ld8(A + fr * lda + 32 * ks + 8 * fq);
#pragma unroll
    for (int kp = 0; kp < 2; ++kp) {
        bf16x8 b[2][NT];
#pragma unroll
        for (int kk = 0; kk < 2; ++kk)
#pragma unroll
            for (int t = 0; t < NT; ++t) b[kk][t] = ld8(B + (16 * t + fr) * ldb + 32 * (2 * kp + kk) + 8 * fq);
#pragma unroll
        for (int kk = 0; kk < 2; ++kk)
#pragma unroll
            for (int t = 0; t < NT; ++t) acc[t] = __builtin_amdgcn_mfma_f32_16x16x32_bf16(b[kk][t], a[2 * kp + kk], acc[t], 0, 0, 0);
        __builtin_amdgcn_sched_barrier(0);
    }
}
template <int NT, class PB>
DI void wave_mm128_areg(f32x4 (&acc)[NT], const bf16x8 (&a)[4], PB B, int ldb, int lane) {
    const int fr = lane & 15, fq = lane >> 4;
#pragma unroll
    for (int kp = 0; kp < 2; ++kp) {
        bf16x8 b[2][NT];
#pragma unroll
        for (int kk = 0; kk < 2; ++kk)
#pragma unroll
            for (int t = 0; t < NT; ++t) b[kk][t] = ld8(B + (16 * t + fr) * ldb + 32 * (2 * kp + kk) + 8 * fq);
#pragma unroll
        for (int kk = 0; kk < 2; ++kk)
#pragma unroll
            for (int t = 0; t < NT; ++t) acc[t] = __builtin_amdgcn_mfma_f32_16x16x32_bf16(b[kk][t], a[2 * kp + kk], acc[t], 0, 0, 0);
        __builtin_amdgcn_sched_barrier(0);
    }
}
DI float wave_incl_scan(float v, int lane) {
#pragma unroll
    for (int o = 1; o < 64; o <<= 1) { const float t = __shfl_up(v, o); v = (lane >= o) ? v + t : v; }
    return v;
}
DI float fexp(float x) { return __builtin_amdgcn_exp2f(x * 1.4426950408889634f); }

DI void gmlp_unit(Frame& F, int c, int g, int& cur_g) {
    LAS float* MU = (LAS float*)(F.lds + 140288); LAS float* RS = MU + 128;
    LAS u16* VNT = (LAS u16*)F.lds;
    LAS u16* WSs = (LAS u16*)(F.lds + 34816);
    if (g != cur_g) { cur_g = g;
#pragma unroll
        for (int i = 0; i < 4; ++i) { const int idx = F.tid + 512 * i; *(LAS u32x4*)(WSs + (idx >> 4) * 136 + 8 * (idx & 15)) = *(const GAS u32x4*)(F.WSB() + g * 16384 + (idx >> 4) * 128 + 8 * (idx & 15)); } }
    const int r0 = 128 * c, fr = F.lane & 15, fq = F.lane >> 4;
#pragma unroll 1
    for (int hb = 0; hb < 2; ++hb) {
        u32x4 a[8], b[8];
#pragma unroll
        for (int i = 0; i < 8; ++i) { const GAS u16* p = (const GAS u16*)(F.PROJ() + (size_t)(r0 + 16 * F.wave + 8 * hb + i) * NPJ + OFF_VA + 16 * F.lane); a[i] = *(const GAS u32x4*)p; b[i] = *(const GAS u32x4*)(p + 8); }
#pragma unroll
        for (int i = 0; i < 8; ++i) {
            const float v[16] = {bflo(a[i].x), bfhi(a[i].x), bflo(a[i].y), bfhi(a[i].y), bflo(a[i].z), bfhi(a[i].z), bflo(a[i].w), bfhi(a[i].w), bflo(b[i].x), bfhi(b[i].x), bflo(b[i].y), bfhi(b[i].y), bflo(b[i].z), bfhi(b[i].z), bflo(b[i].w), bfhi(b[i].w)};
            float s = 0.f;
#pragma unroll
            for (int j = 0; j < 16; ++j) s += v[j];
            const float mean = wave_sum(s) * (1.f / 1024.f); float q = 0.f;
#pragma unroll
            for (int j = 0; j < 16; ++j) { const float d = v[j] - mean; q += d * d; }
            const float var = wave_sum(q) * (1.f / 1024.f);
            if (F.lane == 0) { MU[16 * F.wave + 8 * hb + i] = mean; RS[16 * F.wave + 8 * hb + i] = 1.f / sqrtf(var + LN_EPS); } }
    }
    __syncthreads();
    {
        const int c8 = F.tid & 15;
        u32x4 vq[4];
#pragma unroll
        for (int i = 0; i < 4; ++i) vq[i] = *(const GAS u32x4*)(F.PROJ() + (size_t)(r0 + ((F.tid + 512 * i) >> 4)) * NPJ + OFF_VA + 128 * g + 8 * c8);
        const f32x4 g0 = *(const f32x4*)(F.sgu_g() + 128 * g + 8 * c8), g1 = *(const f32x4*)(F.sgu_g() + 128 * g + 8 * c8 + 4), b0 = *(const f32x4*)(F.sgu_b() + 128 * g + 8 * c8), b1 = *(const f32x4*)(F.sgu_b() + 128 * g + 8 * c8 + 4);
        const float gg[8] = {g0[0], g0[1], g0[2], g0[3], g1[0], g1[1], g1[2], g1[3]}, bb[8] = {b0[0], b0[1], b0[2], b0[3], b1[0], b1[1], b1[2], b1[3]};
#pragma unroll
        for (int i = 0; i < 4; ++i) { const int p = (F.tid + 512 * i) >> 4; const u32x4 v = vq[i]; const float mu = MU[p], rs = RS[p];
            const float x[8] = {bflo(v.x), bfhi(v.x), bflo(v.y), bfhi(v.y), bflo(v.z), bfhi(v.z), bflo(v.w), bfhi(v.w)};
#pragma unroll
            for (int j = 0; j < 8; ++j) VNT[(8 * c8 + j) * 136 + p] = (u16)f2bf((x[j] - mu) * rs * gg[j] + bb[j]); }
    }
    __syncthreads();
    const int q = 16 * F.wave + fr; const float bsq = F.b_s()[g * 128 + q];
    u32x2 uaq[8];
#pragma unroll
    for (int t = 0; t < 8; ++t) uaq[t] = *(const GAS u32x2*)(F.PROJ() + (size_t)(r0 + q) * NPJ + OFF_UA + 128 * g + 16 * t + 4 * fq);
    f32x4 acc[8]; zero_acc<8>(acc);
    wave_mm128<8>(acc, (const LAS u16*)(WSs + 16 * F.wave * 136), 136, (const LAS u16*)VNT, 136, F.lane);
#pragma unroll
    for (int t = 0; t < 8; ++t) *(GAS u32x2*)(F.AB() + (size_t)(r0 + q) * 2048 + 128 * g + 16 * t + 4 * fq) = pack4(unpack4(uaq[t]) * (acc[t] + bsq));
    __syncthreads();
}

DI void mprep_unit(Frame& F, int c, int h, int& cur_h) {
    const int r0 = (c < 2) ? T + 128 * c : 128 * (c - 2);
    const int seq_lo = (c < 2) ? T : 0, seq_hi = (c < 2) ? TR - 1 : T - 1;
    LAS u16* XCs = (LAS u16*)F.lds;
    LAS u16* KT = (LAS u16*)(F.lds + 34816);
    LAS u16* WQs = (LAS u16*)(F.lds + 2 * 34816);
    LAS float* GS = (LAS float*)(F.lds + 4 * 34816);
    const int fr = F.lane & 15, fq = F.lane >> 4;
    if (h != cur_h) { cur_h = h;
#pragma unroll
        for (int i = 0; i < 8; ++i) { const int idx = F.tid + 512 * i; *(LAS u32x4*)(WQs + (idx >> 4) * 136 + 8 * (idx & 15)) = *(const GAS u32x4*)(F.WQK() + (size_t)h * 32768 + (idx >> 4) * 128 + 8 * (idx & 15)); } }
    u32x4 vtq[4];
#pragma unroll
    for (int i = 0; i < 4; ++i) { const int idx = F.tid + 512 * i; vtq[i] = *(const GAS u32x4*)(F.PROJ() + (size_t)(r0 + (idx >> 4)) * NPJ + OFF_VB + 128 * h + 8 * (idx & 15)); }
    if (F.wave < 2) {
        const int dir = F.wave; const int s0 = dir ? 127 - 2 * F.lane : 2 * F.lane, s1 = dir ? 126 - 2 * F.lane : 2 * F.lane + 1;
        const float* g0 = F.GATES() + (size_t)(r0 + s0) * 32 + 16 * dir + h; const float* g1 = F.GATES() + (size_t)(r0 + s1) * 32 + 16 * dir + h;
        const float li0 = g0[0], lf0 = logsig(g0[8]), li1 = g1[0], lf1 = logsig(g1[8]);
        const float incl = wave_incl_scan(lf0 + lf1, F.lane);
        const float b1 = incl, b0 = incl - lf1;
        const float bs = __shfl(incl, 63);
        const float l0 = bs - b0 + li0, l1 = bs - b1 + li1;
        const float ml = wave_max(fmaxf(l0, l1));
        GS[128 * dir + s0] = expf(l0 - ml); GS[128 * dir + s1] = expf(l1 - ml);
        if (F.lane == 0) { float* sc = F.SC() + (size_t)((dir * 8 + h) * NCH + c) * 4; sc[0] = ml; sc[1] = bs; }
        float* gb0 = F.GB() + ((size_t)h * TR + r0 + s0) * 4 + 2 * dir; float* gb1 = F.GB() + ((size_t)h * TR + r0 + s1) * 4 + 2 * dir;
        *(f32x2*)gb0 = (f32x2){li0, b0}; *(f32x2*)gb1 = (f32x2){li1, b1};
    }
    const int cch = 128 * h + 8 * (F.tid & 15);
    f32x4 cw0[2], cw1[2], cw2[2], cbb[2];
#pragma unroll
    for (int hh = 0; hh < 2; ++hh) { cw0[hh] = *(const f32x4*)(F.conv_w() + cch + 4 * hh); cw1[hh] = *(const f32x4*)(F.conv_w() + 1024 + cch + 4 * hh); cw2[hh] = *(const f32x4*)(F.conv_w() + 2048 + cch + 4 * hh); cbb[hh] = *(const f32x4*)(F.conv_b() + cch + 4 * hh); }
    u32x4 xmq[4], xpq[4], xnq[4];
#pragma unroll
    for (int i = 0; i < 4; ++i) { const int row = r0 + ((F.tid + 512 * i) >> 4); const GAS u16* p = (const GAS u16*)(F.PROJ() + (size_t)row * NPJ + OFF_XM + cch); const u32x4 z4 = (u32x4){0u, 0u, 0u, 0u};
        xmq[i] = *(const GAS u32x4*)p; xpq[i] = (row > seq_lo) ? *(const GAS u32x4*)(p - NPJ) : z4; xnq[i] = (row < seq_hi) ? *(const GAS u32x4*)(p + NPJ) : z4; }
#pragma unroll
    for (int i = 0; i < 4; ++i) { const int idx = F.tid + 512 * i, s = idx >> 4, c8 = idx & 15, row = r0 + s, ch = 128 * h + 8 * c8;
        const u32x4 xm = xmq[i], xp = xpq[i], xn = xnq[i];
        float y[8];
#pragma unroll
        for (int hh = 0; hh < 2; ++hh) { const f32x4 w0 = cw0[hh], w1 = cw1[hh], w2 = cw2[hh], cb = cbb[hh];
            const unsigned a0 = hh ? xp.z : xp.x, a1 = hh ? xp.w : xp.y, m0 = hh ? xm.z : xm.x, m1 = hh ? xm.w : xm.y, n0 = hh ? xn.z : xn.x, n1 = hh ? xn.w : xn.y;
            y[4 * hh + 0] = w0[0] * bflo(a0) + w1[0] * bflo(m0) + w2[0] * bflo(n0) + cb[0];
            y[4 * hh + 1] = w0[1] * bfhi(a0) + w1[1] * bfhi(m0) + w2[1] * bfhi(n0) + cb[1];
            y[4 * hh + 2] = w0[2] * bflo(a1) + w1[2] * bflo(m1) + w2[2] * bflo(n1) + cb[2];
            y[4 * hh + 3] = w0[3] * bfhi(a1) + w1[3] * bfhi(m1) + w2[3] * bfhi(n1) + cb[3]; }
#pragma unroll
        for (int j = 0; j < 8; ++j) y[j] = y[j] * sigmoid_fast(y[j]);
        u32x4 o; o.x = cvt_pk_bf16(y[0], y[1]); o.y = cvt_pk_bf16(y[2], y[3]); o.z = cvt_pk_bf16(y[4], y[5]); o.w = cvt_pk_bf16(y[6], y[7]);
        *(LAS u32x4*)(XCs + s * 136 + 8 * c8) = o; *(GAS u32x4*)(F.XC() + (size_t)row * 1024 + ch) = o; }
    __syncthreads();
    {
        f32x4 aq[8]; zero_acc<8>(aq);
        wave_mm128<8>(aq, (const LAS u16*)(XCs + 16 * F.wave * 136), 136, (const LAS u16*)WQs, 136, F.lane);
        const int s = 16 * F.wave + fr;
#pragma unroll
        for (int t = 0; t < 8; ++t) *(GAS u32x2*)(F.Q() + (size_t)(r0 + s) * 1024 + 128 * h + 16 * t + 4 * fq) = pack4(aq[t]);
        zero_acc<8>(aq);
        wave_mm128<8>(aq, (const LAS u16*)(XCs + 16 * F.wave * 136), 136, (const LAS u16*)(WQs + 128 * 136), 136, F.lane);
#pragma unroll
        for (int t = 0; t < 8; ++t) *(GAS u32x2*)(F.K() + (size_t)(r0 + s) * 1024 + 128 * h + 16 * t + 4 * fq) = pack4(aq[t] * 0.08838834764831845f);
        zero_acc<8>(aq);
        wave_mm128<8>(aq, (const LAS u16*)(WQs + (128 + 16 * F.wave) * 136), 136, (const LAS u16*)XCs, 136, F.lane);
        const int d = 16 * F.wave + fr;
#pragma unroll
        for (int t = 0; t < 8; ++t) *(LAS u32x2*)(KT + d * 136 + 16 * t + 4 * fq) = pack4(aq[t] * 0.08838834764831845f);
    }
    __syncthreads();
#pragma unroll
    for (int i = 0; i < 4; ++i) { const int idx = F.tid + 512 * i, s = idx >> 4, c8 = idx & 15;
        const unsigned w[4] = {vtq[i].x, vtq[i].y, vtq[i].z, vtq[i].w};
#pragma unroll
        for (int j = 0; j < 4; ++j) { XCs[(8 * c8 + 2 * j) * 136 + s] = (u16)(w[j] & 0xffffu); XCs[(8 * c8 + 2 * j + 1) * 136 + s] = (u16)(w[j] >> 16); } }
    __syncthreads();
#pragma unroll
    for (int dir = 0; dir < 2; ++dir) {
        f32x4 cf[8]; zero_acc<8>(cf);
#pragma unroll
        for (int ks = 0; ks < 4; ++ks) {
            const u32x4 av = *(const LAS u32x4*)(XCs + (16 * F.wave + fr) * 136 + 32 * ks + 8 * fq);
            const f32x4 w0 = *(const LAS f32x4*)(GS + 128 * dir + 32 * ks + 8 * fq), w1 = *(const LAS f32x4*)(GS + 128 * dir + 32 * ks + 8 * fq + 4);
            u32x4 sv; sv.x = cvt_pk_bf16(bflo(av.x) * w0[0], bfhi(av.x) * w0[1]); sv.y = cvt_pk_bf16(bflo(av.y) * w0[2], bfhi(av.y) * w0[3]);
            sv.z = cvt_pk_bf16(bflo(av.z) * w1[0], bfhi(av.z) * w1[1]); sv.w = cvt_pk_bf16(bflo(av.w) * w1[2], bfhi(av.w) * w1[3]);
            const bf16x8 a = __builtin_bit_cast(bf16x8, sv);
#pragma unroll
            for (int t = 0; t < 8; ++t) { const bf16x8 b = ld8((const LAS u16*)(KT + (16 * t + fr) * 136 + 32 * ks + 8 * fq)); cf[t] = __builtin_amdgcn_mfma_f32_16x16x32_bf16(b, a, cf[t], 0, 0, 0); }
        }
        u16* st = F.ST() + ((size_t)((dir * 8 + h) * NCH + c) * 16384) + (16 * F.wave + fr) * 128;
#pragma unroll
        for (int t = 0; t < 8; ++t) *(GAS u32x2*)(st + 16 * t + 4 * fq) = pack4(cf[t]);
    }
    if (F.tid < 256) { const int dir = F.tid >> 7, d = F.tid & 127; const LAS u16* kt = KT + d * 136; const LAS float* w = GS + 128 * dir; float s = 0.f;
#pragma unroll
        for (int i = 0; i < 16; ++i) { const u32x4 v = *(const LAS u32x4*)(kt + 8 * i); const f32x4 w0 = *(const LAS f32x4*)(w + 8 * i), w1 = *(const LAS f32x4*)(w + 8 * i + 4);
            s += ((bflo(v.x) * w0[0] + bfhi(v.x) * w0[1]) + (bflo(v.y) * w0[2] + bfhi(v.y) * w0[3])) + ((bflo(v.z) * w1[0] + bfhi(v.z) * w1[1]) + (bflo(v.w) * w1[2] + bfhi(v.w) * w1[3])); }
        F.NL()[(size_t)((dir * 8 + h) * NCH + c) * 128 + d] = s; }
    __syncthreads();
}

DI int scan_order(int dir, int j) { return dir == 0 ? j : (j == 0 ? 1 : (j == 1 ? 0 : 131 - j)); }
DI void scan_item(Frame& F, int dh, int blk) {
    const int dir = dh >> 3;
    LAS float* ML = (LAS float*)F.lds; LAS float* BS = ML + 136; LAS float* DEC = ML + 272; LAS float* SCL = ML + 408; LAS float* MB = ML + 544;
    if (F.tid < NCH) { const int cj = scan_order(dir, F.tid); const float* sc = F.SC() + (size_t)(dh * NCH + cj) * 4; ML[F.tid] = sc[0]; BS[F.tid] = sc[1]; }
    __syncthreads();
    if (F.tid == 0) { float m = NEGF; for (int j = 0; j < NCH; ++j) { MB[j] = m; const float mn = fmaxf(BS[j] + m, ML[j]); DEC[j] = fexp(BS[j] + m - mn); SCL[j] = fexp(ML[j] - mn); m = mn; } }
    __syncthreads();
    GAS unsigned* base = (GAS unsigned*)(F.ST() + (size_t)dh * NCH * 16384) + blk * 512 + F.tid;
    float c0 = 0.f, c1 = 0.f;
#pragma unroll 1
    for (int j0 = 0; j0 < NCH; j0 += 26) {
        unsigned kv[26];
#pragma unroll
        for (int jj = 0; jj < 26; ++jj) kv[jj] = base[(size_t)scan_order(dir, j0 + jj) * 8192];
#pragma unroll
        for (int jj = 0; jj < 26; ++jj) { base[(size_t)scan_order(dir, j0 + jj) * 8192] = cvt_pk_bf16(c0, c1);
            const float de = DEC[j0 + jj], sc = SCL[j0 + jj]; c0 = de * c0 + sc * bflo(kv[jj]); c1 = de * c1 + sc * bfhi(kv[jj]); }
    }
    if (blk == 0) {
        if (F.tid < 128) { float n = 0.f; float* nl = F.NL() + (size_t)dh * NCH * 128 + F.tid;
            for (int j = 0; j < NCH; ++j) { const int cj = scan_order(dir, j); const float v = nl[cj * 128]; nl[cj * 128] = n; n = DEC[j] * n + SCL[j] * v; } }
        if (F.tid >= 256 && F.tid < 256 + NCH) { const int j = F.tid - 256; F.SC()[(size_t)(dh * NCH + scan_order(dir, j)) * 4 + 2] = MB[j]; }
    }
    __syncthreads();
}

DI void x3_unit(Frame& F, int lc, int h) {
    const int c = lc + 2, r0 = 128 * lc, fr = F.lane & 15, fq = F.lane >> 4;
    LAS u16* VT = (LAS u16*)F.lds;
    LAS u16* KS = (LAS u16*)(F.lds + 34816);
    LAS u16* PW = KS + F.wave * 16 * 136;
    LAS u16* SF = (LAS u16*)(F.lds + 2 * 34816);
    LAS u16* SB = (LAS u16*)(F.lds + 3 * 34816);
    LAS float* GS = (LAS float*)(F.lds + 4 * 34816);
    const int ql = 16 * F.wave + fr;
    bf16x8 qa[4];
#pragma unroll
    for (int ks = 0; ks < 4; ++ks) qa[ks] = ld8((const GAS u16*)(F.Q() + (size_t)(r0 + ql) * 1024 + 128 * h + 32 * ks + 8 * fq));
    if (F.tid < 128) { const f32x4 g = *(const GAS f32x4*)(F.GB() + ((size_t)h * TR + r0 + F.tid) * 4); GS[F.tid] = g[0]; GS[128 + F.tid] = g[1]; GS[256 + F.tid] = g[2]; GS[384 + F.tid] = g[3]; }
    else if (F.tid < 384) { const int i = F.tid - 128, dir = i >> 7, d = i & 127; GS[512 + i] = F.NL()[(size_t)((dir * 8 + h) * NCH + c) * 128 + d]; }
    const float mf = F.SC()[(size_t)(h * NCH + c) * 4 + 2], mb = F.SC()[(size_t)((8 + h) * NCH + c) * 4 + 2];
    {
        u32x4 vv[4], s0[4], s1[4], kq[4];
        const GAS u16* stf = (const GAS u16*)(F.ST() + (size_t)(h * NCH + c) * 16384); const GAS u16* stb = (const GAS u16*)(F.ST() + (size_t)((8 + h) * NCH + c) * 16384);
#pragma unroll
        for (int i = 0; i < 4; ++i) { const int idx = F.tid + 512 * i, s = idx >> 4, c8 = idx & 15;
            vv[i] = *(const GAS u32x4*)(F.PROJ() + (size_t)(r0 + s) * NPJ + OFF_VB + 128 * h + 8 * c8); s0[i] = *(const GAS u32x4*)(stf + s * 128 + 8 * c8); s1[i] = *(const GAS u32x4*)(stb + s * 128 + 8 * c8);
            kq[i] = *(const GAS u32x4*)(F.K() + (size_t)(r0 + s) * 1024 + 128 * h + 8 * c8); }
#pragma unroll
        for (int i = 0; i < 4; ++i) { const int idx = F.tid + 512 * i, s = idx >> 4, c8 = idx & 15;
            *(LAS u32x4*)(SF + s * 136 + 8 * c8) = s0[i]; *(LAS u32x4*)(SB + s * 136 + 8 * c8) = s1[i]; *(LAS u32x4*)(KS + s * 136 + 8 * c8) = kq[i];
            const unsigned w[4] = {vv[i].x, vv[i].y, vv[i].z, vv[i].w};
#pragma unroll
            for (int j = 0; j < 4; ++j) { VT[(8 * c8 + 2 * j) * 136 + s] = (u16)(w[j] & 0xffffu); VT[(8 * c8 + 2 * j + 1) * 136 + s] = (u16)(w[j] >> 16); } }
    }
    __syncthreads();
    f32x4 sf[8], sb[8]; zero_acc<8>(sf);
    wave_mm128_areg<8>(sf, qa, (const LAS u16*)KS, 136, F.lane);
    __syncthreads();
    const float bqf = GS[128 + ql], bqb = GS[384 + ql];
    float mxf = -3.0e38f, mxb = -3.0e38f;
#pragma unroll
    for (int t = 0; t < 8; ++t)
#pragma unroll
        for (int r = 0; r < 4; ++r) { const int s = 16 * t + 4 * fq + r; const float df = bqf - GS[128 + s] + GS[s], db = bqb - GS[384 + s] + GS[256 + s];
            mxf = (s <= ql) ? fmaxf(mxf, df) : mxf; mxb = (s >= ql) ? fmaxf(mxb, db) : mxb; }
    mxf = fmaxf(mxf, __shfl_xor(mxf, 16)); mxf = fmaxf(mxf, __shfl_xor(mxf, 32)); mxb = fmaxf(mxb, __shfl_xor(mxb, 16)); mxb = fmaxf(mxb, __shfl_xor(mxb, 32));
    const float mrf = fmaxf(bqf + mf, mxf), mrb = fmaxf(bqb + mb, mxb);
    float rsf = 0.f, rsb = 0.f;
#pragma unroll
    for (int t = 0; t < 8; ++t)
#pragma unroll
        for (int r = 0; r < 4; ++r) { const int s = 16 * t + 4 * fq + r; const float df = bqf - GS[128 + s] + GS[s], db = bqb - GS[384 + s] + GS[256 + s];
            const float ef = (s <= ql) ? fexp(df - mrf) : 0.f, eb = (s >= ql) ? fexp(db - mrb) : 0.f; const float s0 = sf[t][r];
            sf[t][r] = s0 * ef; sb[t][r] = s0 * eb; rsf += sf[t][r]; rsb += sb[t][r]; }
    rsf += __shfl_xor(rsf, 16); rsf += __shfl_xor(rsf, 32); rsb += __shfl_xor(rsb, 16); rsb += __shfl_xor(rsb, 32);
    float qnf = 0.f, qnb = 0.f;
#pragma unroll
    for (int i = 0; i < 4; ++i) { const u32x4 qv = __builtin_bit_cast(u32x4, qa[i]); const int d0 = 32 * i + 8 * fq;
        const float qq[8] = {bflo(qv.x), bfhi(qv.x), bflo(qv.y), bfhi(qv.y), bflo(qv.z), bfhi(qv.z), bflo(qv.w), bfhi(qv.w)};
#pragma unroll
        for (int j = 0; j < 8; ++j) { qnf += qq[j] * GS[512 + d0 + j]; qnb += qq[j] * GS[640 + d0 + j]; } }
    qnf += __shfl_xor(qnf, 16); qnf += __shfl_xor(qnf, 32); qnb += __shfl_xor(qnb, 16); qnb += __shfl_xor(qnb, 32);
    const float af = fexp(bqf + mf - mrf), ab = fexp(bqb + mb - mrb);
    const float dnf = fmaxf(fabsf(af * qnf + rsf), fexp(-mrf)), dnb = fmaxf(fabsf(ab * qnb + rsb), fexp(-mrb));
    const float ivf = 1.f / dnf, ivb = 1.f / dnb, rf = af * ivf, rb = ab * ivb;
#pragma unroll
    for (int t = 0; t < 8; ++t) *(LAS u32x2*)(PW + fr * 136 + 16 * t + 4 * fq) = pack4(sf[t] * ivf + sb[t] * ivb);
    LDS_WAIT(); asm volatile("" ::: "memory");
    f32x4 hv[8]; zero_acc<8>(hv);
    wave_mm<8>(hv, (const LAS u16*)PW, 136, (const LAS u16*)VT, 136, 128, F.lane);
    zero_acc<8>(sf);
    wave_mm128_areg<8>(sf, qa, (const LAS u16*)SF, 136, F.lane);
#pragma unroll
    for (int t = 0; t < 8; ++t) hv[t] += sf[t] * rf;
    zero_acc<8>(sb);
    wave_mm128_areg<8>(sb, qa, (const LAS u16*)SB, 136, F.lane);
    float s1 = 0.f;
#pragma unroll
    for (int t = 0; t < 8; ++t) { hv[t] += sb[t] * rb; s1 += (hv[t][0] + hv[t][1]) + (hv[t][2] + hv[t][3]); }
    s1 += __shfl_xor(s1, 16); s1 += __shfl_xor(s1, 32);
    const float mean = s1 * (1.f / 128.f); float s2 = 0.f;
#pragma unroll
    for (int t = 0; t < 8; ++t) { hv[t] = hv[t] - mean; s2 += (hv[t][0] * hv[t][0] + hv[t][1] * hv[t][1]) + (hv[t][2] * hv[t][2] + hv[t][3] * hv[t][3]); }
    s2 += __shfl_xor(s2, 16); s2 += __shfl_xor(s2, 32);
    const float rstd = 1.f / sqrtf(s2 * (1.f / 128.f) + LN_EPS);
    const size_t row = (size_t)(r0 + ql);
#pragma unroll
    for (int hb = 0; hb < 2; ++hb) {
        f32x4 mg[4], sk[4]; u32x2 xcq[4], soq[4];
#pragma unroll
        for (int tt = 0; tt < 4; ++tt) { const int e0 = 128 * h + 16 * (4 * hb + tt) + 4 * fq;
            mg[tt] = *(const f32x4*)(F.mh_g() + e0); sk[tt] = *(const f32x4*)(F.skip() + e0); xcq[tt] = *(const GAS u32x2*)(F.XC() + row * 1024 + e0); soq[tt] = *(const GAS u32x2*)(F.PROJ() + row * NPJ + OFF_OB + e0); }
#pragma unroll
        for (int tt = 0; tt < 4; ++tt) { const int e0 = 128 * h + 16 * (4 * hb + tt) + 4 * fq;
            *(GAS u32x2*)(F.AB() + row * 2048 + 1024 + e0) = pack4(unpack4(soq[tt]) * (hv[4 * hb + tt] * rstd * mg[tt] + sk[tt] * unpack4(xcq[tt]))); }
    }
    __syncthreads();
}

DI void p8_rows(Frame& F) {
    LAS int* HC = (LAS int*)F.lds; LAS int* HB = HC + 32;
    LAS float* ST2 = (LAS float*)(F.lds + 256);
    LAS float* SCP = (LAS float*)(F.lds + 1024);
    LAS float* SHP = SCP + 2048;
    LAS float* LGP = SHP + 2048;
    const float* mod = F.MOD();
    const int fr = F.lane & 15, fq = F.lane >> 4;
    for (int i = F.tid; i < 2048; i += 512) { SCP[i] = 1.f + mod[4 * 2048 + i]; SHP[i] = mod[3 * 2048 + i]; }
    const u16* WRH = (const u16*)F.WRT(); const u16* WRL = WRH + 48 * 2048;
    for (int rb = F.bid; rb < T / 64; rb += F.G) {
        if (F.tid < 32) HC[F.tid] = 0;
        for (int i = 0; i < 8; ++i) {
            const int rl = 8 * F.wave + i, r = 64 * rb + rl;
            GAS f32x4* xr = (GAS f32x4*)(F.out() + (size_t)r * D) + F.lane;
            f32x4 v[8]; float s = 0.f;
#pragma unroll
            for (int j = 0; j < 8; ++j) { v[j] = xr[64 * j]; s += (v[j][0] + v[j][1]) + (v[j][2] + v[j][3]); }
            float mean = wave_sum(s) * (1.f / D), s2 = 0.f;
#pragma unroll
            for (int j = 0; j < 8; ++j) { v[j] = v[j] - mean; s2 += (v[j][0] * v[j][0] + v[j][1] * v[j][1]) + (v[j][2] * v[j][2] + v[j][3] * v[j][3]); }
            float rstd = 1.f / sqrtf(wave_sum(s2) * (1.f / D) + LN_EPS);
            s = 0.f;
#pragma unroll
            for (int j = 0; j < 8; ++j) { const f32x4 g = *(const f32x4*)(F.ln1_g() + 4 * F.lane + 256 * j), b = *(const f32x4*)(F.ln1_b() + 4 * F.lane + 256 * j);
                v[j] = v[j] * rstd * g + b; xr[64 * j] = v[j]; s += (v[j][0] + v[j][1]) + (v[j][2] + v[j][3]); }
            mean = wave_sum(s) * (1.f / D); s2 = 0.f;
#pragma unroll
            for (int j = 0; j < 8; ++j) { const f32x4 d = v[j] - mean; s2 += (d[0] * d[0] + d[1] * d[1]) + (d[2] * d[2] + d[3] * d[3]); }
            rstd = 1.f / sqrtf(wave_sum(s2) * (1.f / D) + LN_EPS);
            if (F.lane == 0) { ST2[2 * rl] = mean; ST2[2 * rl + 1] = rstd; }
        }
        asm volatile("s_waitcnt vmcnt(0)" ::: "memory");
        __syncthreads();
        {
            const int tile = F.wave & 3, kh = F.wave >> 2, rl = 16 * tile + fr; const size_t r = (size_t)(64 * rb + rl);
            const float mean2 = ST2[2 * rl], rstd2 = ST2[2 * rl + 1];
            f32x4 acc[3]; zero_acc<3>(acc);
#pragma unroll 2
            for (int ks = 0; ks < 32; ++ks) {
                const int k = 1024 * kh + 32 * ks + 8 * fq;
                const f32x4 a0 = *(const GAS f32x4*)(F.out() + r * D + k), a1 = *(const GAS f32x4*)(F.out() + r * D + k + 4);
                const f32x4 u0 = (a0 - mean2) * rstd2 * *(const LAS f32x4*)(SCP + k) + *(const LAS f32x4*)(SHP + k);
                const f32x4 u1 = (a1 - mean2) * rstd2 * *(const LAS f32x4*)(SCP + k + 4) + *(const LAS f32x4*)(SHP + k + 4);
                u32x4 hi; hi.x = cvt_pk_bf16(u0[0], u0[1]); hi.y = cvt_pk_bf16(u0[2], u0[3]); hi.z = cvt_pk_bf16(u1[0], u1[1]); hi.w = cvt_pk_bf16(u1[2], u1[3]);
                u32x4 lo; lo.x = cvt_pk_bf16(u0[0] - bflo(hi.x), u0[1] - bfhi(hi.x)); lo.y = cvt_pk_bf16(u0[2] - bflo(hi.y), u0[3] - bfhi(hi.y));
                lo.z = cvt_pk_bf16(u1[0] - bflo(hi.z), u1[1] - bfhi(hi.z)); lo.w = cvt_pk_bf16(u1[2] - bflo(hi.w), u1[3] - bfhi(hi.w));
                *(GAS u32x4*)(F.U2() + r * D + k) = hi;
                const bf16x8 ah = __builtin_bit_cast(bf16x8, hi), al = __builtin_bit_cast(bf16x8, lo);
#pragma unroll
                for (int t = 0; t < 3; ++t) { const bf16x8 bh = ld8((const GAS u16*)(WRH + (16 * t + fr) * 2048 + k)), bl = ld8((const GAS u16*)(WRL + (16 * t + fr) * 2048 + k));
                    acc[t] = __builtin_amdgcn_mfma_f32_16x16x32_bf16(bh, ah, acc[t], 0, 0, 0);
                    acc[t] = __builtin_amdgcn_mfma_f32_16x16x32_bf16(bh, al, acc[t], 0, 0, 0);
                    acc[t] = __builtin_amdgcn_mfma_f32_16x16x32_bf16(bl, ah, acc[t], 0, 0, 0); }
            }
#pragma unroll
            for (int t = 0; t < 3; ++t) *(LAS f32x4*)(LGP + (kh * 64 + rl) * 48 + 16 * t + 4 * fq) = acc[t];
        }
        __syncthreads();
        if (F.tid < 64) {
            const int rl = F.tid, r = 64 * rb + rl; const LAS float* l0 = LGP + rl * 48; const LAS float* l1 = LGP + (64 + rl) * 48;
            float gl[4];
#pragma unroll
            for (int g = 0; g < 4; ++g) gl[g] = l0[g] + l1[g] + F.b_rg()[g];
            int gs = 0; float gm = gl[0];
#pragma unroll
            for (int g = 1; g < 4; ++g) if (gl[g] > gm) { gm = gl[g]; gs = g; }
            float gsum = 0.f;
#pragma unroll
            for (int g = 0; g < 4; ++g) gsum += expf(gl[g] - gm);
            const float pg = 1.f / gsum;
            float el[8];
#pragma unroll
            for (int j = 0; j < 8; ++j) el[j] = l0[4 + 8 * gs + j] + l1[4 + 8 * gs + j] + F.b_re()[8 * gs + j];
            int i0 = 0; float m0 = el[0];
#pragma unroll
            for (int j = 1; j < 8; ++j) if (el[j] > m0) { m0 = el[j]; i0 = j; }
            int i1 = -1; float m1 = -3.0e38f;
#pragma unroll
            for (int j = 0; j < 8; ++j) if (j != i0 && el[j] > m1) { m1 = el[j]; i1 = j; }
            const float x1 = expf(m1 - m0), w0 = pg / (1.f + x1), w1 = pg * x1 / (1.f + x1);
            const int e0 = gs * 8 + i0, e1 = gs * 8 + i1;
            const int sl0 = __hip_atomic_fetch_add(&HC[e0], 1, __ATOMIC_RELAXED, __HIP_MEMORY_SCOPE_WORKGROUP), sl1 = __hip_atomic_fetch_add(&HC[e1], 1, __ATOMIC_RELAXED, __HIP_MEMORY_SCOPE_WORKGROUP);
            F.TOKE()[2 * r] = e0; F.TOKE()[2 * r + 1] = e1; F.TOKW()[2 * r] = w0; F.TOKW()[2 * r + 1] = w1; F.TOKS()[2 * r] = sl0; F.TOKS()[2 * r + 1] = sl1;
        }
        __syncthreads();
        if (F.tid < 32) HB[F.tid] = (int)__hip_atomic_fetch_add(F.ctl() + CW_CNT + F.tid, (unsigned)HC[F.tid], __ATOMIC_RELAXED, __HIP_MEMORY_SCOPE_AGENT);
        __syncthreads();
        if (F.tid < 64) { const int r = 64 * rb + F.tid; F.TOKS()[2 * r] += HB[F.TOKE()[2 * r]]; F.TOKS()[2 * r + 1] += HB[F.TOKE()[2 * r + 1]]; }
        __syncthreads();
    }
}

DI int moe_tables(Frame& F) {
    LAS int* TE = (LAS int*)(F.lds + TILEE_OFF); LAS int* RB = TE + XS_TILES; LAS int* NTp = RB + 32;
    __syncthreads();
    if (F.tid == 0) { int tb = 0; for (int e = 0; e < NE; ++e) { const int cnt = (int)__hip_atomic_load(F.ctl() + CW_CNT + e, __ATOMIC_RELAXED, __HIP_MEMORY_SCOPE_AGENT); int nt = (cnt + 255) >> 8; if (tb + nt > XS_TILES) nt = XS_TILES - tb;
            RB[e] = tb * 256; for (int i = 0; i < nt; ++i) TE[tb + i] = e; tb += nt; } NTp[0] = tb; }
    __syncthreads();
    return NTp[0];
}
DI void p9_gather(Frame& F) {
    (void)moe_tables(F);
    const LAS int* RB = (const LAS int*)(F.lds + TILEE_OFF) + XS_TILES;
    const int gw = F.bid * 8 + F.wave, NGW = F.G * 8;
    for (int a = gw; a < 2 * T; a += NGW) { const int r = a >> 1; const int e = F.TOKE()[a]; const int pos = RB[e] + F.TOKS()[a];
        if (F.lane == 0) F.TOKP()[a] = pos;
        const GAS u32x4* src = (const GAS u32x4*)(F.U2() + (size_t)r * D) + F.lane; GAS u32x4* dst = (GAS u32x4*)(F.XS() + (size_t)pos * D) + F.lane;
#pragma unroll
        for (int j = 0; j < 4; ++j) dst[64 * j] = src[64 * j]; }
}
DI void p12_rows(Frame& F) {
    const int gw = F.bid * 8 + F.wave, NGW = F.G * 8; const float* g2 = F.MOD() + 5 * 2048;
    for (int r = gw; r < T; r += NGW) {
        GAS f32x4* xr = (GAS f32x4*)(F.out() + (size_t)r * D) + F.lane;
        const int p0 = F.TOKP()[2 * r], p1 = F.TOKP()[2 * r + 1]; const float w0 = F.TOKW()[2 * r], w1 = F.TOKW()[2 * r + 1];
        const GAS u32x2* y0 = (const GAS u32x2*)(F.YS() + (size_t)p0 * D) + F.lane; const GAS u32x2* y1 = (const GAS u32x2*)(F.YS() + (size_t)p1 * D) + F.lane;
        f32x4 v[8]; float s = 0.f;
#pragma unroll
        for (int j = 0; j < 8; ++j) { const f32x4 f = unpack4(y0[64 * j]) * w0 + unpack4(y1[64 * j]) * w1; const f32x4 g = *(const f32x4*)(g2 + 4 * F.lane + 256 * j);
            v[j] = xr[64 * j] * ALPHA + g * f; s += (v[j][0] + v[j][1]) + (v[j][2] + v[j][3]); }
        const float mean = wave_sum(s) * (1.f / D); float s2 = 0.f;
#pragma unroll
        for (int j = 0; j < 8; ++j) { v[j] = v[j] - mean; s2 += (v[j][0] * v[j][0] + v[j][1] * v[j][1]) + (v[j][2] * v[j][2] + v[j][3] * v[j][3]); }
        const float rstd = 1.f / sqrtf(wave_sum(s2) * (1.f / D) + LN_EPS);
#pragma unroll
        for (int j = 0; j < 8; ++j) { const f32x4 g = *(const f32x4*)(F.ln2_g() + 4 * F.lane + 256 * j), b = *(const f32x4*)(F.ln2_b() + 4 * F.lane + 256 * j); xr[64 * j] = v[j] * rstd * g + b; }
    }
}

__global__ void __launch_bounds__(512, 2) mk_fwd(Args args) {
    extern __shared__ __attribute__((aligned(16))) unsigned char lds[];
    Frame F;
    F.lds = (LAS unsigned char*)lds;
    F.tid = threadIdx.x; F.lane = F.tid & 63; F.wave = __builtin_amdgcn_readfirstlane(F.tid >> 6); F.bid = blockIdx.x; F.G = gridDim.x;
    F.a = &args; F.ws = args.ws;
    for (int u = F.tid; u < (LDS_BYTES - LDSCTL_OFF) / 4; u += 512) ((LAS unsigned*)(F.lds + LDSCTL_OFF))[u] = 0u;
    __syncthreads();
    const int lo = args.ph_lo, hi = args.ph_hi;
    const bool fused = (hi - lo) > 1;
    XcdBarrier bar; bar.bar = F.ctl() + CW_BAR; bar.x = 0; bar.st = nullptr;
    if (fused) bar = xcd_barrier_post(F.ctl() + CW_BAR, (volatile LAS unsigned*)(F.lds + MISC_OFF));
#ifndef PH_MASK
#define PH_MASK 0x1fff
#endif
#define IN(k) (((PH_MASK >> (k)) & 1) && lo <= (k) && (k) < hi)
#define SEAM(k) do { if (IN(k) && IN((k) + 1)) xcd_barrier(bar); PEND(k); PSTART((k) + 1); } while (0)
#ifdef PROBE_MASK
    unsigned long long p_t = __builtin_amdgcn_s_memrealtime(), p_acc = 0;
#define PSTART(k) do { if ((PROBE_MASK >> (k)) & 1) p_t = __builtin_amdgcn_s_memrealtime(); } while (0)
#define PEND(k) do { if ((PROBE_MASK >> (k)) & 1) p_acc += __builtin_amdgcn_s_memrealtime() - p_t; } while (0)
#else
#define PSTART(k) do { } while (0)
#define PEND(k) do { } while (0)
#endif

    if (IN(0)) { p0_prologue(F); } SEAM(0);
    if (IN(1)) { p1_rows(F); } SEAM(1);
    if (IN(2)) {
        pg8::SchedGrid<0> S; S.nM = TR / 256; S.nN = NPAD / 256; S.nwg = S.nM * S.nN; S.G = F.G; S.c = F.bid; S.A = (const char*)F.U(); S.B = (const char*)F.WIN(); S.a_tile = (size_t)256 * 2048 * 2; S.b_tile = (size_t)256 * 2048 * 2; S.a_split = 0; S.b_split = 0;
        pg8::EpiProj E{F.PROJ(), F.GATES(), F.b_in()};
        pg8::gemm_phase<pg8::EpiProj, pg8::SchedGrid<0>, true>(F.lds, 2048, 2048, 2048, S, E);
    } SEAM(2);
    if (IN(3)) {
        int cur_g = -1, cur_h = -1;
        for (int u = F.bid; u < 1024 + NCH * 8; u += F.G) { if (u < 1024) { PSTART(13); gmlp_unit(F, u >> 3, u & 7, cur_g); PEND(13); } else { const int v = u - 1024; PSTART(14); mprep_unit(F, v >> 3, v & 7, cur_h); PEND(14); } }
    } SEAM(3);
    if (IN(4)) { for (int u = F.bid; u < 256; u += F.G) scan_item(F, u >> 4, u & 15); } SEAM(4);
    if (IN(5)) { for (int u = F.bid; u < 1024; u += F.G) x3_unit(F, u >> 3, u & 7); } SEAM(5);
    if (IN(6)) {
        pg8::SchedGrid<1> S; S.nM = T / 256; S.nN = 8; S.nwg = S.nM * S.nN; S.G = F.G; S.c = F.bid; S.A = (const char*)F.AB(); S.B = (const char*)F.PAB(); S.a_tile = (size_t)256 * 2048 * 2; S.b_tile = (size_t)256 * 2048 * 2; S.a_split = 2048; S.b_split = 2048;
        pg8::EpiMerge E{F.Z(), F.PROJ()};
        pg8::gemm_phase<pg8::EpiMerge, pg8::SchedGrid<1>, true>(F.lds, 1024, 2048, 2048, S, E);
    } SEAM(6);
    if (IN(7)) {
        pg8::SchedGrid<0> S; S.nM = T / 256; S.nN = 8; S.nwg = S.nM * S.nN; S.G = F.G; S.c = F.bid; S.A = (const char*)F.Z(); S.B = (const char*)F.WO(); S.a_tile = (size_t)256 * 2048 * 2; S.b_tile = (size_t)256 * 2048 * 2; S.a_split = 0; S.b_split = 0;
        pg8::EpiWo E{F.x(), F.out(), F.MOD() + 2 * 2048};
        pg8::gemm_phase<pg8::EpiWo, pg8::SchedGrid<0>, true>(F.lds, 2048, 2048, 2048, S, E);
    } SEAM(7);
    if (IN(8)) { p8_rows(F); } SEAM(8);
    if (IN(9)) { p9_gather(F); } SEAM(9);
    if (IN(10)) {
        const int NT = moe_tables(F);
        pg8::SchedMoe S; S.nwg = NT * 8; S.G = F.G; S.c = F.bid; S.tile_e = (const LAS int*)(F.lds + TILEE_OFF); S.A = (const char*)F.XS(); S.B = (const char*)F.W13(); S.a_tile = (size_t)256 * 2048 * 2; S.b_exp = (size_t)2048 * 2048 * 2; S.b_tile = (size_t)256 * 2048 * 2;
        pg8::EpiMoeUp E{F.H()};
        pg8::gemm_phase<pg8::EpiMoeUp, pg8::SchedMoe, true>(F.lds, 2048, 2048, 2048, S, E);
    } SEAM(10);
    if (IN(11)) {
        const int NT = moe_tables(F);
        pg8::SchedMoe S; S.nwg = NT * 8; S.G = F.G; S.c = F.bid; S.tile_e = (const LAS int*)(F.lds + TILEE_OFF); S.A = (const char*)F.H(); S.B = (const char*)F.W2(); S.a_tile = (size_t)256 * 1024 * 2; S.b_exp = (size_t)2048 * 1024 * 2; S.b_tile = (size_t)256 * 1024 * 2;
        pg8::EpiMoeDown E{F.YS()};
        pg8::gemm_phase<pg8::EpiMoeDown, pg8::SchedMoe, true>(F.lds, 1024, 1024, 1024, S, E);
    } SEAM(11);
    if (IN(12)) { p12_rows(F); }
    PEND(12);
#ifdef PROBE_MASK
    if (fused) xcd_barrier(bar);
    if (F.bid == 0 && F.tid == 0) { const unsigned long long t0 = __builtin_amdgcn_s_memrealtime(); while (__builtin_amdgcn_s_memrealtime() - t0 < p_acc * PROBE_MUL) __builtin_amdgcn_s_sleep(8); }
#endif
#undef IN
#undef SEAM
}

extern "C" void kernel_launch(void* const* d_in, const int* in_sizes, int n_in, void* d_out, int out_size, void* d_ws, size_t ws_size, hipStream_t stream) {
    static int grid = 0;
    if (grid == 0) {
        if (n_in != 32 || out_size != T * D || ws_size < WS_END) { fprintf(stderr, "kernel_launch: unexpected shapes (n_in %d, out %d, ws %zu; need ws >= %zu); nothing launched\n", n_in, out_size, ws_size, (size_t)WS_END); grid = -1; return; }
        int dev = 0, cus = 0, per_cu = 0;
        if (hipGetDevice(&dev) != hipSuccess || hipDeviceGetAttribute(&cus, hipDeviceAttributeMultiprocessorCount, dev) != hipSuccess) { grid = -1; return; }
        if (hipFuncSetAttribute((const void*)mk_fwd, hipFuncAttributeMaxDynamicSharedMemorySize, LDS_BYTES) != hipSuccess) { fprintf(stderr, "kernel_launch: hipFuncSetAttribute failed\n"); grid = -1; return; }
        if (hipOccupancyMaxActiveBlocksPerMultiprocessor(&per_cu, (const void*)mk_fwd, 512, LDS_BYTES) != hipSuccess || per_cu < 1) { fprintf(stderr, "kernel_launch: occupancy query reports %d\n", per_cu); }
        (void)hipGetLastError();
        grid = cus;
    }
    if (grid < 0) return;
    (void)hipMemsetAsync((char*)d_ws + WS_CTL, 0, CTL_ZERO_BYTES, stream);
    Args a{};
    for (int i = 0; i < 32; ++i) a.in[i] = (const float*)d_in[i];
    a.outp = (float*)d_out; a.ws = (unsigned char*)d_ws;
    if (MK_N_LAUNCHES == 1) { a.ph_lo = 0; a.ph_hi = NPHASE; hipLaunchKernelGGL(mk_fwd, dim3(grid), dim3(512), LDS_BYTES, stream, a); }
    else for (int p = 0; p < NPHASE; ++p) { a.ph_lo = p; a.ph_hi = p + 1; hipLaunchKernelGGL(mk_fwd, dim3(grid), dim3(512), LDS_BYTES, stream, a); }
}
```

```cpp
#include <hip/hip_runtime.h>
#include <cstdio>
#include <cstdint>

#ifndef MK_N_LAUNCHES
#define MK_N_LAUNCHES 1
#endif

#define GAS __attribute__((address_space(1)))
#define LAS __attribute__((address_space(3)))
#define DI __device__ __forceinline__
typedef unsigned short u16;
typedef short bf16x8 __attribute__((ext_vector_type(8)));
typedef float f32x4 __attribute__((ext_vector_type(4)));
typedef float f32x2 __attribute__((ext_vector_type(2)));
typedef unsigned u32x4 __attribute__((ext_vector_type(4)));
typedef unsigned u32x2 __attribute__((ext_vector_type(2)));

constexpr int T = 16384, TC = 256, TR = T + TC, D = 2048, DIN = 9248, NPJ = 9216, NPAD = 9472;
constexpr int OFF_UA = 0, OFF_VA = 1024, OFF_XM = 2048, OFF_VB = 3072, OFF_OB = 4096, OFF_GA = 5120, OFF_GB = 7168, OFF_GATES = 9216;
constexpr int NCH = 130;
constexpr int NE = 32, DE = 1024;
constexpr int XS_TILES = 160;
constexpr float LN_EPS = 1e-5f, NEGF = -1e30f, ALPHA = 1.189207115002721f;
constexpr int NPHASE = 13;

constexpr size_t MiB = 1u << 20;
constexpr size_t WS_CTL = 0, CTL_ZERO_BYTES = 1 * MiB;
constexpr size_t WS_MOD = 1 * MiB;
constexpr size_t WS_WRT = 1 * MiB + 512 * 1024;
constexpr size_t WS_WQK = 2 * MiB;
constexpr size_t WS_WSB = 2 * MiB + 512 * 1024;
constexpr size_t WS_GB = 3 * MiB;
constexpr size_t WS_NL = 6 * MiB;
constexpr size_t WS_SC = 7 * MiB + 512 * 1024;
constexpr size_t WS_TOKE = 8 * MiB;
constexpr size_t WS_TOKW = 8 * MiB + 128 * 1024;
constexpr size_t WS_TOKS = 8 * MiB + 256 * 1024;
constexpr size_t WS_TOKP = 8 * MiB + 384 * 1024;
constexpr size_t WS_GATES = 9 * MiB;
constexpr size_t WS_WIN = 16 * MiB;
constexpr size_t WS_PAB = 53 * MiB;
constexpr size_t WS_WO = 61 * MiB;
constexpr size_t WS_W13 = 69 * MiB;
constexpr size_t WS_W2 = 325 * MiB;
constexpr size_t WS_R1 = 453 * MiB;
constexpr size_t WS_XS = WS_R1, WS_H = WS_R1 + 160 * MiB;
constexpr size_t WS_R2 = 746 * MiB;
constexpr size_t WS_R3 = 811 * MiB;
constexpr size_t WS_R4 = 875 * MiB;
constexpr size_t WS_R5 = 940 * MiB;
constexpr size_t WS_YS = WS_R2;
constexpr size_t WS_END = 1004 * MiB;
static_assert(WS_R1 + (size_t)TR * NPJ * 2 <= WS_R2 && WS_H + (size_t)XS_TILES * 256 * 1024 * 2 <= WS_R2, "R1");
static_assert(WS_R2 + (size_t)TR * 2048 * 2 <= WS_R3 && WS_R3 + (size_t)T * 2048 * 2 <= WS_R4 && WS_R4 + (size_t)16 * NCH * 16384 * 2 <= WS_R5 && WS_R5 + (size_t)T * 2048 * 2 <= WS_END, "R2-5");
static_assert(WS_YS + (size_t)XS_TILES * 256 * 2048 * 2 <= WS_R5, "YS");
static_assert(WS_WIN + (size_t)NPAD * 2048 * 2 <= WS_PAB && WS_W13 + (size_t)32 * 2048 * 2048 * 2 <= WS_W2 && WS_W2 + (size_t)32 * 2048 * 1024 * 2 <= WS_R1, "weights");
static_assert(WS_GB + (size_t)8 * TR * 16 <= WS_NL && WS_NL + (size_t)16 * NCH * 128 * 4 <= WS_SC && WS_GATES + (size_t)TR * 32 * 4 <= WS_WIN, "small");
constexpr int CW_CNT = 64;
constexpr int CW_BAR = 4096;

constexpr int RING_BYTES = 131072;
constexpr int LDSCTL_OFF = 147456;
constexpr int MISC_OFF = LDSCTL_OFF + 64;
constexpr int TILEE_OFF = LDSCTL_OFF + 256;
constexpr int LDS_BYTES = 149504;

DI unsigned cvt_pk_bf16(float lo, float hi) { unsigned r; asm volatile("v_cvt_pk_bf16_f32 %0, %1, %2" : "=v"(r) : "v"(lo), "v"(hi)); return r; }
DI unsigned f2bf(float f) { return cvt_pk_bf16(f, 0.f) & 0xffffu; }
DI float bflo(unsigned w) { return __uint_as_float(w << 16); }
DI float bfhi(unsigned w) { return __uint_as_float(w & 0xffff0000u); }
DI u32x2 pack4(f32x4 v) { u32x2 o; o.x = cvt_pk_bf16(v[0], v[1]); o.y = cvt_pk_bf16(v[2], v[3]); return o; }
DI f32x4 unpack4(u32x2 w) { return (f32x4){bflo(w.x), bfhi(w.x), bflo(w.y), bfhi(w.y)}; }
DI float sigmoid_fast(float x) { return __builtin_amdgcn_rcpf(1.f + __builtin_amdgcn_exp2f(-1.4426950408889634f * x)); }
DI float gelu_tanh_fast(float x) { const float y = 1.5957691216057308f * (x + 0.044715f * x * x * x); return x * sigmoid_fast(y); }
DI float logsig(float x) { return x < 0.f ? x - log1pf(expf(x)) : -log1pf(expf(-x)); }
DI float wave_sum(float v) {
#pragma unroll
    for (int o = 1; o < 64; o <<= 1) v += __shfl_xor(v, o);
    return v;
}
DI float wave_max(float v) {
#pragma unroll
    for (int o = 1; o < 64; o <<= 1) v = fmaxf(v, __shfl_xor(v, o));
    return v;
}
#define LDS_WAIT() asm volatile("s_waitcnt lgkmcnt(0)" ::: "memory")

namespace pg8 {
constexpr int BM = 256, BK = 64, HALF = 128, HTB = HALF * BK * 2, STAGE_BYTES = 8 * HTB, NXCD = 8, WGM = 8;
__host__ __device__ __forceinline__ int lds_byte(int r, int c) { const int st = (r >> 4) * 2 + (c >> 5), rr = r & 15, cc = c & 31, ob = rr * 64 + cc * 2; return st * 1024 + (ob ^ (((ob >> 9) & 1) << 5)); }
__host__ __device__ __forceinline__ void stage_rc(int b, int& R, int& C) { const int st = b / 1024, sb = b % 1024, swz = sb ^ (((sb >> 9) & 1) << 5); R = (st >> 1) * 16 + swz / 64; C = (st & 1) * 32 + (swz % 64) / 2; }
__host__ __device__ __forceinline__ int perm32(int rho) { const int n = rho >> 4, i = rho & 15; return 8 * (i >> 2) + 4 * n + (i & 3); }
struct Unit { int pm, pn, ex; };
DI int xcd_remap(int wgid, int nwg) { const int q = nwg / NXCD, r = nwg % NXCD, xcd = wgid % NXCD, off = wgid / NXCD; return (xcd < r ? xcd * (q + 1) : r * (q + 1) + (xcd - r) * q) + off; }

template <int SPLIT> struct SchedGrid {
    int nM, nN, nwg, G, c; const char* A; const char* B; size_t a_tile, b_tile, a_split, b_split;
    DI bool next(int i, Unit& u) const {
        const int j = SPLIT ? (i >> 1) : i; u.ex = SPLIT ? (i & 1) : 0;
        const long L = (long)j * G + c; if (L >= nwg) return false;
        const int wgid = xcd_remap((int)L, nwg);
        const int nig = WGM * nN, gid = wgid / nig, fm = gid * WGM, gsz = (nM - fm) < WGM ? (nM - fm) : WGM;
        u.pm = fm + ((wgid % nig) % gsz); u.pn = (wgid % nig) / gsz; return true;
    }
    DI const char* a_base(const Unit& u) const { return A + (size_t)u.pm * a_tile + (size_t)u.ex * a_split; }
    DI const char* b_base(const Unit& u) const { return B + (size_t)u.pn * b_tile + (size_t)u.ex * b_split; }
    DI void a_ready(const Unit&) const {}
    DI void done(const Unit&) const {}
};
struct SchedMoe {
    int nwg, G, c; const LAS int* tile_e; const char* A; const char* B; size_t a_tile, b_exp, b_tile;
    DI bool next(int i, Unit& u) const {
        const long L = (long)i * G + c; if (L >= nwg) return false;
        const int w = xcd_remap((int)L, nwg); u.pm = w >> 3; u.pn = w & 7; u.ex = __builtin_amdgcn_readfirstlane(tile_e[u.pm]); return true;
    }
    DI const char* a_base(const Unit& u) const { return A + (size_t)u.pm * a_tile; }
    DI const char* b_base(const Unit& u) const { return B + (size_t)u.ex * b_exp + (size_t)u.pn * b_tile; }
    DI void a_ready(const Unit&) const {}
    DI void done(const Unit&) const {}
};

DI void glds16_saddr(const char* sbase, unsigned voff, unsigned lds_dst) {
    unsigned keep;
    asm volatile("s_mov_b32 %0, m0\n\ts_mov_b32 m0, %3\n\ts_nop 2\n\tglobal_load_lds_dwordx4 %1, %2\n\ts_mov_b32 m0, %0" : "=&s"(keep) : "v"(voff), "s"(sbase), "s"(lds_dst) : "memory");
}
template <class Epi, class Sched, bool ALIGN_EPI>
DI void gemm_phase(LAS unsigned char* lds, const int K, const int lda, const int ldb, const Sched& S, const Epi& E) {
    const int tid = threadIdx.x, wid = __builtin_amdgcn_readfirstlane(tid >> 6), lane = tid & 63, wr = wid >> 2, wc = wid & 3, fr = lane & 15, fq = lane >> 4;
    const int nt = K / BK;
    unsigned voffA[2], voffB[2];
#pragma unroll
    for (int i = 0; i < 2; ++i) { int R, C; stage_rc(tid * 16 + i * 8192, R, C); const int Rb = Epi::PERM ? ((R & ~31) + perm32(R & 31)) : R;
        voffA[i] = (unsigned)(R * lda + C) * 2u; voffB[i] = (unsigned)(Rb * ldb + C) * 2u; }
    const size_t kstep = (size_t)(BK * 2);
    const size_t hstepA = (size_t)HALF * lda * 2, hstepB = (size_t)HALF * ldb * 2;
    const unsigned ldsb = (unsigned)(size_t)lds + (unsigned)wid * 1024u;
    const int aoff = lds_byte(wr * 64 + fr, fq * 8), boff = lds_byte(wc * 32 + fr, fq * 8);
#define PG8_SA(b, h) (((b) * 2 + (h)) * HTB)
#define PG8_SB(b, h) ((4 + (b) * 2 + (h)) * HTB)
#define PG8_STAGE(bufoff, gbase, voff) do { _Pragma("unroll") for (int _i = 0; _i < 2; ++_i) glds16_saddr((const char*)(gbase), (voff)[_i], ldsb + (unsigned)((bufoff) + _i * 8192)); } while (0)
#define PG8_LDA(dst, b, h) do { _Pragma("unroll") for (int m = 0; m < 4; ++m) _Pragma("unroll") for (int k = 0; k < 2; ++k) dst[m][k] = *(const LAS bf16x8*)(lds + PG8_SA(b, h) + aoff + m * 2048 + k * 1024); } while (0)
#define PG8_LDB(dst, b, h) do { _Pragma("unroll") for (int n = 0; n < 2; ++n) _Pragma("unroll") for (int k = 0; k < 2; ++k) dst[n][k] = *(const LAS bf16x8*)(lds + PG8_SB(b, h) + boff + n * 2048 + k * 1024); } while (0)
#define PG8_MMA(ai, bj, At, Bt) do { __builtin_amdgcn_s_setprio(1); _Pragma("unroll") for (int m = 0; m < 4; ++m) _Pragma("unroll") for (int n = 0; n < 2; ++n) _Pragma("unroll") for (int k = 0; k < 2; ++k) \
        acc[ai][bj][m][n] = __builtin_amdgcn_mfma_f32_16x16x32_bf16(Bt[n][k], At[m][k], acc[ai][bj][m][n], 0, 0, 0); __builtin_amdgcn_s_setprio(0); } while (0)
#define PG8_WAIT_V(n) asm volatile("s_waitcnt vmcnt(" #n ")" ::: "memory")
#define PG8_WAIT_L(n) asm volatile("s_waitcnt lgkmcnt(" #n ")" ::: "memory")
#define PG8_BAR __builtin_amdgcn_s_barrier()
#define PG8_SCHED __builtin_amdgcn_sched_barrier(0)
    Unit cur, nxt; int ui = 0;
    if (!S.next(0, cur)) return;
    f32x4 acc[2][2][4][2];
#pragma unroll
    for (int a = 0; a < 2; ++a)
#pragma unroll
        for (int b = 0; b < 2; ++b)
#pragma unroll
            for (int m = 0; m < 4; ++m)
#pragma unroll
                for (int n = 0; n < 2; ++n) acc[a][b][m][n] = (f32x4){0.f, 0.f, 0.f, 0.f};
    bf16x8 At[4][2], B0[2][2], B1[2][2];
    const char* cA = S.a_base(cur); const char* cB = S.b_base(cur);
    S.a_ready(cur);
    PG8_STAGE(PG8_SB(0, 0), cB, voffB); PG8_STAGE(PG8_SB(0, 1), cB + hstepB, voffB); PG8_STAGE(PG8_SA(0, 0), cA, voffA); PG8_STAGE(PG8_SA(0, 1), cA + hstepA, voffA);
    if (wr == 1) PG8_BAR;
    PG8_WAIT_V(2); PG8_BAR;
    PG8_STAGE(PG8_SB(1, 0), cB + kstep, voffB); PG8_STAGE(PG8_SA(1, 0), cA + kstep, voffA); PG8_STAGE(PG8_SB(1, 1), cB + hstepB + kstep, voffB);
    PG8_WAIT_V(6); PG8_BAR;
    for (;;) {
        const bool has_next = S.next(ui + 1, nxt);
        const char* nA = has_next ? S.a_base(nxt) : cA; const char* nB = has_next ? S.b_base(nxt) : cB;
#pragma unroll 1
        for (int t = 0; t < nt; t += 2) {
            const bool last = (t == nt - 2);
            const char* a1 = cA + (size_t)(t + 1) * kstep;
            const char* a2 = last ? nA : cA + (size_t)(t + 2) * kstep; const char* b2 = last ? nB : cB + (size_t)(t + 2) * kstep;
            const char* a3 = a2 + kstep; const char* b3 = b2 + kstep;
            if (last && has_next) S.a_ready(nxt);
            PG8_LDB(B0, 0, 0); PG8_LDB(B1, 0, 1); PG8_SCHED; PG8_LDA(At, 0, 0); PG8_STAGE(PG8_SA(1, 1), a1 + hstepA, voffA);
            PG8_WAIT_V(8); PG8_WAIT_L(0); PG8_BAR; PG8_MMA(0, 0, At, B0); PG8_MMA(0, 1, At, B1); PG8_BAR; PG8_SCHED;
            PG8_LDA(At, 0, 1); PG8_STAGE(PG8_SB(0, 0), b2, voffB); PG8_STAGE(PG8_SB(0, 1), b2 + hstepB, voffB); PG8_STAGE(PG8_SA(0, 0), a2, voffA);
            PG8_WAIT_V(8); PG8_WAIT_L(0); PG8_BAR; PG8_MMA(1, 0, At, B0); PG8_MMA(1, 1, At, B1); PG8_BAR; PG8_SCHED;
            PG8_LDB(B0, 1, 0); PG8_LDB(B1, 1, 1); PG8_SCHED; PG8_LDA(At, 1, 0); PG8_STAGE(PG8_SA(0, 1), a2 + hstepA, voffA);
            PG8_WAIT_V(8); PG8_WAIT_L(0); PG8_BAR; PG8_MMA(0, 0, At, B0); PG8_MMA(0, 1, At, B1); PG8_BAR; PG8_SCHED;
            PG8_LDA(At, 1, 1); PG8_STAGE(PG8_SB(1, 0), b3, voffB); PG8_STAGE(PG8_SB(1, 1), b3 + hstepB, voffB); PG8_STAGE(PG8_SA(1, 0), a3, voffA);
            PG8_WAIT_V(8); PG8_WAIT_L(0); PG8_BAR; PG8_MMA(1, 0, At, B0); PG8_MMA(1, 1, At, B1); PG8_BAR; PG8_SCHED;
        }
        if constexpr (ALIGN_EPI) { if (wr == 0) PG8_BAR; }
        E(acc, cur, wr, wc, fr, fq); S.done(cur);
        if (!has_next) break;
#pragma unroll
        for (int a = 0; a < 2; ++a)
#pragma unroll
            for (int b = 0; b < 2; ++b)
#pragma unroll
                for (int m = 0; m < 4; ++m)
#pragma unroll
                    for (int n = 0; n < 2; ++n) acc[a][b][m][n] = (f32x4){0.f, 0.f, 0.f, 0.f};
        cur = nxt; cA = nA; cB = nB; ++ui;
        if constexpr (ALIGN_EPI) { if (wr == 1) PG8_BAR; }
    }
    PG8_WAIT_V(0);
    if constexpr (!ALIGN_EPI) { if (wr == 0) PG8_BAR; }
    PG8_BAR;
#undef PG8_SA
#undef PG8_SB
#undef PG8_STAGE
#undef PG8_LDA
#undef PG8_LDB
#undef PG8_MMA
#undef PG8_WAIT_V
#undef PG8_WAIT_L
#undef PG8_BAR
#undef PG8_SCHED
}

struct EpiProj {
    static constexpr bool PERM = true;
    u16* P; float* gates; const float* bias;
    DI void operator()(const f32x4 (&acc)[2][2][4][2], const Unit& u, int wr, int wc, int fr, int fq) const {
        const int row0 = u.pm * BM + wr * 64 + fr;
        if (u.pn == 36) {
            if (wc == 0) {
                const int c0 = 8 * fq; const f32x4 b0 = *(const f32x4*)(bias + OFF_GATES + c0), b1 = *(const f32x4*)(bias + OFF_GATES + c0 + 4);
#pragma unroll
                for (int ai = 0; ai < 2; ++ai)
#pragma unroll
                    for (int m = 0; m < 4; ++m) { float* g = gates + (size_t)(row0 + ai * HALF + m * 16) * 32 + c0;
                        *(f32x4*)g = acc[ai][0][m][0] + b0; *(f32x4*)(g + 4) = acc[ai][0][m][1] + b1; }
            }
            return;
        }
        const int seg = u.pn >> 2; const int mode = (seg <= 1) ? 1 : ((seg <= 3) ? 0 : 2);
        const int col0 = u.pn * BM + wc * 32 + 8 * fq;
        f32x4 bv[2][2];
#pragma unroll
        for (int bj = 0; bj < 2; ++bj)
#pragma unroll
            for (int n = 0; n < 2; ++n) bv[bj][n] = *(const f32x4*)(bias + col0 + bj * HALF + 4 * n);
#pragma unroll
        for (int ai = 0; ai < 2; ++ai)
#pragma unroll
            for (int m = 0; m < 4; ++m) { u16* rowp = P + (size_t)(row0 + ai * HALF + m * 16) * NPJ + col0;
#pragma unroll
                for (int bj = 0; bj < 2; ++bj) { f32x4 v0 = acc[ai][bj][m][0] + bv[bj][0], v1 = acc[ai][bj][m][1] + bv[bj][1];
                    if (mode == 1) {
#pragma unroll
                        for (int j = 0; j < 4; ++j) { v0[j] = gelu_tanh_fast(v0[j]); v1[j] = gelu_tanh_fast(v1[j]); } }
                    else if (mode == 2) {
#pragma unroll
                        for (int j = 0; j < 4; ++j) { v0[j] = sigmoid_fast(v0[j]); v1[j] = sigmoid_fast(v1[j]); } }
                    u32x4 w; w.x = cvt_pk_bf16(v0[0], v0[1]); w.y = cvt_pk_bf16(v0[2], v0[3]); w.z = cvt_pk_bf16(v1[0], v1[1]); w.w = cvt_pk_bf16(v1[2], v1[3]);
                    *(u32x4*)(rowp + bj * HALF) = w; } }
    }
};
struct EpiMerge {
    static constexpr bool PERM = true;
    u16* Z; const u16* P;
    DI void operator()(const f32x4 (&acc)[2][2][4][2], const Unit& u, int wr, int wc, int fr, int fq) const {
        const int row0 = u.pm * BM + wr * 64 + fr, col0 = u.pn * BM + wc * 32 + 8 * fq, goff = u.ex ? OFF_GB : OFF_GA;
#pragma unroll
        for (int ai = 0; ai < 2; ++ai) {
            u32x4 gq[4][2], zq[4][2];
#pragma unroll
            for (int m = 0; m < 4; ++m) { const size_t row = (size_t)(row0 + ai * HALF + m * 16); const u16* zp = Z + row * 2048 + col0; const u16* gp = P + row * NPJ + goff + col0;
#pragma unroll
                for (int bj = 0; bj < 2; ++bj) { gq[m][bj] = *(const u32x4*)(gp + bj * HALF); zq[m][bj] = u.ex ? *(const u32x4*)(zp + bj * HALF) : (u32x4){0u, 0u, 0u, 0u}; } }
#pragma unroll
            for (int m = 0; m < 4; ++m) { const size_t row = (size_t)(row0 + ai * HALF + m * 16); u16* zp = Z + row * 2048 + col0;
#pragma unroll
                for (int bj = 0; bj < 2; ++bj) { const u32x4 g = gq[m][bj], z = zq[m][bj];
                    const f32x4 v0 = acc[ai][bj][m][0] * (f32x4){bflo(g.x), bfhi(g.x), bflo(g.y), bfhi(g.y)} + (f32x4){bflo(z.x), bfhi(z.x), bflo(z.y), bfhi(z.y)};
                    const f32x4 v1 = acc[ai][bj][m][1] * (f32x4){bflo(g.z), bfhi(g.z), bflo(g.w), bfhi(g.w)} + (f32x4){bflo(z.z), bfhi(z.z), bflo(z.w), bfhi(z.w)};
                    u32x4 w; w.x = cvt_pk_bf16(v0[0], v0[1]); w.y = cvt_pk_bf16(v0[2], v0[3]); w.z = cvt_pk_bf16(v1[0], v1[1]); w.w = cvt_pk_bf16(v1[2], v1[3]);
                    *(u32x4*)(zp + bj * HALF) = w; } }
        }
    }
};
struct EpiWo {
    static constexpr bool PERM = false;
    const float* x; float* R; const float* g1;
    DI void operator()(const f32x4 (&acc)[2][2][4][2], const Unit& u, int wr, int wc, int fr, int fq) const {
        const int row0 = u.pm * BM + wr * 64 + fr, col0 = u.pn * BM + wc * 32 + 4 * fq;
        f32x4 gv[2][2];
#pragma unroll
        for (int bj = 0; bj < 2; ++bj)
#pragma unroll
            for (int n = 0; n < 2; ++n) gv[bj][n] = *(const f32x4*)(g1 + col0 + bj * HALF + n * 16);
#pragma unroll
        for (int ai = 0; ai < 2; ++ai) {
            f32x4 xs[4][2][2];
#pragma unroll
            for (int m = 0; m < 4; ++m) { const size_t off = (size_t)(row0 + ai * HALF + m * 16) * 2048 + col0;
#pragma unroll
                for (int bj = 0; bj < 2; ++bj)
#pragma unroll
                    for (int n = 0; n < 2; ++n) xs[m][bj][n] = *(const f32x4*)(x + off + bj * HALF + n * 16); }
#pragma unroll
            for (int m = 0; m < 4; ++m) { const size_t off = (size_t)(row0 + ai * HALF + m * 16) * 2048 + col0;
#pragma unroll
                for (int bj = 0; bj < 2; ++bj)
#pragma unroll
                    for (int n = 0; n < 2; ++n) *(f32x4*)(R + off + bj * HALF + n * 16) = xs[m][bj][n] * ALPHA + gv[bj][n] * acc[ai][bj][m][n]; }
        }
    }
};
struct EpiMoeUp {
    static constexpr bool PERM = true;
    u16* H;
    DI void operator()(const f32x4 (&acc)[2][2][4][2], const Unit& u, int wr, int wc, int fr, int fq) const {
        const int row0 = u.pm * BM + wr * 64 + fr, col0 = u.pn * HALF + wc * 32 + 8 * fq;
#pragma unroll
        for (int ai = 0; ai < 2; ++ai)
#pragma unroll
            for (int m = 0; m < 4; ++m) { u16* hp = H + (size_t)(row0 + ai * HALF + m * 16) * DE + col0; f32x4 o[2];
#pragma unroll
                for (int n = 0; n < 2; ++n)
#pragma unroll
                    for (int j = 0; j < 4; ++j) { const float a = acc[ai][0][m][n][j]; o[n][j] = a * sigmoid_fast(a) * acc[ai][1][m][n][j]; }
                u32x4 w; w.x = cvt_pk_bf16(o[0][0], o[0][1]); w.y = cvt_pk_bf16(o[0][2], o[0][3]); w.z = cvt_pk_bf16(o[1][0], o[1][1]); w.w = cvt_pk_bf16(o[1][2], o[1][3]);
                *(u32x4*)hp = w; }
    }
};
struct EpiMoeDown {
    static constexpr bool PERM = true;
    u16* Y;
    DI void operator()(const f32x4 (&acc)[2][2][4][2], const Unit& u, int wr, int wc, int fr, int fq) const {
        const int row0 = u.pm * BM + wr * 64 + fr, col0 = u.pn * BM + wc * 32 + 8 * fq;
#pragma unroll
        for (int ai = 0; ai < 2; ++ai)
#pragma unroll
            for (int m = 0; m < 4; ++m) { u16* yp = Y + (size_t)(row0 + ai * HALF + m * 16) * 2048 + col0;
#pragma unroll
                for (int bj = 0; bj < 2; ++bj) { const f32x4 v0 = acc[ai][bj][m][0], v1 = acc[ai][bj][m][1];
                    u32x4 w; w.x = cvt_pk_bf16(v0[0], v0[1]); w.y = cvt_pk_bf16(v0[2], v0[3]); w.z = cvt_pk_bf16(v1[0], v1[1]); w.w = cvt_pk_bf16(v1[2], v1[3]);
                    *(u32x4*)(yp + bj * HALF) = w; } }
    }
};
}

#define XB_TMO      128
#define XB_XCNT(j)  (256  + 64 * (j))
#define XB_XSUB(j)  (1280 + 64 * (j))
#define XB_XGEN(j)  (2304 + 64 * (j))
#define XB_TOP      3328
#define XB_TOPGEN   3392
#define XCD_BAR_WORDS 3456
#define XB_SPIN_CAP (1u << 18)
__device__ __forceinline__ unsigned xb_ld(unsigned* p)              { return __hip_atomic_load(p, __ATOMIC_RELAXED, __HIP_MEMORY_SCOPE_AGENT); }
__device__ __forceinline__ unsigned xb_add(unsigned* p, unsigned v) { return __hip_atomic_fetch_add(p, v, __ATOMIC_RELAXED, __HIP_MEMORY_SCOPE_AGENT); }
__device__ __forceinline__ unsigned xb_xcc_id() { return (unsigned)__builtin_amdgcn_s_getreg((3 << 11) | 20) & 0xFu; }
#define XB_SPIN(cond, bar) do { unsigned _sp = 0; while (cond) { __builtin_amdgcn_s_sleep(1); \
    if ((++_sp & 255u) == 0u) { if (xb_ld(&(bar)[XB_TMO])) break; if (_sp > XB_SPIN_CAP) { atomicAdd(&(bar)[XB_TMO], 1u); break; } } } } while (0)
struct XcdBarrier { unsigned* bar; unsigned x; volatile LAS unsigned* st; };
__device__ __forceinline__ XcdBarrier xcd_barrier_post(unsigned* bar, volatile LAS unsigned* st) {
    XcdBarrier b; b.bar = bar; b.x = xb_xcc_id(); b.st = st;
    if (threadIdx.x == 0) (void)xb_add(&bar[XB_XCNT(b.x)], 1u);
    return b;
}
__device__ __forceinline__ void xcd_barrier_complete(unsigned* bar, unsigned x, unsigned& nloc, unsigned& nx) {
    const unsigned G = gridDim.x * gridDim.y * gridDim.z;
    unsigned sum, cnt, mine, sp = 0u;
    for (;;) {
        sum = 0u; cnt = 0u; mine = 0u;
#pragma unroll
        for (unsigned j = 0; j < 16; ++j) { const unsigned c = xb_ld(&bar[XB_XCNT(j)]); sum += c; cnt += (c > 0u) ? 1u : 0u; mine = (j == x) ? c : mine; }
        if (sum == G) break;
        __builtin_amdgcn_s_sleep(1);
        if ((++sp & 255u) == 0u) { if (xb_ld(&bar[XB_TMO])) break; if (sp > XB_SPIN_CAP) { atomicAdd(&bar[XB_TMO], 1u); break; } }
    }
    nloc = mine > 0u ? mine : 1u; nx = cnt > 0u ? cnt : 1u;
}
__device__ __forceinline__ void xcd_barrier(const XcdBarrier& b) {
    asm volatile("s_waitcnt vmcnt(0)" ::: "memory");
    __syncthreads();
    if (threadIdx.x == 0) {
        unsigned* bar = b.bar;
        __builtin_amdgcn_s_waitcnt(0);
        unsigned nloc = b.st[0], nx = b.st[1];
        if (nloc == 0u) { xcd_barrier_complete(bar, b.x, nloc, nx); b.st[0] = nloc; b.st[1] = nx; }
        const unsigned old = xb_add(&bar[XB_XSUB(b.x)], 1u);
        const unsigned gen = old / nloc;
        if (old + 1u == (gen + 1u) * nloc) {
            __builtin_amdgcn_fence(__ATOMIC_RELEASE, "agent");
            asm volatile("s_waitcnt vmcnt(0)" ::: "memory");
            const unsigned og = xb_add(&bar[XB_TOP], 1u);
            const unsigned tg = og / nx;
            if (og + 1u == (tg + 1u) * nx) xb_add(&bar[XB_TOPGEN], 1u);
            else XB_SPIN(xb_ld(&bar[XB_TOPGEN]) == tg, bar);
            __builtin_amdgcn_fence(__ATOMIC_ACQUIRE, "agent");
            xb_add(&bar[XB_XGEN(b.x)], 1u);
            asm volatile("s_waitcnt vmcnt(0)" ::: "memory");
        } else {
            XB_SPIN(xb_ld(&bar[XB_XGEN(b.x)]) == gen, bar);
            __builtin_amdgcn_fence(__ATOMIC_ACQUIRE, "agent");
            asm volatile("s_waitcnt vmcnt(0)" ::: "memory");
        }
    }
    __syncthreads();
}

struct Args { const float* in[32]; float* outp; unsigned char* ws; int ph_lo, ph_hi; };
struct Frame {
    LAS unsigned char* lds;
    int tid, lane, wave, bid, G;
    const Args* a; unsigned char* ws;
    DI const float* in(int i) const { asm("" : "+s"(i)); return a->in[i]; }
    DI const float* x() const { return in(0); }
    DI const float* c() const { return in(1); }
    DI const float* ctx() const { return in(2); }
    DI const float* c_ctx() const { return in(3); }
    DI const float* w_ada() const { return in(4); }
    DI const float* b_ada() const { return in(5); }
    DI const float* w_in() const { return in(6); }
    DI const float* b_in() const { return in(7); }
    DI const float* w_s() const { return in(8); }
    DI const float* b_s() const { return in(9); }
    DI const float* sgu_g() const { return in(10); }
    DI const float* sgu_b() const { return in(11); }
    DI const float* conv_w() const { return in(12); }
    DI const float* conv_b() const { return in(13); }
    DI const float* w_q() const { return in(14); }
    DI const float* w_k() const { return in(15); }
    DI const float* mh_g() const { return in(16); }
    DI const float* skip() const { return in(17); }
    DI const float* p_a() const { return in(18); }
    DI const float* p_b() const { return in(19); }
    DI const float* w_o() const { return in(20); }
    DI const float* ln1_g() const { return in(21); }
    DI const float* ln1_b() const { return in(22); }
    DI const float* w_rg() const { return in(23); }
    DI const float* b_rg() const { return in(24); }
    DI const float* w_re() const { return in(25); }
    DI const float* b_re() const { return in(26); }
    DI const float* w1() const { return in(27); }
    DI const float* w3() const { return in(28); }
    DI const float* w2() const { return in(29); }
    DI const float* ln2_g() const { return in(30); }
    DI const float* ln2_b() const { return in(31); }
    DI unsigned* ctl() const { return (unsigned*)(ws + WS_CTL); }
    DI float* MOD() const { return (float*)(ws + WS_MOD); }
    DI float* WRT() const { return (float*)(ws + WS_WRT); }
    DI float* GB() const { return (float*)(ws + WS_GB); }
    DI float* NL() const { return (float*)(ws + WS_NL); }
    DI float* SC() const { return (float*)(ws + WS_SC); }
    DI float* TOKW() const { return (float*)(ws + WS_TOKW); }
    DI float* GATES() const { return (float*)(ws + WS_GATES); }
    DI int* TOKE() const { return (int*)(ws + WS_TOKE); }
    DI int* TOKS() const { return (int*)(ws + WS_TOKS); }
    DI int* TOKP() const { return (int*)(ws + WS_TOKP); }
    DI u16* WQK() const { return (u16*)(ws + WS_WQK); }
    DI u16* WSB() const { return (u16*)(ws + WS_WSB); }
    DI u16* WIN() const { return (u16*)(ws + WS_WIN); }
    DI u16* PAB() const { return (u16*)(ws + WS_PAB); }
    DI u16* WO() const { return (u16*)(ws + WS_WO); }
    DI u16* W13() const { return (u16*)(ws + WS_W13); }
    DI u16* W2() const { return (u16*)(ws + WS_W2); }
    DI u16* PROJ() const { return (u16*)(ws + WS_R1); }
    DI u16* XS() const { return (u16*)(ws + WS_XS); }
    DI u16* H() const { return (u16*)(ws + WS_H); }
    DI u16* U() const { return (u16*)(ws + WS_R2); }
    DI u16* Q() const { return (u16*)(ws + WS_R2); }
    DI u16* K() const { return (u16*)(ws + WS_R2) + (size_t)TR * 1024; }
    DI u16* U2() const { return (u16*)(ws + WS_R2); }
    DI u16* XC() const { return (u16*)(ws + WS_R3); }
    DI u16* Z() const { return (u16*)(ws + WS_R3); }
    DI u16* ST() const { return (u16*)(ws + WS_R4); }
    DI u16* AB() const { return (u16*)(ws + WS_R5); }
    DI u16* YS() const { return (u16*)(ws + WS_YS); }
    DI float* out() const { return a->outp; }
};

DI bf16x8 ld8(const LAS u16* p) { return *(const LAS bf16x8*)p; }
DI bf16x8 ld8(const GAS u16* p) { return *(const GAS bf16x8*)p; }
template <int NT, class PA, class PB>
DI void wave_mm(f32x4 (&acc)[NT], PA A, int lda, PB B, int ldb, int K, int lane) {
    const int fr = lane & 15, fq = lane >> 4;
#pragma unroll 1
    for (int k0 = 0; k0 < K; k0 += 32) {
        const bf16x8 a = ld8(A + fr * lda + k0 + 8 * fq);
#pragma unroll
        for (int t = 0; t < NT; ++t) { const bf16x8 b = ld8(B + (16 * t + fr) * ldb + k0 + 8 * fq); acc[t] = __builtin_amdgcn_mfma_f32_16x16x32_bf16(b, a, acc[t], 0, 0, 0); }
    }
}
template <int NT> DI void zero_acc(f32x4 (&acc)[NT]) {
#pragma unroll
    for (int t = 0; t < NT; ++t) acc[t] = (f32x4){0.f, 0.f, 0.f, 0.f};
}

DI void p0_gemv(Frame& F, int cb) {
    LAS float* sv = (LAS float*)F.lds;
    LAS float* red = sv + 4096;
    for (int i = F.tid; i < 2048; i += 512) { const float a = F.c()[i], b = F.c_ctx()[i]; sv[i] = a / (1.f + expf(-a)); sv[2048 + i] = b / (1.f + expf(-b)); }
    __syncthreads();
    const int l16 = F.tid & 15, rl = F.tid >> 4;
    f32x4 a1 = (f32x4){0.f, 0.f, 0.f, 0.f}, a2 = a1;
    const float* wp = F.w_ada() + (size_t)rl * 12288 + 64 * cb + 4 * l16;
#pragma unroll 8
    for (int it = 0; it < 64; ++it) { const f32x4 w = *(const GAS f32x4*)(wp + (size_t)it * 32 * 12288); const float s1 = sv[rl + 32 * it], s2 = sv[2048 + rl + 32 * it]; a1 += w * s1; a2 += w * s2; }
    *(LAS f32x4*)(red + (rl * 16 + l16) * 8) = a1; *(LAS f32x4*)(red + (rl * 16 + l16) * 8 + 4) = a2;
    __syncthreads();
    if (F.tid < 128) { const int v = F.tid >> 6, col = F.tid & 63, q16 = col >> 2, j = col & 3; float s = 0.f;
        for (int r = 0; r < 32; ++r) s += red[(r * 16 + q16) * 8 + v * 4 + j];
        F.MOD()[v * 12288 + 64 * cb + col] = s + F.b_ada()[64 * cb + col]; }
    __syncthreads();
}
DI void tr_item(const float* src, int ldn, int k0, int n0, int nvalid, u16* dst, int ldk, int drow0, int dk0, LAS float* scr, int lane) {
    const bool ok = n0 < nvalid;
    f32x4 v[8];
#pragma unroll
    for (int i = 0; i < 8; ++i) { const int kk = 8 * i + (lane >> 3); v[i] = ok ? *(const GAS f32x4*)(src + (size_t)(k0 + kk) * ldn + n0 + 4 * (lane & 7)) : (f32x4){0.f, 0.f, 0.f, 0.f}; }
#pragma unroll
    for (int i = 0; i < 8; ++i) { const int kk = 8 * i + (lane >> 3); LAS float* d = scr + kk * 33 + 4 * (lane & 7); d[0] = v[i][0]; d[1] = v[i][1]; d[2] = v[i][2]; d[3] = v[i][3]; }
    LDS_WAIT(); asm volatile("" ::: "memory");
    const int c = lane & 7;
#pragma unroll
    for (int j = 0; j < 4; ++j) { const int nn = (lane >> 3) + 8 * j; const LAS float* s = scr + (8 * c) * 33 + nn;
        u32x4 o; o.x = cvt_pk_bf16(s[0 * 33], s[1 * 33]); o.y = cvt_pk_bf16(s[2 * 33], s[3 * 33]); o.z = cvt_pk_bf16(s[4 * 33], s[5 * 33]); o.w = cvt_pk_bf16(s[6 * 33], s[7 * 33]);
        *(GAS u32x4*)(dst + (size_t)(drow0 + nn) * ldk + dk0 + 8 * c) = o; }
    LDS_WAIT(); asm volatile("" ::: "memory");
}
DI void p0_prologue(Frame& F) {
    for (int cb = F.bid; cb < 192; cb += F.G) p0_gemv(F, cb);
    LAS float* scr = (LAS float*)(F.lds + F.wave * 16384);
    const int gw = F.bid * 8 + F.wave, NGW = F.G * 8;
    constexpr int I_IN = 32 * (NPAD / 32), I_PA = 16 * 64, I_WO = 32 * 64, I_W1 = 32 * 1024, I_W2 = 32 * 1024, I_QK = 8 * 8;
    constexpr int NITEMS = I_IN + 2 * I_PA + I_WO + 2 * I_W1 + I_W2 + 2 * I_QK;
    for (int it = gw; it < NITEMS; it += NGW) {
        int r = it;
        if (r < I_IN) { const int nb = r % (NPAD / 32), kb = r / (NPAD / 32); tr_item(F.w_in(), DIN, 64 * kb, 32 * nb, DIN, F.WIN(), 2048, 32 * nb, 64 * kb, scr, F.lane); continue; } r -= I_IN;
        if (r < I_PA) { const int nb = r % 64, kb = r / 64; tr_item(F.p_a(), 2048, 64 * kb, 32 * nb, 2048, F.PAB(), 2048, 32 * nb, 64 * kb, scr, F.lane); continue; } r -= I_PA;
        if (r < I_PA) { const int nb = r % 64, kb = r / 64; tr_item(F.p_b(), 2048, 64 * kb, 32 * nb, 2048, F.PAB(), 2048, 32 * nb, 1024 + 64 * kb, scr, F.lane); continue; } r -= I_PA;
        if (r < I_WO) { const int nb = r % 64, kb = r / 64; tr_item(F.w_o(), 2048, 64 * kb, 32 * nb, 2048, F.WO(), 2048, 32 * nb, 64 * kb, scr, F.lane); continue; } r -= I_WO;
        if (r < I_W1) { const int e = r >> 10, rr = r & 1023, nb = rr & 31, kb = rr >> 5, n0 = 32 * nb;
            tr_item(F.w1() + (size_t)e * 2048 * 1024, 1024, 64 * kb, n0, 1024, F.W13() + (size_t)e * 2048 * 2048, 2048, 256 * (n0 >> 7) + (n0 & 127), 64 * kb, scr, F.lane); continue; } r -= I_W1;
        if (r < I_W1) { const int e = r >> 10, rr = r & 1023, nb = rr & 31, kb = rr >> 5, n0 = 32 * nb;
            tr_item(F.w3() + (size_t)e * 2048 * 1024, 1024, 64 * kb, n0, 1024, F.W13() + (size_t)e * 2048 * 2048, 2048, 256 * (n0 >> 7) + 128 + (n0 & 127), 64 * kb, scr, F.lane); continue; } r -= I_W1;
        if (r < I_W2) { const int e = r >> 10, rr = r & 1023, nb = rr & 63, kb = rr >> 6;
            tr_item(F.w2() + (size_t)e * 1024 * 2048, 2048, 64 * kb, 32 * nb, 2048, F.W2() + (size_t)e * 2048 * 1024, 1024, 32 * nb, 64 * kb, scr, F.lane); continue; } r -= I_W2;
        if (r < I_QK) { const int h = r >> 3, rr = r & 7, nb = rr & 3, kb = rr >> 2;
            tr_item(F.w_q() + (size_t)h * 16384, 128, 64 * kb, 32 * nb, 128, F.WQK() + (size_t)h * 32768, 128, 32 * nb, 64 * kb, scr, F.lane); continue; } r -= I_QK;
        { const int h = r >> 3, rr = r & 7, nb = rr & 3, kb = rr >> 2;
            tr_item(F.w_k() + (size_t)h * 16384, 128, 64 * kb, 32 * nb, 128, F.WQK() + (size_t)h * 32768, 128, 128 + 32 * nb, 64 * kb, scr, F.lane); }
    }
    const int gt = F.bid * 512 + F.tid, NGT = F.G * 512;
    for (int i = gt; i < 48 * 2048; i += NGT) { const int j = i >> 11, k = i & 2047; const float w = (j < 4) ? F.w_rg()[k * 4 + j] : (j < 36 ? F.w_re()[k * 32 + (j - 4)] : 0.f);
        const unsigned hi = f2bf(w); const unsigned lo = f2bf(w - __uint_as_float(hi << 16)); u16* wr = (u16*)F.WRT(); wr[i] = (u16)hi; wr[48 * 2048 + i] = (u16)lo; }
    for (int i = gt; i < 8 * 16384; i += NGT) F.WSB()[i] = (u16)f2bf(F.w_s()[i]);
}

DI void p1_rows(Frame& F) {
    const int gw = F.bid * 8 + F.wave, NGW = F.G * 8;
    for (int rr = gw; rr < TR; rr += 2 * NGW) {
        f32x4 v[2][8]; bool ok[2]; int rw[2];
#pragma unroll
        for (int q = 0; q < 2; ++q) { const int r = rr + q * NGW; ok[q] = r < TR; rw[q] = ok[q] ? r : rr;
            const float* src = rw[q] < T ? F.x() + (size_t)rw[q] * D : F.ctx() + (size_t)(rw[q] - T) * D; const GAS f32x4* xr = (const GAS f32x4*)src + F.lane;
#pragma unroll
            for (int j = 0; j < 8; ++j) v[q][j] = xr[64 * j]; }
#pragma unroll
        for (int q = 0; q < 2; ++q) { if (!ok[q]) continue;
            const float* mod = F.MOD() + (rw[q] < T ? 0 : 12288);
            float s = 0.f;
#pragma unroll
            for (int j = 0; j < 8; ++j) s += (v[q][j][0] + v[q][j][1]) + (v[q][j][2] + v[q][j][3]);
            const float mean = wave_sum(s) * (1.f / D); float s2 = 0.f;
#pragma unroll
            for (int j = 0; j < 8; ++j) { v[q][j] = v[q][j] - mean; s2 += (v[q][j][0] * v[q][j][0] + v[q][j][1] * v[q][j][1]) + (v[q][j][2] * v[q][j][2] + v[q][j][3] * v[q][j][3]); }
            const float rstd = 1.f / sqrtf(wave_sum(s2) * (1.f / D) + LN_EPS);
            GAS u32x2* o = (GAS u32x2*)(F.U() + (size_t)rw[q] * D) + F.lane;
#pragma unroll
            for (int j = 0; j < 8; ++j) { const f32x4 sh = *(const f32x4*)(mod + 4 * F.lane + 256 * j), sc = *(const f32x4*)(mod + 2048 + 4 * F.lane + 256 * j);
                o[64 * j] = pack4(v[q][j] * rstd * (sc + 1.f) + sh); } }
    }
}

template <int NT, class PA, class PB>
DI void wave_mm128(f32x4 (&acc)[NT], PA A, int lda, PB B, int ldb, int lane) {
    const int fr = lane & 15, fq = lane >> 4;
    bf16x8 a[4];
#pragma unroll
    for (int ks = 0; ks < 4; ++ks) a[ks] = ld8(A + fr * lda + 32 * ks + 8 * fq);
#pragma unroll
    for (int kp = 0; kp < 2; ++kp) {
        bf16x8 b[2][NT];
#pragma unroll
        for (int kk = 0; kk < 2; ++kk)
#pragma unroll
            for (int t = 0; t < NT; ++t) b[kk][t] = ld8(B + (16 * t + fr) * ldb + 32 * (2 * kp + kk) + 8 * fq);
#pragma unroll
        for (int kk = 0; kk < 2; ++kk)
#pragma unroll
            for (int t = 0; t < NT; ++t) acc[t] = __builtin_amdgcn_mfma_f32_16x16x32_bf16(b[kk][t], a[2 * kp + kk], acc[t], 0, 0, 0);
        __builtin_amdgcn_sched_barrier(0);
    }
}
template <int NT, class PB>
DI void wave_mm128_areg(f32x4 (&acc)[NT], const bf16x8 (&a)[4], PB B, int ldb, int lane) {
    const int fr = lane & 15, fq = lane >> 4;
#pragma unroll
    for (int kp = 0; kp < 2; ++kp) {
        bf16x8 b[2][NT];
#pragma unroll
        for (int kk = 0; kk < 2; ++kk)
#pragma unroll
            for (int t = 0; t < NT; ++t) b[kk][t] = ld8(B + (16 * t + fr) * ldb + 32 * (2 * kp + kk) + 8 * fq);
#pragma unroll
        for (int kk = 0; kk < 2; ++kk)
#pragma unroll
            for (int t = 0; t < NT; ++t) acc[t] = __builtin_amdgcn_mfma_f32_16x16x32_bf16(b[kk][t], a[2 * kp + kk], acc[t], 0, 0, 0);
        __builtin_amdgcn_sched_barrier(0);
    }
}
DI float wave_incl_scan(float v, int lane) {
#pragma unroll
    for (int o = 1; o < 64; o <<= 1) { const float t = __shfl_up(v, o); v = (lane >= o) ? v + t : v; }
    return v;
}
DI float fexp(float x) { return __builtin_amdgcn_exp2f(x * 1.4426950408889634f); }

DI void gmlp_unit(Frame& F, int c, int g, int& cur_g) {
    LAS float* MU = (LAS float*)(F.lds + 140288); LAS float* RS = MU + 128;
    LAS u16* VNT = (LAS u16*)F.lds;
    LAS u16* WSs = (LAS u16*)(F.lds + 34816);
    if (g != cur_g) { cur_g = g;
#pragma unroll
        for (int i = 0; i < 4; ++i) { const int idx = F.tid + 512 * i; *(LAS u32x4*)(WSs + (idx >> 4) * 136 + 8 * (idx & 15)) = *(const GAS u32x4*)(F.WSB() + g * 16384 + (idx >> 4) * 128 + 8 * (idx & 15)); } }
    const int r0 = 128 * c, fr = F.lane & 15, fq = F.lane >> 4;
#pragma unroll 1
    for (int hb = 0; hb < 2; ++hb) {
        u32x4 a[8], b[8];
#pragma unroll
        for (int i = 0; i < 8; ++i) { const GAS u16* p = (const GAS u16*)(F.PROJ() + (size_t)(r0 + 16 * F.wave + 8 * hb + i) * NPJ + OFF_VA + 16 * F.lane); a[i] = *(const GAS u32x4*)p; b[i] = *(const GAS u32x4*)(p + 8); }
#pragma unroll
        for (int i = 0; i < 8; ++i) {
            const float v[16] = {bflo(a[i].x), bfhi(a[i].x), bflo(a[i].y), bfhi(a[i].y), bflo(a[i].z), bfhi(a[i].z), bflo(a[i].w), bfhi(a[i].w), bflo(b[i].x), bfhi(b[i].x), bflo(b[i].y), bfhi(b[i].y), bflo(b[i].z), bfhi(b[i].z), bflo(b[i].w), bfhi(b[i].w)};
            float s = 0.f;
#pragma unroll
            for (int j = 0; j < 16; ++j) s += v[j];
            const float mean = wave_sum(s) * (1.f / 1024.f); float q = 0.f;
#pragma unroll
            for (int j = 0; j < 16; ++j) { const float d = v[j] - mean; q += d * d; }
            const float var = wave_sum(q) * (1.f / 1024.f);
            if (F.lane == 0) { MU[16 * F.wave + 8 * hb + i] = mean; RS[16 * F.wave + 8 * hb + i] = 1.f / sqrtf(var + LN_EPS); } }
    }
    __syncthreads();
    {
        const int c8 = F.tid & 15;
        u32x4 vq[4];
#pragma unroll
        for (int i = 0; i < 4; ++i) vq[i] = *(const GAS u32x4*)(F.PROJ() + (size_t)(r0 + ((F.tid + 512 * i) >> 4)) * NPJ + OFF_VA + 128 * g + 8 * c8);
        const f32x4 g0 = *(const f32x4*)(F.sgu_g() + 128 * g + 8 * c8), g1 = *(const f32x4*)(F.sgu_g() + 128 * g + 8 * c8 + 4), b0 = *(const f32x4*)(F.sgu_b() + 128 * g + 8 * c8), b1 = *(const f32x4*)(F.sgu_b() + 128 * g + 8 * c8 + 4);
        const float gg[8] = {g0[0], g0[1], g0[2], g0[3], g1[0], g1[1], g1[2], g1[3]}, bb[8] = {b0[0], b0[1], b0[2], b0[3], b1[0], b1[1], b1[2], b1[3]};
#pragma unroll
        for (int i = 0; i < 4; ++i) { const int p = (F.tid + 512 * i) >> 4; const u32x4 v = vq[i]; const float mu = MU[p], rs = RS[p];
            const float x[8] = {bflo(v.x), bfhi(v.x), bflo(v.y), bfhi(v.y), bflo(v.z), bfhi(v.z), bflo(v.w), bfhi(v.w)};
#pragma unroll
            for (int j = 0; j < 8; ++j) VNT[(8 * c8 + j) * 136 + p] = (u16)f2bf((x[j] - mu) * rs * gg[j] + bb[j]); }
    }
    __syncthreads();
    const int q = 16 * F.wave + fr; const float bsq = F.b_s()[g * 128 + q];
    u32x2 uaq[8];
#pragma unroll
    for (int t = 0; t < 8; ++t) uaq[t] = *(const GAS u32x2*)(F.PROJ() + (size_t)(r0 + q) * NPJ + OFF_UA + 128 * g + 16 * t + 4 * fq);
    f32x4 acc[8]; zero_acc<8>(acc);
    wave_mm128<8>(acc, (const LAS u16*)(WSs + 16 * F.wave * 136), 136, (const LAS u16*)VNT, 136, F.lane);
#pragma unroll
    for (int t = 0; t < 8; ++t) *(GAS u32x2*)(F.AB() + (size_t)(r0 + q) * 2048 + 128 * g + 16 * t + 4 * fq) = pack4(unpack4(uaq[t]) * (acc[t] + bsq));
    __syncthreads();
}

DI void mprep_unit(Frame& F, int c, int h, int& cur_h) {
    const int r0 = (c < 2) ? T + 128 * c : 128 * (c - 2);
    const int seq_lo = (c < 2) ? T : 0, seq_hi = (c < 2) ? TR - 1 : T - 1;
    LAS u16* XCs = (LAS u16*)F.lds;
    LAS u16* KT = (LAS u16*)(F.lds + 34816);
    LAS u16* WQs = (LAS u16*)(F.lds + 2 * 34816);
    LAS float* GS = (LAS float*)(F.lds + 4 * 34816);
    const int fr = F.lane & 15, fq = F.lane >> 4;
    if (h != cur_h) { cur_h = h;
#pragma unroll
        for (int i = 0; i < 8; ++i) { const int idx = F.tid + 512 * i; *(LAS u32x4*)(WQs + (idx >> 4) * 136 + 8 * (idx & 15)) = *(const GAS u32x4*)(F.WQK() + (size_t)h * 32768 + (idx >> 4) * 128 + 8 * (idx & 15)); } }
    u32x4 vtq[4];
#pragma unroll
    for (int i = 0; i < 4; ++i) { const int idx = F.tid + 512 * i; vtq[i] = *(const GAS u32x4*)(F.PROJ() + (size_t)(r0 + (idx >> 4)) * NPJ + OFF_VB + 128 * h + 8 * (idx & 15)); }
    if (F.wave < 2) {
        const int dir = F.wave; const int s0 = dir ? 127 - 2 * F.lane : 2 * F.lane, s1 = dir ? 126 - 2 * F.lane : 2 * F.lane + 1;
        const float* g0 = F.GATES() + (size_t)(r0 + s0) * 32 + 16 * dir + h; const float* g1 = F.GATES() + (size_t)(r0 + s1) * 32 + 16 * dir + h;
        const float li0 = g0[0], lf0 = logsig(g0[8]), li1 = g1[0], lf1 = logsig(g1[8]);
        const float incl = wave_incl_scan(lf0 + lf1, F.lane);
        const float b1 = incl, b0 = incl - lf1;
        const float bs = __shfl(incl, 63);
        const float l0 = bs - b0 + li0, l1 = bs - b1 + li1;
        const float ml = wave_max(fmaxf(l0, l1));
        GS[128 * dir + s0] = expf(l0 - ml); GS[128 * dir + s1] = expf(l1 - ml);
        if (F.lane == 0) { float* sc = F.SC() + (size_t)((dir * 8 + h) * NCH + c) * 4; sc[0] = ml; sc[1] = bs; }
        float* gb0 = F.GB() + ((size_t)h * TR + r0 + s0) * 4 + 2 * dir; float* gb1 = F.GB() + ((size_t)h * TR + r0 + s1) * 4 + 2 * dir;
        *(f32x2*)gb0 = (f32x2){li0, b0}; *(f32x2*)gb1 = (f32x2){li1, b1};
    }
    const int cch = 128 * h + 8 * (F.tid & 15);
    f32x4 cw0[2], cw1[2], cw2[2], cbb[2];
#pragma unroll
    for (int hh = 0; hh < 2; ++hh) { cw0[hh] = *(const f32x4*)(F.conv_w() + cch + 4 * hh); cw1[hh] = *(const f32x4*)(F.conv_w() + 1024 + cch + 4 * hh); cw2[hh] = *(const f32x4*)(F.conv_w() + 2048 + cch + 4 * hh); cbb[hh] = *(const f32x4*)(F.conv_b() + cch + 4 * hh); }
    u32x4 xmq[4], xpq[4], xnq[4];
#pragma unroll
    for (int i = 0; i < 4; ++i) { const int row = r0 + ((F.tid + 512 * i) >> 4); const GAS u16* p = (const GAS u16*)(F.PROJ() + (size_t)row * NPJ + OFF_XM + cch); const u32x4 z4 = (u32x4){0u, 0u, 0u, 0u};
        xmq[i] = *(const GAS u32x4*)p; xpq[i] = (row > seq_lo) ? *(const GAS u32x4*)(p - NPJ) : z4; xnq[i] = (row < seq_hi) ? *(const GAS u32x4*)(p + NPJ) : z4; }
#pragma unroll
    for (int i = 0; i < 4; ++i) { const int idx = F.tid + 512 * i, s = idx >> 4, c8 = idx & 15, row = r0 + s, ch = 128 * h + 8 * c8;
        const u32x4 xm = xmq[i], xp = xpq[i], xn = xnq[i];
        float y[8];
#pragma unroll
        for (int hh = 0; hh < 2; ++hh) { const f32x4 w0 = cw0[hh], w1 = cw1[hh], w2 = cw2[hh], cb = cbb[hh];
            const unsigned a0 = hh ? xp.z : xp.x, a1 = hh ? xp.w : xp.y, m0 = hh ? xm.z : xm.x, m1 = hh ? xm.w : xm.y, n0 = hh ? xn.z : xn.x, n1 = hh ? xn.w : xn.y;
            y[4 * hh + 0] = w0[0] * bflo(a0) + w1[0] * bflo(m0) + w2[0] * bflo(n0) + cb[0];
            y[4 * hh + 1] = w0[1] * bfhi(a0) + w1[1] * bfhi(m0) + w2[1] * bfhi(n0) + cb[1];
            y[4 * hh + 2] = w0[2] * bflo(a1) + w1[2] * bflo(m1) + w2[2] * bflo(n1) + cb[2];
            y[4 * hh + 3] = w0[3] * bfhi(a1) + w1[3] * bfhi(m1) + w2[3] * bfhi(n1) + cb[3]; }
#pragma unroll
        for (int j = 0; j < 8; ++j) y[j] = y[j] * sigmoid_fast(y[j]);
        u32x4 o; o.x = cvt_pk_bf16(y[0], y[1]); o.y = cvt_pk_bf16(y[2], y[3]); o.z = cvt_pk_bf16(y[4], y[5]); o.w = cvt_pk_bf16(y[6], y[7]);
        *(LAS u32x4*)(XCs + s * 136 + 8 * c8) = o; *(GAS u32x4*)(F.XC() + (size_t)row * 1024 + ch) = o; }
    __syncthreads();
    {
        f32x4 aq[8]; zero_acc<8>(aq);
        wave_mm128<8>(aq, (const LAS u16*)(XCs + 16 * F.wave * 136), 136, (const LAS u16*)WQs, 136, F.lane);
        const int s = 16 * F.wave + fr;
#pragma unroll
        for (int t = 0; t < 8; ++t) *(GAS u32x2*)(F.Q() + (size_t)(r0 + s) * 1024 + 128 * h + 16 * t + 4 * fq) = pack4(aq[t]);
        zero_acc<8>(aq);
        wave_mm128<8>(aq, (const LAS u16*)(XCs + 16 * F.wave * 136), 136, (const LAS u16*)(WQs + 128 * 136), 136, F.lane);
#pragma unroll
        for (int t = 0; t < 8; ++t) *(GAS u32x2*)(F.K() + (size_t)(r0 + s) * 1024 + 128 * h + 16 * t + 4 * fq) = pack4(aq[t] * 0.08838834764831845f);
        zero_acc<8>(aq);
        wave_mm128<8>(aq, (const LAS u16*)(WQs + (128 + 16 * F.wave) * 136), 136, (const LAS u16*)XCs, 136, F.lane);
        const int d = 16 * F.wave + fr;
#pragma unroll
        for (int t = 0; t < 8; ++t) *(LAS u32x2*)(KT + d * 136 + 16 * t + 4 * fq) = pack4(aq[t] * 0.08838834764831845f);
    }
    __syncthreads();
#pragma unroll
    for (int i = 0; i < 4; ++i) { const int idx = F.tid + 512 * i, s = idx >> 4, c8 = idx & 15;
        const unsigned w[4] = {vtq[i].x, vtq[i].y, vtq[i].z, vtq[i].w};
#pragma unroll
        for (int j = 0; j < 4; ++j) { XCs[(8 * c8 + 2 * j) * 136 + s] = (u16)(w[j] & 0xffffu); XCs[(8 * c8 + 2 * j + 1) * 136 + s] = (u16)(w[j] >> 16); } }
    __syncthreads();
#pragma unroll
    for (int dir = 0; dir < 2; ++dir) {
        f32x4 cf[8]; zero_acc<8>(cf);
#pragma unroll
        for (int ks = 0; ks < 4; ++ks) {
            const u32x4 av = *(const LAS u32x4*)(XCs + (16 * F.wave + fr) * 136 + 32 * ks + 8 * fq);
            const f32x4 w0 = *(const LAS f32x4*)(GS + 128 * dir + 32 * ks + 8 * fq), w1 = *(const LAS f32x4*)(GS + 128 * dir + 32 * ks + 8 * fq + 4);
            u32x4 sv; sv.x = cvt_pk_bf16(bflo(av.x) * w0[0], bfhi(av.x) * w0[1]); sv.y = cvt_pk_bf16(bflo(av.y) * w0[2], bfhi(av.y) * w0[3]);
            sv.z = cvt_pk_bf16(bflo(av.z) * w1[0], bfhi(av.z) * w1[1]); sv.w = cvt_pk_bf16(bflo(av.w) * w1[2], bfhi(av.w) * w1[3]);
            const bf16x8 a = __builtin_bit_cast(bf16x8, sv);
#pragma unroll
            for (int t = 0; t < 8; ++t) { const bf16x8 b = ld8((const LAS u16*)(KT + (16 * t + fr) * 136 + 32 * ks + 8 * fq)); cf[t] = __builtin_amdgcn_mfma_f32_16x16x32_bf16(b, a, cf[t], 0, 0, 0); }
        }
        u16* st = F.ST() + ((size_t)((dir * 8 + h) * NCH + c) * 16384) + (16 * F.wave + fr) * 128;
#pragma unroll
        for (int t = 0; t < 8; ++t) *(GAS u32x2*)(st + 16 * t + 4 * fq) = pack4(cf[t]);
    }
    if (F.tid < 256) { const int dir = F.tid >> 7, d = F.tid & 127; const LAS u16* kt = KT + d * 136; const LAS float* w = GS + 128 * dir; float s = 0.f;
#pragma unroll
        for (int i = 0; i < 16; ++i) { const u32x4 v = *(const LAS u32x4*)(kt + 8 * i); const f32x4 w0 = *(const LAS f32x4*)(w + 8 * i), w1 = *(const LAS f32x4*)(w + 8 * i + 4);
            s += ((bflo(v.x) * w0[0] + bfhi(v.x) * w0[1]) + (bflo(v.y) * w0[2] + bfhi(v.y) * w0[3])) + ((bflo(v.z) * w1[0] + bfhi(v.z) * w1[1]) + (bflo(v.w) * w1[2] + bfhi(v.w) * w1[3])); }
        F.NL()[(size_t)((dir * 8 + h) * NCH + c) * 128 + d] = s; }
    __syncthreads();
}

DI int scan_order(int dir, int j) { return dir == 0 ? j : (j == 0 ? 1 : (j == 1 ? 0 : 131 - j)); }
DI void scan_item(Frame& F, int dh, int blk) {
    const int dir = dh >> 3;
    LAS float* ML = (LAS float*)F.lds; LAS float* BS = ML + 136; LAS float* DEC = ML + 272; LAS float* SCL = ML + 408; LAS float* MB = ML + 544;
    if (F.tid < NCH) { const int cj = scan_order(dir, F.tid); const float* sc = F.SC() + (size_t)(dh * NCH + cj) * 4; ML[F.tid] = sc[0]; BS[F.tid] = sc[1]; }
    __syncthreads();
    if (F.tid == 0) { float m = NEGF; for (int j = 0; j < NCH; ++j) { MB[j] = m; const float mn = fmaxf(BS[j] + m, ML[j]); DEC[j] = fexp(BS[j] + m - mn); SCL[j] = fexp(ML[j] - mn); m = mn; } }
    __syncthreads();
    GAS unsigned* base = (GAS unsigned*)(F.ST() + (size_t)dh * NCH * 16384) + blk * 512 + F.tid;
    float c0 = 0.f, c1 = 0.f;
#pragma unroll 1
    for (int j0 = 0; j0 < NCH; j0 += 26) {
        unsigned kv[26];
#pragma unroll
        for (int jj = 0; jj < 26; ++jj) kv[jj] = base[(size_t)scan_order(dir, j0 + jj) * 8192];
#pragma unroll
        for (int jj = 0; jj < 26; ++jj) { base[(size_t)scan_order(dir, j0 + jj) * 8192] = cvt_pk_bf16(c0, c1);
            const float de = DEC[j0 + jj], sc = SCL[j0 + jj]; c0 = de * c0 + sc * bflo(kv[jj]); c1 = de * c1 + sc * bfhi(kv[jj]); }
    }
    if (blk == 0) {
        if (F.tid < 128) { float n = 0.f; GAS float* nl = (GAS float*)(F.NL() + (size_t)dh * NCH * 128 + F.tid);
#pragma unroll 1
            for (int j0 = 0; j0 < NCH; j0 += 26) { float nv[26];
#pragma unroll
                for (int jj = 0; jj < 26; ++jj) nv[jj] = nl[scan_order(dir, j0 + jj) * 128];
#pragma unroll
                for (int jj = 0; jj < 26; ++jj) { nl[scan_order(dir, j0 + jj) * 128] = n; n = DEC[j0 + jj] * n + SCL[j0 + jj] * nv[jj]; } } }
        if (F.tid >= 256 && F.tid < 256 + NCH) { const int j = F.tid - 256; F.SC()[(size_t)(dh * NCH + scan_order(dir, j)) * 4 + 2] = MB[j]; }
    }
    __syncthreads();
}

DI void x3_unit(Frame& F, int lc, int h) {
    const int c = lc + 2, r0 = 128 * lc, fr = F.lane & 15, fq = F.lane >> 4;
    LAS u16* VT = (LAS u16*)F.lds;
    LAS u16* KS = (LAS u16*)(F.lds + 34816);
    LAS u16* PW = KS + F.wave * 16 * 136;
    LAS u16* SF = (LAS u16*)(F.lds + 2 * 34816);
    LAS u16* SB = (LAS u16*)(F.lds + 3 * 34816);
    LAS float* GS = (LAS float*)(F.lds + 4 * 34816);
    const int ql = 16 * F.wave + fr;
    bf16x8 qa[4];
#pragma unroll
    for (int ks = 0; ks < 4; ++ks) qa[ks] = ld8((const GAS u16*)(F.Q() + (size_t)(r0 + ql) * 1024 + 128 * h + 32 * ks + 8 * fq));
    if (F.tid < 128) { const f32x4 g = *(const GAS f32x4*)(F.GB() + ((size_t)h * TR + r0 + F.tid) * 4); GS[F.tid] = g[0]; GS[128 + F.tid] = g[1]; GS[256 + F.tid] = g[2]; GS[384 + F.tid] = g[3]; }
    else if (F.tid < 384) { const int i = F.tid - 128, dir = i >> 7, d = i & 127; GS[512 + i] = F.NL()[(size_t)((dir * 8 + h) * NCH + c) * 128 + d]; }
    const float mf = F.SC()[(size_t)(h * NCH + c) * 4 + 2], mb = F.SC()[(size_t)((8 + h) * NCH + c) * 4 + 2];
    {
        u32x4 vv[4], s0[4], s1[4], kq[4];
        const GAS u16* stf = (const GAS u16*)(F.ST() + (size_t)(h * NCH + c) * 16384); const GAS u16* stb = (const GAS u16*)(F.ST() + (size_t)((8 + h) * NCH + c) * 16384);
#pragma unroll
        for (int i = 0; i < 4; ++i) { const int idx = F.tid + 512 * i, s = idx >> 4, c8 = idx & 15;
            vv[i] = *(const GAS u32x4*)(F.PROJ() + (size_t)(r0 + s) * NPJ + OFF_VB + 128 * h + 8 * c8); s0[i] = *(const GAS u32x4*)(stf + s * 128 + 8 * c8); s1[i] = *(const GAS u32x4*)(stb + s * 128 + 8 * c8);
            kq[i] = *(const GAS u32x4*)(F.K() + (size_t)(r0 + s) * 1024 + 128 * h + 8 * c8); }
#pragma unroll
        for (int i = 0; i < 4; ++i) { const int idx = F.tid + 512 * i, s = idx >> 4, c8 = idx & 15;
            *(LAS u32x4*)(SF + s * 136 + 8 * c8) = s0[i]; *(LAS u32x4*)(SB + s * 136 + 8 * c8) = s1[i]; *(LAS u32x4*)(KS + s * 136 + 8 * c8) = kq[i];
            const unsigned w[4] = {vv[i].x, vv[i].y, vv[i].z, vv[i].w};
#pragma unroll
            for (int j = 0; j < 4; ++j) { VT[(8 * c8 + 2 * j) * 136 + s] = (u16)(w[j] & 0xffffu); VT[(8 * c8 + 2 * j + 1) * 136 + s] = (u16)(w[j] >> 16); } }
    }
    __syncthreads();
    f32x4 sf[8], sb[8]; zero_acc<8>(sf);
    wave_mm128_areg<8>(sf, qa, (const LAS u16*)KS, 136, F.lane);
    __syncthreads();
    const float bqf = GS[128 + ql], bqb = GS[384 + ql];
    float mxf = -3.0e38f, mxb = -3.0e38f;
#pragma unroll
    for (int t = 0; t < 8; ++t)
#pragma unroll
        for (int r = 0; r < 4; ++r) { const int s = 16 * t + 4 * fq + r; const float df = bqf - GS[128 + s] + GS[s], db = bqb - GS[384 + s] + GS[256 + s];
            mxf = (s <= ql) ? fmaxf(mxf, df) : mxf; mxb = (s >= ql) ? fmaxf(mxb, db) : mxb; }
    mxf = fmaxf(mxf, __shfl_xor(mxf, 16)); mxf = fmaxf(mxf, __shfl_xor(mxf, 32)); mxb = fmaxf(mxb, __shfl_xor(mxb, 16)); mxb = fmaxf(mxb, __shfl_xor(mxb, 32));
    const float mrf = fmaxf(bqf + mf, mxf), mrb = fmaxf(bqb + mb, mxb);
    float rsf = 0.f, rsb = 0.f;
#pragma unroll
    for (int t = 0; t < 8; ++t)
#pragma unroll
        for (int r = 0; r < 4; ++r) { const int s = 16 * t + 4 * fq + r; const float df = bqf - GS[128 + s] + GS[s], db = bqb - GS[384 + s] + GS[256 + s];
            const float ef = (s <= ql) ? fexp(df - mrf) : 0.f, eb = (s >= ql) ? fexp(db - mrb) : 0.f; const float s0 = sf[t][r];
            sf[t][r] = s0 * ef; sb[t][r] = s0 * eb; rsf += sf[t][r]; rsb += sb[t][r]; }
    rsf += __shfl_xor(rsf, 16); rsf += __shfl_xor(rsf, 32); rsb += __shfl_xor(rsb, 16); rsb += __shfl_xor(rsb, 32);
    float qnf = 0.f, qnb = 0.f;
#pragma unroll
    for (int i = 0; i < 4; ++i) { const u32x4 qv = __builtin_bit_cast(u32x4, qa[i]); const int d0 = 32 * i + 8 * fq;
        const float qq[8] = {bflo(qv.x), bfhi(qv.x), bflo(qv.y), bfhi(qv.y), bflo(qv.z), bfhi(qv.z), bflo(qv.w), bfhi(qv.w)};
#pragma unroll
        for (int j = 0; j < 8; ++j) { qnf += qq[j] * GS[512 + d0 + j]; qnb += qq[j] * GS[640 + d0 + j]; } }
    qnf += __shfl_xor(qnf, 16); qnf += __shfl_xor(qnf, 32); qnb += __shfl_xor(qnb, 16); qnb += __shfl_xor(qnb, 32);
    const float af = fexp(bqf + mf - mrf), ab = fexp(bqb + mb - mrb);
    const float dnf = fmaxf(fabsf(af * qnf + rsf), fexp(-mrf)), dnb = fmaxf(fabsf(ab * qnb + rsb), fexp(-mrb));
    const float ivf = 1.f / dnf, ivb = 1.f / dnb, rf = af * ivf, rb = ab * ivb;
#pragma unroll
    for (int t = 0; t < 8; ++t) *(LAS u32x2*)(PW + fr * 136 + 16 * t + 4 * fq) = pack4(sf[t] * ivf + sb[t] * ivb);
    LDS_WAIT(); asm volatile("" ::: "memory");
    f32x4 hv[8]; zero_acc<8>(hv);
    wave_mm<8>(hv, (const LAS u16*)PW, 136, (const LAS u16*)VT, 136, 128, F.lane);
    zero_acc<8>(sf);
    wave_mm128_areg<8>(sf, qa, (const LAS u16*)SF, 136, F.lane);
#pragma unroll
    for (int t = 0; t < 8; ++t) hv[t] += sf[t] * rf;
    zero_acc<8>(sb);
    wave_mm128_areg<8>(sb, qa, (const LAS u16*)SB, 136, F.lane);
    float s1 = 0.f;
#pragma unroll
    for (int t = 0; t < 8; ++t) { hv[t] += sb[t] * rb; s1 += (hv[t][0] + hv[t][1]) + (hv[t][2] + hv[t][3]); }
    s1 += __shfl_xor(s1, 16); s1 += __shfl_xor(s1, 32);
    const float mean = s1 * (1.f / 128.f); float s2 = 0.f;
#pragma unroll
    for (int t = 0; t < 8; ++t) { hv[t] = hv[t] - mean; s2 += (hv[t][0] * hv[t][0] + hv[t][1] * hv[t][1]) + (hv[t][2] * hv[t][2] + hv[t][3] * hv[t][3]); }
    s2 += __shfl_xor(s2, 16); s2 += __shfl_xor(s2, 32);
    const float rstd = 1.f / sqrtf(s2 * (1.f / 128.f) + LN_EPS);
    const size_t row = (size_t)(r0 + ql);
#pragma unroll
    for (int hb = 0; hb < 2; ++hb) {
        f32x4 mg[4], sk[4]; u32x2 xcq[4], soq[4];
#pragma unroll
        for (int tt = 0; tt < 4; ++tt) { const int e0 = 128 * h + 16 * (4 * hb + tt) + 4 * fq;
            mg[tt] = *(const f32x4*)(F.mh_g() + e0); sk[tt] = *(const f32x4*)(F.skip() + e0); xcq[tt] = *(const GAS u32x2*)(F.XC() + row * 1024 + e0); soq[tt] = *(const GAS u32x2*)(F.PROJ() + row * NPJ + OFF_OB + e0); }
#pragma unroll
        for (int tt = 0; tt < 4; ++tt) { const int e0 = 128 * h + 16 * (4 * hb + tt) + 4 * fq;
            *(GAS u32x2*)(F.AB() + row * 2048 + 1024 + e0) = pack4(unpack4(soq[tt]) * (hv[4 * hb + tt] * rstd * mg[tt] + sk[tt] * unpack4(xcq[tt]))); }
    }
    __syncthreads();
}

DI void p8_rows(Frame& F) {
    LAS int* HC = (LAS int*)F.lds; LAS int* HB = HC + 32;
    LAS float* ST2 = (LAS float*)(F.lds + 256);
    LAS float* SCP = (LAS float*)(F.lds + 1024);
    LAS float* SHP = SCP + 2048;
    LAS float* LGP = SHP + 2048;
    const float* mod = F.MOD();
    const int fr = F.lane & 15, fq = F.lane >> 4;
    for (int i = F.tid; i < 2048; i += 512) { SCP[i] = 1.f + mod[4 * 2048 + i]; SHP[i] = mod[3 * 2048 + i]; }
    const u16* WRH = (const u16*)F.WRT(); const u16* WRL = WRH + 48 * 2048;
    for (int rb = F.bid; rb < T / 64; rb += F.G) {
        if (F.tid < 32) HC[F.tid] = 0;
        for (int i = 0; i < 8; ++i) {
            const int rl = 8 * F.wave + i, r = 64 * rb + rl;
            GAS f32x4* xr = (GAS f32x4*)(F.out() + (size_t)r * D) + F.lane;
            f32x4 v[8]; float s = 0.f;
#pragma unroll
            for (int j = 0; j < 8; ++j) { v[j] = xr[64 * j]; s += (v[j][0] + v[j][1]) + (v[j][2] + v[j][3]); }
            float mean = wave_sum(s) * (1.f / D), s2 = 0.f;
#pragma unroll
            for (int j = 0; j < 8; ++j) { v[j] = v[j] - mean; s2 += (v[j][0] * v[j][0] + v[j][1] * v[j][1]) + (v[j][2] * v[j][2] + v[j][3] * v[j][3]); }
            float rstd = 1.f / sqrtf(wave_sum(s2) * (1.f / D) + LN_EPS);
            s = 0.f;
#pragma unroll
            for (int j = 0; j < 8; ++j) { const f32x4 g = *(const f32x4*)(F.ln1_g() + 4 * F.lane + 256 * j), b = *(const f32x4*)(F.ln1_b() + 4 * F.lane + 256 * j);
                v[j] = v[j] * rstd * g + b; xr[64 * j] = v[j]; s += (v[j][0] + v[j][1]) + (v[j][2] + v[j][3]); }
            mean = wave_sum(s) * (1.f / D); s2 = 0.f;
#pragma unroll
            for (int j = 0; j < 8; ++j) { const f32x4 d = v[j] - mean; s2 += (d[0] * d[0] + d[1] * d[1]) + (d[2] * d[2] + d[3] * d[3]); }
            rstd = 1.f / sqrtf(wave_sum(s2) * (1.f / D) + LN_EPS);
            if (F.lane == 0) { ST2[2 * rl] = mean; ST2[2 * rl + 1] = rstd; }
        }
        asm volatile("s_waitcnt vmcnt(0)" ::: "memory");
        __syncthreads();
        {
            const int tile = F.wave & 3, kh = F.wave >> 2, rl = 16 * tile + fr; const size_t r = (size_t)(64 * rb + rl);
            const float mean2 = ST2[2 * rl], rstd2 = ST2[2 * rl + 1];
            f32x4 acc[3]; zero_acc<3>(acc);
#pragma unroll 2
            for (int ks = 0; ks < 32; ++ks) {
                const int k = 1024 * kh + 32 * ks + 8 * fq;
                const f32x4 a0 = *(const GAS f32x4*)(F.out() + r * D + k), a1 = *(const GAS f32x4*)(F.out() + r * D + k + 4);
                const f32x4 u0 = (a0 - mean2) * rstd2 * *(const LAS f32x4*)(SCP + k) + *(const LAS f32x4*)(SHP + k);
                const f32x4 u1 = (a1 - mean2) * rstd2 * *(const LAS f32x4*)(SCP + k + 4) + *(const LAS f32x4*)(SHP + k + 4);
                u32x4 hi; hi.x = cvt_pk_bf16(u0[0], u0[1]); hi.y = cvt_pk_bf16(u0[2], u0[3]); hi.z = cvt_pk_bf16(u1[0], u1[1]); hi.w = cvt_pk_bf16(u1[2], u1[3]);
                u32x4 lo; lo.x = cvt_pk_bf16(u0[0] - bflo(hi.x), u0[1] - bfhi(hi.x)); lo.y = cvt_pk_bf16(u0[2] - bflo(hi.y), u0[3] - bfhi(hi.y));
                lo.z = cvt_pk_bf16(u1[0] - bflo(hi.z), u1[1] - bfhi(hi.z)); lo.w = cvt_pk_bf16(u1[2] - bflo(hi.w), u1[3] - bfhi(hi.w));
                *(GAS u32x4*)(F.U2() + r * D + k) = hi;
                const bf16x8 ah = __builtin_bit_cast(bf16x8, hi), al = __builtin_bit_cast(bf16x8, lo);
#pragma unroll
                for (int t = 0; t < 3; ++t) { const bf16x8 bh = ld8((const GAS u16*)(WRH + (16 * t + fr) * 2048 + k)), bl = ld8((const GAS u16*)(WRL + (16 * t + fr) * 2048 + k));
                    acc[t] = __builtin_amdgcn_mfma_f32_16x16x32_bf16(bh, ah, acc[t], 0, 0, 0);
                    acc[t] = __builtin_amdgcn_mfma_f32_16x16x32_bf16(bh, al, acc[t], 0, 0, 0);
                    acc[t] = __builtin_amdgcn_mfma_f32_16x16x32_bf16(bl, ah, acc[t], 0, 0, 0); }
            }
#pragma unroll
            for (int t = 0; t < 3; ++t) *(LAS f32x4*)(LGP + (kh * 64 + rl) * 48 + 16 * t + 4 * fq) = acc[t];
        }
        __syncthreads();
        if (F.tid < 64) {
            const int rl = F.tid, r = 64 * rb + rl; const LAS float* l0 = LGP + rl * 48; const LAS float* l1 = LGP + (64 + rl) * 48;
            float gl[4];
#pragma unroll
            for (int g = 0; g < 4; ++g) gl[g] = l0[g] + l1[g] + F.b_rg()[g];
            int gs = 0; float gm = gl[0];
#pragma unroll
            for (int g = 1; g < 4; ++g) if (gl[g] > gm) { gm = gl[g]; gs = g; }
            float gsum = 0.f;
#pragma unroll
            for (int g = 0; g < 4; ++g) gsum += expf(gl[g] - gm);
            const float pg = 1.f / gsum;
            float el[8];
#pragma unroll
            for (int j = 0; j < 8; ++j) el[j] = l0[4 + 8 * gs + j] + l1[4 + 8 * gs + j] + F.b_re()[8 * gs + j];
            int i0 = 0; float m0 = el[0];
#pragma unroll
            for (int j = 1; j < 8; ++j) if (el[j] > m0) { m0 = el[j]; i0 = j; }
            int i1 = -1; float m1 = -3.0e38f;
#pragma unroll
            for (int j = 0; j < 8; ++j) if (j != i0 && el[j] > m1) { m1 = el[j]; i1 = j; }
            const float x1 = expf(m1 - m0), w0 = pg / (1.f + x1), w1 = pg * x1 / (1.f + x1);
            const int e0 = gs * 8 + i0, e1 = gs * 8 + i1;
            const int sl0 = __hip_atomic_fetch_add(&HC[e0], 1, __ATOMIC_RELAXED, __HIP_MEMORY_SCOPE_WORKGROUP), sl1 = __hip_atomic_fetch_add(&HC[e1], 1, __ATOMIC_RELAXED, __HIP_MEMORY_SCOPE_WORKGROUP);
            F.TOKE()[2 * r] = e0; F.TOKE()[2 * r + 1] = e1; F.TOKW()[2 * r] = w0; F.TOKW()[2 * r + 1] = w1; F.TOKS()[2 * r] = sl0; F.TOKS()[2 * r + 1] = sl1;
        }
        __syncthreads();
        if (F.tid < 32) HB[F.tid] = (int)__hip_atomic_fetch_add(F.ctl() + CW_CNT + F.tid, (unsigned)HC[F.tid], __ATOMIC_RELAXED, __HIP_MEMORY_SCOPE_AGENT);
        __syncthreads();
        if (F.tid < 64) { const int r = 64 * rb + F.tid; F.TOKS()[2 * r] += HB[F.TOKE()[2 * r]]; F.TOKS()[2 * r + 1] += HB[F.TOKE()[2 * r + 1]]; }
        __syncthreads();
    }
}

DI int moe_tables(Frame& F) {
    LAS int* TE = (LAS int*)(F.lds + TILEE_OFF); LAS int* RB = TE + XS_TILES; LAS int* NTp = RB + 32;
    __syncthreads();
    if (F.tid == 0) { int tb = 0; for (int e = 0; e < NE; ++e) { const int cnt = (int)__hip_atomic_load(F.ctl() + CW_CNT + e, __ATOMIC_RELAXED, __HIP_MEMORY_SCOPE_AGENT); int nt = (cnt + 255) >> 8; if (tb + nt > XS_TILES) nt = XS_TILES - tb;
            RB[e] = tb * 256; for (int i = 0; i < nt; ++i) TE[tb + i] = e; tb += nt; } NTp[0] = tb; }
    __syncthreads();
    return NTp[0];
}
DI void p9_gather(Frame& F) {
    (void)moe_tables(F);
    const LAS int* RB = (const LAS int*)(F.lds + TILEE_OFF) + XS_TILES;
    const int gw = F.bid * 8 + F.wave, NGW = F.G * 8;
    for (int a0 = gw; a0 < 2 * T; a0 += 4 * NGW) {
        int pos[4]; u32x4 d[4][4];
#pragma unroll
        for (int q = 0; q < 4; ++q) { const int a = a0 + q * NGW; const bool ok = a < 2 * T; const int aa = ok ? a : a0; pos[q] = ok ? RB[F.TOKE()[aa]] + F.TOKS()[aa] : -1; }
#pragma unroll
        for (int q = 0; q < 4; ++q) { const int a = (a0 + q * NGW) < 2 * T ? a0 + q * NGW : a0; const GAS u32x4* src = (const GAS u32x4*)(F.U2() + (size_t)(a >> 1) * D) + F.lane;
#pragma unroll
            for (int j = 0; j < 4; ++j) d[q][j] = src[64 * j]; }
#pragma unroll
        for (int q = 0; q < 4; ++q) { if (pos[q] < 0) continue; if (F.lane == 0) F.TOKP()[a0 + q * NGW] = pos[q];
            GAS u32x4* dst = (GAS u32x4*)(F.XS() + (size_t)pos[q] * D) + F.lane;
#pragma unroll
            for (int j = 0; j < 4; ++j) dst[64 * j] = d[q][j]; }
    }
}
DI void p12_rows(Frame& F) {
    const int gw = F.bid * 8 + F.wave, NGW = F.G * 8; const float* g2 = F.MOD() + 5 * 2048;
    for (int rr = gw; rr < T; rr += 2 * NGW) {
        f32x4 v[2][8]; u32x2 ya[2][8], yb[2][8]; float w0[2], w1[2]; bool ok[2]; int rw[2];
#pragma unroll
        for (int q = 0; q < 2; ++q) { const int r = rr + q * NGW; ok[q] = r < T; rw[q] = ok[q] ? r : rr;
            const int p0 = F.TOKP()[2 * rw[q]], p1 = F.TOKP()[2 * rw[q] + 1]; w0[q] = F.TOKW()[2 * rw[q]]; w1[q] = F.TOKW()[2 * rw[q] + 1];
            const GAS f32x4* xr = (const GAS f32x4*)(F.out() + (size_t)rw[q] * D) + F.lane;
            const GAS u32x2* y0 = (const GAS u32x2*)(F.YS() + (size_t)p0 * D) + F.lane; const GAS u32x2* y1 = (const GAS u32x2*)(F.YS() + (size_t)p1 * D) + F.lane;
#pragma unroll
            for (int j = 0; j < 8; ++j) { v[q][j] = xr[64 * j]; ya[q][j] = y0[64 * j]; yb[q][j] = y1[64 * j]; } }
#pragma unroll
        for (int q = 0; q < 2; ++q) { if (!ok[q]) continue;
            float s = 0.f;
#pragma unroll
            for (int j = 0; j < 8; ++j) { const f32x4 f = unpack4(ya[q][j]) * w0[q] + unpack4(yb[q][j]) * w1[q]; const f32x4 g = *(const f32x4*)(g2 + 4 * F.lane + 256 * j);
                v[q][j] = v[q][j] * ALPHA + g * f; s += (v[q][j][0] + v[q][j][1]) + (v[q][j][2] + v[q][j][3]); }
            const float mean = wave_sum(s) * (1.f / D); float s2 = 0.f;
#pragma unroll
            for (int j = 0; j < 8; ++j) { v[q][j] = v[q][j] - mean; s2 += (v[q][j][0] * v[q][j][0] + v[q][j][1] * v[q][j][1]) + (v[q][j][2] * v[q][j][2] + v[q][j][3] * v[q][j][3]); }
            const float rstd = 1.f / sqrtf(wave_sum(s2) * (1.f / D) + LN_EPS);
            GAS f32x4* xo = (GAS f32x4*)(F.out() + (size_t)rw[q] * D) + F.lane;
#pragma unroll
            for (int j = 0; j < 8; ++j) { const f32x4 g = *(const f32x4*)(F.ln2_g() + 4 * F.lane + 256 * j), b = *(const f32x4*)(F.ln2_b() + 4 * F.lane + 256 * j); xo[64 * j] = v[q][j] * rstd * g + b; } }
    }
}

__global__ void __launch_bounds__(512, 2) mk_fwd(Args args) {
    extern __shared__ __attribute__((aligned(16))) unsigned char lds[];
    Frame F;
    F.lds = (LAS unsigned char*)lds;
    F.tid = threadIdx.x; F.lane = F.tid & 63; F.wave = __builtin_amdgcn_readfirstlane(F.tid >> 6); F.bid = blockIdx.x; F.G = gridDim.x;
    F.a = &args; F.ws = args.ws;
    for (int u = F.tid; u < (LDS_BYTES - LDSCTL_OFF) / 4; u += 512) ((LAS unsigned*)(F.lds + LDSCTL_OFF))[u] = 0u;
    __syncthreads();
    const int lo = args.ph_lo, hi = args.ph_hi;
    const bool fused = (hi - lo) > 1;
    XcdBarrier bar; bar.bar = F.ctl() + CW_BAR; bar.x = 0; bar.st = nullptr;
    if (fused) bar = xcd_barrier_post(F.ctl() + CW_BAR, (volatile LAS unsigned*)(F.lds + MISC_OFF));
#ifndef PH_MASK
#define PH_MASK 0x1fff
#endif
#define IN(k) (((PH_MASK >> (k)) & 1) && lo <= (k) && (k) < hi)
#define SEAM(k) do { if (IN(k) && IN((k) + 1)) xcd_barrier(bar); PEND(k); PSTART((k) + 1); } while (0)
#ifdef PROBE_MASK
    unsigned long long p_t = __builtin_amdgcn_s_memrealtime(), p_acc = 0;
#define PSTART(k) do { if ((PROBE_MASK >> (k)) & 1) p_t = __builtin_amdgcn_s_memrealtime(); } while (0)
#define PEND(k) do { if ((PROBE_MASK >> (k)) & 1) p_acc += __builtin_amdgcn_s_memrealtime() - p_t; } while (0)
#else
#define PSTART(k) do { } while (0)
#define PEND(k) do { } while (0)
#endif

    if (IN(0)) { p0_prologue(F); } SEAM(0);
    if (IN(1)) { p1_rows(F); } SEAM(1);
    if (IN(2)) {
        pg8::SchedGrid<0> S; S.nM = TR / 256; S.nN = NPAD / 256; S.nwg = S.nM * S.nN; S.G = F.G; S.c = F.bid; S.A = (const char*)F.U(); S.B = (const char*)F.WIN(); S.a_tile = (size_t)256 * 2048 * 2; S.b_tile = (size_t)256 * 2048 * 2; S.a_split = 0; S.b_split = 0;
        pg8::EpiProj E{F.PROJ(), F.GATES(), F.b_in()};
        pg8::gemm_phase<pg8::EpiProj, pg8::SchedGrid<0>, true>(F.lds, 2048, 2048, 2048, S, E);
    } SEAM(2);
    if (IN(3)) {
        int cur_g = -1, cur_h = -1;
        for (int u = F.bid; u < 1024 + NCH * 8; u += F.G) { if (u < 1024) { PSTART(13); gmlp_unit(F, u >> 3, u & 7, cur_g); PEND(13); } else { const int v = u - 1024; PSTART(14); mprep_unit(F, v >> 3, v & 7, cur_h); PEND(14); } }
    } SEAM(3);
    if (IN(4)) { for (int u = F.bid; u < 256; u += F.G) scan_item(F, u >> 4, u & 15); } SEAM(4);
    if (IN(5)) { for (int u = F.bid; u < 1024; u += F.G) x3_unit(F, u >> 3, u & 7); } SEAM(5);
    if (IN(6)) {
        pg8::SchedGrid<1> S; S.nM = T / 256; S.nN = 8; S.nwg = S.nM * S.nN; S.G = F.G; S.c = F.bid; S.A = (const char*)F.AB(); S.B = (const char*)F.PAB(); S.a_tile = (size_t)256 * 2048 * 2; S.b_tile = (size_t)256 * 2048 * 2; S.a_split = 2048; S.b_split = 2048;
        pg8::EpiMerge E{F.Z(), F.PROJ()};
        pg8::gemm_phase<pg8::EpiMerge, pg8::SchedGrid<1>, true>(F.lds, 1024, 2048, 2048, S, E);
    } SEAM(6);
    if (IN(7)) {
        pg8::SchedGrid<0> S; S.nM = T / 256; S.nN = 8; S.nwg = S.nM * S.nN; S.G = F.G; S.c = F.bid; S.A = (const char*)F.Z(); S.B = (const char*)F.WO(); S.a_tile = (size_t)256 * 2048 * 2; S.b_tile = (size_t)256 * 2048 * 2; S.a_split = 0; S.b_split = 0;
        pg8::EpiWo E{F.x(), F.out(), F.MOD() + 2 * 2048};
        pg8::gemm_phase<pg8::EpiWo, pg8::SchedGrid<0>, true>(F.lds, 2048, 2048, 2048, S, E);
    } SEAM(7);
    if (IN(8)) { p8_rows(F); } SEAM(8);
    if (IN(9)) { p9_gather(F); } SEAM(9);
    if (IN(10)) {
        const int NT = moe_tables(F);
        pg8::SchedMoe S; S.nwg = NT * 8; S.G = F.G; S.c = F.bid; S.tile_e = (const LAS int*)(F.lds + TILEE_OFF); S.A = (const char*)F.XS(); S.B = (const char*)F.W13(); S.a_tile = (size_t)256 * 2048 * 2; S.b_exp = (size_t)2048 * 2048 * 2; S.b_tile = (size_t)256 * 2048 * 2;
        pg8::EpiMoeUp E{F.H()};
        pg8::gemm_phase<pg8::EpiMoeUp, pg8::SchedMoe, true>(F.lds, 2048, 2048, 2048, S, E);
    } SEAM(10);
    if (IN(11)) {
        const int NT = moe_tables(F);
        pg8::SchedMoe S; S.nwg = NT * 8; S.G = F.G; S.c = F.bid; S.tile_e = (const LAS int*)(F.lds + TILEE_OFF); S.A = (const char*)F.H(); S.B = (const char*)F.W2(); S.a_tile = (size_t)256 * 1024 * 2; S.b_exp = (size_t)2048 * 1024 * 2; S.b_tile = (size_t)256 * 1024 * 2;
        pg8::EpiMoeDown E{F.YS()};
        pg8::gemm_phase<pg8::EpiMoeDown, pg8::SchedMoe, true>(F.lds, 1024, 1024, 1024, S, E);
    } SEAM(11);
    if (IN(12)) { p12_rows(F); }
    PEND(12);
#ifdef PROBE_MASK
    if (fused) xcd_barrier(bar);
    if (F.bid == 0 && F.tid == 0) { const unsigned long long t0 = __builtin_amdgcn_s_memrealtime(); while (__builtin_amdgcn_s_memrealtime() - t0 < p_acc * PROBE_MUL) __builtin_amdgcn_s_sleep(8); }
#endif
#undef IN
#undef SEAM
}

extern "C" void kernel_launch(void* const* d_in, const int* in_sizes, int n_in, void* d_out, int out_size, void* d_ws, size_t ws_size, hipStream_t stream) {
    static int grid = 0;
    if (grid == 0) {
        if (n_in != 32 || out_size != T * D || ws_size < WS_END) { fprintf(stderr, "kernel_launch: unexpected shapes (n_in %d, out %d, ws %zu; need ws >= %zu); nothing launched\n", n_in, out_size, ws_size, (size_t)WS_END); grid = -1; return; }
        int dev = 0, cus = 0, per_cu = 0;
        if (hipGetDevice(&dev) != hipSuccess || hipDeviceGetAttribute(&cus, hipDeviceAttributeMultiprocessorCount, dev) != hipSuccess) { grid = -1; return; }
        if (hipFuncSetAttribute((const void*)mk_fwd, hipFuncAttributeMaxDynamicSharedMemorySize, LDS_BYTES) != hipSuccess) { fprintf(stderr, "kernel_launch: hipFuncSetAttribute failed\n"); grid = -1; return; }
        if (hipOccupancyMaxActiveBlocksPerMultiprocessor(&per_cu, (const void*)mk_fwd, 512, LDS_BYTES) != hipSuccess || per_cu < 1) { fprintf(stderr, "kernel_launch: occupancy query reports %d\n", per_cu); }
        (void)hipGetLastError();
        grid = cus;
    }
    if (grid < 0) return;
    (void)hipMemsetAsync((char*)d_ws + WS_CTL, 0, CTL_ZERO_BYTES, stream);
    Args a{};
    for (int i = 0; i < 32; ++i) a.in[i] = (const float*)d_in[i];
    a.outp = (float*)d_out; a.ws = (unsigned char*)d_ws;
    if (MK_N_LAUNCHES == 1) { a.ph_lo = 0; a.ph_hi = NPHASE; hipLaunchKernelGGL(mk_fwd, dim3(grid), dim3(512), LDS_BYTES, stream, a); }
    else for (int p = 0; p < NPHASE; ++p) { a.ph_lo = p; a.ph_hi = p + 1; hipLaunchKernelGGL(mk_fwd, dim3(grid), dim3(512), LDS_BYTES, stream, a); }
}
```

```cpp
#include <hip/hip_runtime.h>
#include <cstdio>
#include <cstdint>

#ifndef MK_N_LAUNCHES
#define MK_N_LAUNCHES 1
#endif

#define GAS __attribute__((address_space(1)))
#define LAS __attribute__((address_space(3)))
#define DI __device__ __forceinline__
typedef unsigned short u16;
typedef short bf16x8 __attribute__((ext_vector_type(8)));
typedef float f32x4 __attribute__((ext_vector_type(4)));
typedef float f32x2 __attribute__((ext_vector_type(2)));
typedef unsigned u32x4 __attribute__((ext_vector_type(4)));
typedef unsigned u32x2 __attribute__((ext_vector_type(2)));

constexpr int T = 16384, TC = 256, TR = T + TC, D = 2048, DIN = 9248, NPJ = 9216, NPAD = 9472;
constexpr int OFF_UA = 0, OFF_VA = 1024, OFF_XM = 2048, OFF_VB = 3072, OFF_OB = 4096, OFF_GA = 5120, OFF_GB = 7168, OFF_GATES = 9216;
constexpr int NCH = 130;
constexpr int NE = 32, DE = 1024;
constexpr int XS_TILES = 160;
constexpr float LN_EPS = 1e-5f, NEGF = -1e30f, ALPHA = 1.189207115002721f;
constexpr int NPHASE = 13;

constexpr size_t MiB = 1u << 20;
constexpr size_t WS_CTL = 0, CTL_ZERO_BYTES = 1 * MiB;
constexpr size_t WS_MOD = 1 * MiB;
constexpr size_t WS_WRT = 1 * MiB + 512 * 1024;
constexpr size_t WS_WQK = 2 * MiB;
constexpr size_t WS_WSB = 2 * MiB + 512 * 1024;
constexpr size_t WS_GB = 3 * MiB;
constexpr size_t WS_NL = 6 * MiB;
constexpr size_t WS_SC = 7 * MiB + 512 * 1024;
constexpr size_t WS_TOKE = 8 * MiB;
constexpr size_t WS_TOKW = 8 * MiB + 128 * 1024;
constexpr size_t WS_TOKS = 8 * MiB + 256 * 1024;
constexpr size_t WS_TOKP = 8 * MiB + 384 * 1024;
constexpr size_t WS_GATES = 9 * MiB;
constexpr size_t WS_STATP = 12 * MiB;
constexpr size_t WS_WIN = 16 * MiB;
constexpr size_t WS_PAB = 53 * MiB;
constexpr size_t WS_WO = 61 * MiB;
constexpr size_t WS_W13 = 69 * MiB;
constexpr size_t WS_W2 = 325 * MiB;
constexpr size_t WS_R1 = 453 * MiB;
constexpr size_t WS_XS = WS_R1, WS_H = WS_R1 + 160 * MiB;
constexpr size_t WS_R2 = 746 * MiB;
constexpr size_t WS_R3 = 811 * MiB;
constexpr size_t WS_R4 = 875 * MiB;
constexpr size_t WS_R5 = 940 * MiB;
constexpr size_t WS_YS = WS_R2;
constexpr size_t WS_END = 1004 * MiB;
static_assert(WS_R1 + (size_t)TR * NPJ * 2 <= WS_R2 && WS_H + (size_t)XS_TILES * 256 * 1024 * 2 <= WS_R2, "R1");
static_assert(WS_R2 + (size_t)TR * 2048 * 2 <= WS_R3 && WS_R3 + (size_t)T * 2048 * 2 <= WS_R4 && WS_R4 + (size_t)16 * NCH * 16384 * 2 <= WS_R5 && WS_R5 + (size_t)T * 2048 * 2 <= WS_END, "R2-5");
static_assert(WS_YS + (size_t)XS_TILES * 256 * 2048 * 2 <= WS_R5, "YS");
static_assert(WS_WIN + (size_t)NPAD * 2048 * 2 <= WS_PAB && WS_W13 + (size_t)32 * 2048 * 2048 * 2 <= WS_W2 && WS_W2 + (size_t)32 * 2048 * 1024 * 2 <= WS_R1, "weights");
static_assert(WS_GB + (size_t)8 * TR * 16 <= WS_NL && WS_NL + (size_t)16 * NCH * 128 * 4 <= WS_SC && WS_GATES + (size_t)TR * 32 * 4 <= WS_WIN, "small");
constexpr int CW_CNT = 64;
constexpr int CW_BAR = 4096;

constexpr int RING_BYTES = 131072;
constexpr int LDSCTL_OFF = 147456;
constexpr int MISC_OFF = LDSCTL_OFF + 64;
constexpr int TILEE_OFF = LDSCTL_OFF + 256;
constexpr int LDS_BYTES = 149504;

DI unsigned cvt_pk_bf16(float lo, float hi) { unsigned r; asm volatile("v_cvt_pk_bf16_f32 %0, %1, %2" : "=v"(r) : "v"(lo), "v"(hi)); return r; }
DI unsigned f2bf(float f) { return cvt_pk_bf16(f, 0.f) & 0xffffu; }
DI float bflo(unsigned w) { return __uint_as_float(w << 16); }
DI float bfhi(unsigned w) { return __uint_as_float(w & 0xffff0000u); }
DI u32x2 pack4(f32x4 v) { u32x2 o; o.x = cvt_pk_bf16(v[0], v[1]); o.y = cvt_pk_bf16(v[2], v[3]); return o; }
DI f32x4 unpack4(u32x2 w) { return (f32x4){bflo(w.x), bfhi(w.x), bflo(w.y), bfhi(w.y)}; }
DI float sigmoid_fast(float x) { return __builtin_amdgcn_rcpf(1.f + __builtin_amdgcn_exp2f(-1.4426950408889634f * x)); }
DI float gelu_tanh_fast(float x) { const float y = 1.5957691216057308f * (x + 0.044715f * x * x * x); return x * sigmoid_fast(y); }
DI float logsig(float x) { return x < 0.f ? x - log1pf(expf(x)) : -log1pf(expf(-x)); }
DI float wave_sum(float v) {
#pragma unroll
    for (int o = 1; o < 64; o <<= 1) v += __shfl_xor(v, o);
    return v;
}
DI float wave_max(float v) {
#pragma unroll
    for (int o = 1; o < 64; o <<= 1) v = fmaxf(v, __shfl_xor(v, o));
    return v;
}
#define LDS_WAIT() asm volatile("s_waitcnt lgkmcnt(0)" ::: "memory")

namespace pg8 {
constexpr int BM = 256, BK = 64, HALF = 128, HTB = HALF * BK * 2, STAGE_BYTES = 8 * HTB, NXCD = 8, WGM = 8;
__host__ __device__ __forceinline__ int lds_byte(int r, int c) { const int st = (r >> 4) * 2 + (c >> 5), rr = r & 15, cc = c & 31, ob = rr * 64 + cc * 2; return st * 1024 + (ob ^ (((ob >> 9) & 1) << 5)); }
__host__ __device__ __forceinline__ void stage_rc(int b, int& R, int& C) { const int st = b / 1024, sb = b % 1024, swz = sb ^ (((sb >> 9) & 1) << 5); R = (st >> 1) * 16 + swz / 64; C = (st & 1) * 32 + (swz % 64) / 2; }
__host__ __device__ __forceinline__ int perm32(int rho) { const int n = rho >> 4, i = rho & 15; return 8 * (i >> 2) + 4 * n + (i & 3); }
struct Unit { int pm, pn, ex; };
DI int xcd_remap(int wgid, int nwg) { const int q = nwg / NXCD, r = nwg % NXCD, xcd = wgid % NXCD, off = wgid / NXCD; return (xcd < r ? xcd * (q + 1) : r * (q + 1) + (xcd - r) * q) + off; }

template <int SPLIT> struct SchedGrid {
    int nM, nN, nwg, G, c; const char* A; const char* B; size_t a_tile, b_tile, a_split, b_split;
    DI bool next(int i, Unit& u) const {
        const int j = SPLIT ? (i >> 1) : i; u.ex = SPLIT ? (i & 1) : 0;
        const long L = (long)j * G + c; if (L >= nwg) return false;
        const int wgid = xcd_remap((int)L, nwg);
        const int nig = WGM * nN, gid = wgid / nig, fm = gid * WGM, gsz = (nM - fm) < WGM ? (nM - fm) : WGM;
        u.pm = fm + ((wgid % nig) % gsz); u.pn = (wgid % nig) / gsz; return true;
    }
    DI const char* a_base(const Unit& u) const { return A + (size_t)u.pm * a_tile + (size_t)u.ex * a_split; }
    DI const char* b_base(const Unit& u) const { return B + (size_t)u.pn * b_tile + (size_t)u.ex * b_split; }
    DI void a_ready(const Unit&) const {}
    DI void done(const Unit&) const {}
};
struct SchedMoe {
    int nwg, G, c; const LAS int* tile_e; const char* A; const char* B; size_t a_tile, b_exp, b_tile;
    DI bool next(int i, Unit& u) const {
        const long L = (long)i * G + c; if (L >= nwg) return false;
        const int w = xcd_remap((int)L, nwg); u.pm = w >> 3; u.pn = w & 7; u.ex = __builtin_amdgcn_readfirstlane(tile_e[u.pm]); return true;
    }
    DI const char* a_base(const Unit& u) const { return A + (size_t)u.pm * a_tile; }
    DI const char* b_base(const Unit& u) const { return B + (size_t)u.ex * b_exp + (size_t)u.pn * b_tile; }
    DI void a_ready(const Unit&) const {}
    DI void done(const Unit&) const {}
};

DI void glds16_saddr(const char* sbase, unsigned voff, unsigned lds_dst) {
    unsigned keep;
    asm volatile("s_mov_b32 %0, m0\n\ts_mov_b32 m0, %3\n\ts_nop 2\n\tglobal_load_lds_dwordx4 %1, %2\n\ts_mov_b32 m0, %0" : "=&s"(keep) : "v"(voff), "s"(sbase), "s"(lds_dst) : "memory");
}
template <class Epi, class Sched, bool ALIGN_EPI>
DI void gemm_phase(LAS unsigned char* lds, const int K, const int lda, const int ldb, const Sched& S, const Epi& E) {
    const int tid = threadIdx.x, wid = __builtin_amdgcn_readfirstlane(tid >> 6), lane = tid & 63, wr = wid >> 2, wc = wid & 3, fr = lane & 15, fq = lane >> 4;
    const int nt = K / BK;
    unsigned voffA[2], voffB[2];
#pragma unroll
    for (int i = 0; i < 2; ++i) { int R, C; stage_rc(tid * 16 + i * 8192, R, C); const int Rb = Epi::PERM ? ((R & ~31) + perm32(R & 31)) : R;
        voffA[i] = (unsigned)(R * lda + C) * 2u; voffB[i] = (unsigned)(Rb * ldb + C) * 2u; }
    const size_t kstep = (size_t)(BK * 2);
    const size_t hstepA = (size_t)HALF * lda * 2, hstepB = (size_t)HALF * ldb * 2;
    const unsigned ldsb = (unsigned)(size_t)lds + (unsigned)wid * 1024u;
    const int aoff = lds_byte(wr * 64 + fr, fq * 8), boff = lds_byte(wc * 32 + fr, fq * 8);
#define PG8_SA(b, h) (((b) * 2 + (h)) * HTB)
#define PG8_SB(b, h) ((4 + (b) * 2 + (h)) * HTB)
#define PG8_STAGE(bufoff, gbase, voff) do { _Pragma("unroll") for (int _i = 0; _i < 2; ++_i) glds16_saddr((const char*)(gbase), (voff)[_i], ldsb + (unsigned)((bufoff) + _i * 8192)); } while (0)
#define PG8_LDA(dst, b, h) do { _Pragma("unroll") for (int m = 0; m < 4; ++m) _Pragma("unroll") for (int k = 0; k < 2; ++k) dst[m][k] = *(const LAS bf16x8*)(lds + PG8_SA(b, h) + aoff + m * 2048 + k * 1024); } while (0)
#define PG8_LDB(dst, b, h) do { _Pragma("unroll") for (int n = 0; n < 2; ++n) _Pragma("unroll") for (int k = 0; k < 2; ++k) dst[n][k] = *(const LAS bf16x8*)(lds + PG8_SB(b, h) + boff + n * 2048 + k * 1024); } while (0)
#define PG8_MMA(ai, bj, At, Bt) do { __builtin_amdgcn_s_setprio(1); _Pragma("unroll") for (int m = 0; m < 4; ++m) _Pragma("unroll") for (int n = 0; n < 2; ++n) _Pragma("unroll") for (int k = 0; k < 2; ++k) \
        acc[ai][bj][m][n] = __builtin_amdgcn_mfma_f32_16x16x32_bf16(Bt[n][k], At[m][k], acc[ai][bj][m][n], 0, 0, 0); __builtin_amdgcn_s_setprio(0); } while (0)
#define PG8_WAIT_V(n) asm volatile("s_waitcnt vmcnt(" #n ")" ::: "memory")
#define PG8_WAIT_L(n) asm volatile("s_waitcnt lgkmcnt(" #n ")" ::: "memory")
#define PG8_BAR __builtin_amdgcn_s_barrier()
#define PG8_SCHED __builtin_amdgcn_sched_barrier(0)
    Unit cur, nxt; int ui = 0;
    if (!S.next(0, cur)) return;
    f32x4 acc[2][2][4][2];
#pragma unroll
    for (int a = 0; a < 2; ++a)
#pragma unroll
        for (int b = 0; b < 2; ++b)
#pragma unroll
            for (int m = 0; m < 4; ++m)
#pragma unroll
                for (int n = 0; n < 2; ++n) acc[a][b][m][n] = (f32x4){0.f, 0.f, 0.f, 0.f};
    bf16x8 At[4][2], B0[2][2], B1[2][2];
    const char* cA = S.a_base(cur); const char* cB = S.b_base(cur);
    S.a_ready(cur);
    PG8_STAGE(PG8_SB(0, 0), cB, voffB); PG8_STAGE(PG8_SB(0, 1), cB + hstepB, voffB); PG8_STAGE(PG8_SA(0, 0), cA, voffA); PG8_STAGE(PG8_SA(0, 1), cA + hstepA, voffA);
    if (wr == 1) PG8_BAR;
    PG8_WAIT_V(2); PG8_BAR;
    PG8_STAGE(PG8_SB(1, 0), cB + kstep, voffB); PG8_STAGE(PG8_SA(1, 0), cA + kstep, voffA); PG8_STAGE(PG8_SB(1, 1), cB + hstepB + kstep, voffB);
    PG8_WAIT_V(6); PG8_BAR;
    for (;;) {
        const bool has_next = S.next(ui + 1, nxt);
        const char* nA = has_next ? S.a_base(nxt) : cA; const char* nB = has_next ? S.b_base(nxt) : cB;
#pragma unroll 1
        for (int t = 0; t < nt; t += 2) {
            const bool last = (t == nt - 2);
            const char* a1 = cA + (size_t)(t + 1) * kstep;
            const char* a2 = last ? nA : cA + (size_t)(t + 2) * kstep; const char* b2 = last ? nB : cB + (size_t)(t + 2) * kstep;
            const char* a3 = a2 + kstep; const char* b3 = b2 + kstep;
            if (last && has_next) S.a_ready(nxt);
            PG8_LDB(B0, 0, 0); PG8_LDB(B1, 0, 1); PG8_SCHED; PG8_LDA(At, 0, 0); PG8_STAGE(PG8_SA(1, 1), a1 + hstepA, voffA);
            PG8_WAIT_V(8); PG8_WAIT_L(0); PG8_BAR; PG8_MMA(0, 0, At, B0); PG8_MMA(0, 1, At, B1); PG8_BAR; PG8_SCHED;
            PG8_LDA(At, 0, 1); PG8_STAGE(PG8_SB(0, 0), b2, voffB); PG8_STAGE(PG8_SB(0, 1), b2 + hstepB, voffB); PG8_STAGE(PG8_SA(0, 0), a2, voffA);
            PG8_WAIT_V(8); PG8_WAIT_L(0); PG8_BAR; PG8_MMA(1, 0, At, B0); PG8_MMA(1, 1, At, B1); PG8_BAR; PG8_SCHED;
            PG8_LDB(B0, 1, 0); PG8_LDB(B1, 1, 1); PG8_SCHED; PG8_LDA(At, 1, 0); PG8_STAGE(PG8_SA(0, 1), a2 + hstepA, voffA);
            PG8_WAIT_V(8); PG8_WAIT_L(0); PG8_BAR; PG8_MMA(0, 0, At, B0); PG8_MMA(0, 1, At, B1); PG8_BAR; PG8_SCHED;
            PG8_LDA(At, 1, 1); PG8_STAGE(PG8_SB(1, 0), b3, voffB); PG8_STAGE(PG8_SB(1, 1), b3 + hstepB, voffB); PG8_STAGE(PG8_SA(1, 0), a3, voffA);
            PG8_WAIT_V(8); PG8_WAIT_L(0); PG8_BAR; PG8_MMA(1, 0, At, B0); PG8_MMA(1, 1, At, B1); PG8_BAR; PG8_SCHED;
        }
        if constexpr (ALIGN_EPI) { if (wr == 0) PG8_BAR; }
        E(acc, cur, wr, wc, fr, fq); S.done(cur);
        if (!has_next) break;
#pragma unroll
        for (int a = 0; a < 2; ++a)
#pragma unroll
            for (int b = 0; b < 2; ++b)
#pragma unroll
                for (int m = 0; m < 4; ++m)
#pragma unroll
                    for (int n = 0; n < 2; ++n) acc[a][b][m][n] = (f32x4){0.f, 0.f, 0.f, 0.f};
        cur = nxt; cA = nA; cB = nB; ++ui;
        if constexpr (ALIGN_EPI) { if (wr == 1) PG8_BAR; }
    }
    PG8_WAIT_V(0);
    if constexpr (!ALIGN_EPI) { if (wr == 0) PG8_BAR; }
    PG8_BAR;
#undef PG8_SA
#undef PG8_SB
#undef PG8_STAGE
#undef PG8_LDA
#undef PG8_LDB
#undef PG8_MMA
#undef PG8_WAIT_V
#undef PG8_WAIT_L
#undef PG8_BAR
#undef PG8_SCHED
}

struct EpiProj {
    static constexpr bool PERM = true;
    u16* P; float* gates; const float* bias; float* statp;
    DI void operator()(const f32x4 (&acc)[2][2][4][2], const Unit& u, int wr, int wc, int fr, int fq) const {
        const int row0 = u.pm * BM + wr * 64 + fr;
        if (u.pn == 36) {
            if (wc == 0) {
                const int c0 = 8 * fq; const f32x4 b0 = *(const f32x4*)(bias + OFF_GATES + c0), b1 = *(const f32x4*)(bias + OFF_GATES + c0 + 4);
#pragma unroll
                for (int ai = 0; ai < 2; ++ai)
#pragma unroll
                    for (int m = 0; m < 4; ++m) { float* g = gates + (size_t)(row0 + ai * HALF + m * 16) * 32 + c0;
                        *(f32x4*)g = acc[ai][0][m][0] + b0; *(f32x4*)(g + 4) = acc[ai][0][m][1] + b1; }
            }
            return;
        }
        const int seg = u.pn >> 2; const int mode = (seg <= 1) ? 1 : ((seg <= 3) ? 0 : 2);
        const int col0 = u.pn * BM + wc * 32 + 8 * fq;
        f32x4 bv[2][2];
#pragma unroll
        for (int bj = 0; bj < 2; ++bj)
#pragma unroll
            for (int n = 0; n < 2; ++n) bv[bj][n] = *(const f32x4*)(bias + col0 + bj * HALF + 4 * n);
        float ps[2][4], pq[2][4];
#pragma unroll
        for (int ai = 0; ai < 2; ++ai)
#pragma unroll
            for (int m = 0; m < 4; ++m) { ps[ai][m] = 0.f; pq[ai][m] = 0.f; }
#pragma unroll
        for (int ai = 0; ai < 2; ++ai)
#pragma unroll
            for (int m = 0; m < 4; ++m) { u16* rowp = P + (size_t)(row0 + ai * HALF + m * 16) * NPJ + col0;
#pragma unroll
                for (int bj = 0; bj < 2; ++bj) { f32x4 v0 = acc[ai][bj][m][0] + bv[bj][0], v1 = acc[ai][bj][m][1] + bv[bj][1];
                    if (mode == 1) {
#pragma unroll
                        for (int j = 0; j < 4; ++j) { v0[j] = gelu_tanh_fast(v0[j]); v1[j] = gelu_tanh_fast(v1[j]); } }
                    else if (mode == 2) {
#pragma unroll
                        for (int j = 0; j < 4; ++j) { v0[j] = sigmoid_fast(v0[j]); v1[j] = sigmoid_fast(v1[j]); } }
                    u32x4 w; w.x = cvt_pk_bf16(v0[0], v0[1]); w.y = cvt_pk_bf16(v0[2], v0[3]); w.z = cvt_pk_bf16(v1[0], v1[1]); w.w = cvt_pk_bf16(v1[2], v1[3]);
                    *(u32x4*)(rowp + bj * HALF) = w;
                    if (seg == 1) {
                        const float r8[8] = {bflo(w.x), bfhi(w.x), bflo(w.y), bfhi(w.y), bflo(w.z), bfhi(w.z), bflo(w.w), bfhi(w.w)};
#pragma unroll
                        for (int j = 0; j < 8; ++j) { ps[ai][m] += r8[j]; pq[ai][m] += r8[j] * r8[j]; } } } }
        if (seg == 1) {
#pragma unroll
            for (int ai = 0; ai < 2; ++ai)
#pragma unroll
                for (int m = 0; m < 4; ++m) { float a = ps[ai][m], b = pq[ai][m]; a += __shfl_xor(a, 16); a += __shfl_xor(a, 32); b += __shfl_xor(b, 16); b += __shfl_xor(b, 32);
                    if (fq == 0) *(f32x2*)(statp + (size_t)(row0 + ai * HALF + m * 16) * 32 + ((u.pn & 3) * 4 + wc) * 2) = (f32x2){a, b}; }
        }
    }
};
struct EpiMerge {
    static constexpr bool PERM = true;
    u16* Z; const u16* P;
    DI void operator()(const f32x4 (&acc)[2][2][4][2], const Unit& u, int wr, int wc, int fr, int fq) const {
        const int row0 = u.pm * BM + wr * 64 + fr, col0 = u.pn * BM + wc * 32 + 8 * fq, goff = u.ex ? OFF_GB : OFF_GA;
#pragma unroll
        for (int ai = 0; ai < 2; ++ai) {
            u32x4 gq[4][2], zq[4][2];
#pragma unroll
            for (int m = 0; m < 4; ++m) { const size_t row = (size_t)(row0 + ai * HALF + m * 16); const u16* zp = Z + row * 2048 + col0; const u16* gp = P + row * NPJ + goff + col0;
#pragma unroll
                for (int bj = 0; bj < 2; ++bj) { gq[m][bj] = *(const u32x4*)(gp + bj * HALF); zq[m][bj] = u.ex ? *(const u32x4*)(zp + bj * HALF) : (u32x4){0u, 0u, 0u, 0u}; } }
#pragma unroll
            for (int m = 0; m < 4; ++m) { const size_t row = (size_t)(row0 + ai * HALF + m * 16); u16* zp = Z + row * 2048 + col0;
#pragma unroll
                for (int bj = 0; bj < 2; ++bj) { const u32x4 g = gq[m][bj], z = zq[m][bj];
                    const f32x4 v0 = acc[ai][bj][m][0] * (f32x4){bflo(g.x), bfhi(g.x), bflo(g.y), bfhi(g.y)} + (f32x4){bflo(z.x), bfhi(z.x), bflo(z.y), bfhi(z.y)};
                    const f32x4 v1 = acc[ai][bj][m][1] * (f32x4){bflo(g.z), bfhi(g.z), bflo(g.w), bfhi(g.w)} + (f32x4){bflo(z.z), bfhi(z.z), bflo(z.w), bfhi(z.w)};
                    u32x4 w; w.x = cvt_pk_bf16(v0[0], v0[1]); w.y = cvt_pk_bf16(v0[2], v0[3]); w.z = cvt_pk_bf16(v1[0], v1[1]); w.w = cvt_pk_bf16(v1[2], v1[3]);
                    *(u32x4*)(zp + bj * HALF) = w; } }
        }
    }
};
struct EpiWo {
    static constexpr bool PERM = true;
    const float* x; u16* R; const float* g1;
    DI void operator()(const f32x4 (&acc)[2][2][4][2], const Unit& u, int wr, int wc, int fr, int fq) const {
        const int row0 = u.pm * BM + wr * 64 + fr, col0 = u.pn * BM + wc * 32 + 8 * fq;
        f32x4 gv[2][2];
#pragma unroll
        for (int bj = 0; bj < 2; ++bj)
#pragma unroll
            for (int n = 0; n < 2; ++n) gv[bj][n] = *(const f32x4*)(g1 + col0 + bj * HALF + 4 * n);
#pragma unroll
        for (int ai = 0; ai < 2; ++ai) {
            f32x4 xs[4][2][2];
#pragma unroll
            for (int m = 0; m < 4; ++m) { const size_t off = (size_t)(row0 + ai * HALF + m * 16) * 2048 + col0;
#pragma unroll
                for (int bj = 0; bj < 2; ++bj)
#pragma unroll
                    for (int n = 0; n < 2; ++n) xs[m][bj][n] = *(const f32x4*)(x + off + bj * HALF + 4 * n); }
#pragma unroll
            for (int m = 0; m < 4; ++m) { const size_t off = (size_t)(row0 + ai * HALF + m * 16) * 2048 + col0;
#pragma unroll
                for (int bj = 0; bj < 2; ++bj) { const f32x4 v0 = xs[m][bj][0] * ALPHA + gv[bj][0] * acc[ai][bj][m][0], v1 = xs[m][bj][1] * ALPHA + gv[bj][1] * acc[ai][bj][m][1];
                    u32x4 w; w.x = cvt_pk_bf16(v0[0], v0[1]); w.y = cvt_pk_bf16(v0[2], v0[3]); w.z = cvt_pk_bf16(v1[0], v1[1]); w.w = cvt_pk_bf16(v1[2], v1[3]);
                    *(u32x4*)(R + off + bj * HALF) = w; } }
        }
    }
};
struct EpiMoeUp {
    static constexpr bool PERM = true;
    u16* H;
    DI void operator()(const f32x4 (&acc)[2][2][4][2], const Unit& u, int wr, int wc, int fr, int fq) const {
        const int row0 = u.pm * BM + wr * 64 + fr, col0 = u.pn * HALF + wc * 32 + 8 * fq;
#pragma unroll
        for (int ai = 0; ai < 2; ++ai)
#pragma unroll
            for (int m = 0; m < 4; ++m) { u16* hp = H + (size_t)(row0 + ai * HALF + m * 16) * DE + col0; f32x4 o[2];
#pragma unroll
                for (int n = 0; n < 2; ++n)
#pragma unroll
                    for (int j = 0; j < 4; ++j) { const float a = acc[ai][0][m][n][j]; o[n][j] = a * sigmoid_fast(a) * acc[ai][1][m][n][j]; }
                u32x4 w; w.x = cvt_pk_bf16(o[0][0], o[0][1]); w.y = cvt_pk_bf16(o[0][2], o[0][3]); w.z = cvt_pk_bf16(o[1][0], o[1][1]); w.w = cvt_pk_bf16(o[1][2], o[1][3]);
                *(u32x4*)hp = w; }
    }
};
struct EpiMoeDown {
    static constexpr bool PERM = true;
    u16* Y;
    DI void operator()(const f32x4 (&acc)[2][2][4][2], const Unit& u, int wr, int wc, int fr, int fq) const {
        const int row0 = u.pm * BM + wr * 64 + fr, col0 = u.pn * BM + wc * 32 + 8 * fq;
#pragma unroll
        for (int ai = 0; ai < 2; ++ai)
#pragma unroll
            for (int m = 0; m < 4; ++m) { u16* yp = Y + (size_t)(row0 + ai * HALF + m * 16) * 2048 + col0;
#pragma unroll
                for (int bj = 0; bj < 2; ++bj) { const f32x4 v0 = acc[ai][bj][m][0], v1 = acc[ai][bj][m][1];
                    u32x4 w; w.x = cvt_pk_bf16(v0[0], v0[1]); w.y = cvt_pk_bf16(v0[2], v0[3]); w.z = cvt_pk_bf16(v1[0], v1[1]); w.w = cvt_pk_bf16(v1[2], v1[3]);
                    *(u32x4*)(yp + bj * HALF) = w; } }
    }
};
}

#define XB_TMO      128
#define XB_XCNT(j)  (256  + 64 * (j))
#define XB_XSUB(j)  (1280 + 64 * (j))
#define XB_XGEN(j)  (2304 + 64 * (j))
#define XB_TOP      3328
#define XB_TOPGEN   3392
#define XCD_BAR_WORDS 3456
#define XB_SPIN_CAP (1u << 18)
__device__ __forceinline__ unsigned xb_ld(unsigned* p)              { return __hip_atomic_load(p, __ATOMIC_RELAXED, __HIP_MEMORY_SCOPE_AGENT); }
__device__ __forceinline__ unsigned xb_add(unsigned* p, unsigned v) { return __hip_atomic_fetch_add(p, v, __ATOMIC_RELAXED, __HIP_MEMORY_SCOPE_AGENT); }
__device__ __forceinline__ unsigned xb_xcc_id() { return (unsigned)__builtin_amdgcn_s_getreg((3 << 11) | 20) & 0xFu; }
#define XB_SPIN(cond, bar) do { unsigned _sp = 0; while (cond) { __builtin_amdgcn_s_sleep(1); \
    if ((++_sp & 255u) == 0u) { if (xb_ld(&(bar)[XB_TMO])) break; if (_sp > XB_SPIN_CAP) { atomicAdd(&(bar)[XB_TMO], 1u); break; } } } } while (0)
struct XcdBarrier { unsigned* bar; unsigned x; volatile LAS unsigned* st; };
__device__ __forceinline__ XcdBarrier xcd_barrier_post(unsigned* bar, volatile LAS unsigned* st) {
    XcdBarrier b; b.bar = bar; b.x = xb_xcc_id(); b.st = st;
    if (threadIdx.x == 0) (void)xb_add(&bar[XB_XCNT(b.x)], 1u);
    return b;
}
__device__ __forceinline__ void xcd_barrier_complete(unsigned* bar, unsigned x, unsigned& nloc, unsigned& nx) {
    const unsigned G = gridDim.x * gridDim.y * gridDim.z;
    unsigned sum, cnt, mine, sp = 0u;
    for (;;) {
        sum = 0u; cnt = 0u; mine = 0u;
#pragma unroll
        for (unsigned j = 0; j < 16; ++j) { const unsigned c = xb_ld(&bar[XB_XCNT(j)]); sum += c; cnt += (c > 0u) ? 1u : 0u; mine = (j == x) ? c : mine; }
        if (sum == G) break;
        __builtin_amdgcn_s_sleep(1);
        if ((++sp & 255u) == 0u) { if (xb_ld(&bar[XB_TMO])) break; if (sp > XB_SPIN_CAP) { atomicAdd(&bar[XB_TMO], 1u); break; } }
    }
    nloc = mine > 0u ? mine : 1u; nx = cnt > 0u ? cnt : 1u;
}
__device__ __forceinline__ void xcd_barrier(const XcdBarrier& b) {
    asm volatile("s_waitcnt vmcnt(0)" ::: "memory");
    __syncthreads();
    if (threadIdx.x == 0) {
        unsigned* bar = b.bar;
        __builtin_amdgcn_s_waitcnt(0);
        unsigned nloc = b.st[0], nx = b.st[1];
        if (nloc == 0u) { xcd_barrier_complete(bar, b.x, nloc, nx); b.st[0] = nloc; b.st[1] = nx; }
        const unsigned old = xb_add(&bar[XB_XSUB(b.x)], 1u);
        const unsigned gen = old / nloc;
        if (old + 1u == (gen + 1u) * nloc) {
            __builtin_amdgcn_fence(__ATOMIC_RELEASE, "agent");
            asm volatile("s_waitcnt vmcnt(0)" ::: "memory");
            const unsigned og = xb_add(&bar[XB_TOP], 1u);
            const unsigned tg = og / nx;
            if (og + 1u == (tg + 1u) * nx) xb_add(&bar[XB_TOPGEN], 1u);
            else XB_SPIN(xb_ld(&bar[XB_TOPGEN]) == tg, bar);
            __builtin_amdgcn_fence(__ATOMIC_ACQUIRE, "agent");
            xb_add(&bar[XB_XGEN(b.x)], 1u);
            asm volatile("s_waitcnt vmcnt(0)" ::: "memory");
        } else {
            XB_SPIN(xb_ld(&bar[XB_XGEN(b.x)]) == gen, bar);
            __builtin_amdgcn_fence(__ATOMIC_ACQUIRE, "agent");
            asm volatile("s_waitcnt vmcnt(0)" ::: "memory");
        }
    }
    __syncthreads();
}

struct Args { const float* in[32]; float* outp; unsigned char* ws; int ph_lo, ph_hi; };
struct Frame {
    LAS unsigned char* lds;
    int tid, lane, wave, bid, G;
    const Args* a; unsigned char* ws;
    DI const float* in(int i) const { asm("" : "+s"(i)); return a->in[i]; }
    DI const float* x() const { return in(0); }
    DI const float* c() const { return in(1); }
    DI const float* ctx() const { return in(2); }
    DI const float* c_ctx() const { return in(3); }
    DI const float* w_ada() const { return in(4); }
    DI const float* b_ada() const { return in(5); }
    DI const float* w_in() const { return in(6); }
    DI const float* b_in() const { return in(7); }
    DI const float* w_s() const { return in(8); }
    DI const float* b_s() const { return in(9); }
    DI const float* sgu_g() const { return in(10); }
    DI const float* sgu_b() const { return in(11); }
    DI const float* conv_w() const { return in(12); }
    DI const float* conv_b() const { return in(13); }
    DI const float* w_q() const { return in(14); }
    DI const float* w_k() const { return in(15); }
    DI const float* mh_g() const { return in(16); }
    DI const float* skip() const { return in(17); }
    DI const float* p_a() const { return in(18); }
    DI const float* p_b() const { return in(19); }
    DI const float* w_o() const { return in(20); }
    DI const float* ln1_g() const { return in(21); }
    DI const float* ln1_b() const { return in(22); }
    DI const float* w_rg() const { return in(23); }
    DI const float* b_rg() const { return in(24); }
    DI const float* w_re() const { return in(25); }
    DI const float* b_re() const { return in(26); }
    DI const float* w1() const { return in(27); }
    DI const float* w3() const { return in(28); }
    DI const float* w2() const { return in(29); }
    DI const float* ln2_g() const { return in(30); }
    DI const float* ln2_b() const { return in(31); }
    DI unsigned* ctl() const { return (unsigned*)(ws + WS_CTL); }
    DI float* MOD() const { return (float*)(ws + WS_MOD); }
    DI float* WRT() const { return (float*)(ws + WS_WRT); }
    DI float* GB() const { return (float*)(ws + WS_GB); }
    DI float* NL() const { return (float*)(ws + WS_NL); }
    DI float* SC() const { return (float*)(ws + WS_SC); }
    DI float* TOKW() const { return (float*)(ws + WS_TOKW); }
    DI float* GATES() const { return (float*)(ws + WS_GATES); }
    DI int* TOKE() const { return (int*)(ws + WS_TOKE); }
    DI int* TOKS() const { return (int*)(ws + WS_TOKS); }
    DI int* TOKP() const { return (int*)(ws + WS_TOKP); }
    DI u16* WQK() const { return (u16*)(ws + WS_WQK); }
    DI u16* WSB() const { return (u16*)(ws + WS_WSB); }
    DI u16* WIN() const { return (u16*)(ws + WS_WIN); }
    DI u16* PAB() const { return (u16*)(ws + WS_PAB); }
    DI u16* WO() const { return (u16*)(ws + WS_WO); }
    DI u16* W13() const { return (u16*)(ws + WS_W13); }
    DI u16* W2() const { return (u16*)(ws + WS_W2); }
    DI u16* PROJ() const { return (u16*)(ws + WS_R1); }
    DI u16* XS() const { return (u16*)(ws + WS_XS); }
    DI u16* H() const { return (u16*)(ws + WS_H); }
    DI u16* U() const { return (u16*)(ws + WS_R2); }
    DI u16* Q() const { return (u16*)(ws + WS_R2); }
    DI u16* K() const { return (u16*)(ws + WS_R2) + (size_t)TR * 1024; }
    DI u16* U2() const { return (u16*)(ws + WS_R2); }
    DI u16* XC() const { return (u16*)(ws + WS_R3); }
    DI u16* Z() const { return (u16*)(ws + WS_R3); }
    DI u16* ST() const { return (u16*)(ws + WS_R4); }
    DI u16* AB() const { return (u16*)(ws + WS_R5); }
    DI u16* X1() const { return (u16*)(ws + WS_R5); }
    DI u16* YS() const { return (u16*)(ws + WS_YS); }
    DI float* out() const { return a->outp; }
};

DI bf16x8 ld8(const LAS u16* p) { return *(const LAS bf16x8*)p; }
DI bf16x8 ld8(const GAS u16* p) { return *(const GAS bf16x8*)p; }
template <int NT, class PA, class PB>
DI void wave_mm(f32x4 (&acc)[NT], PA A, int lda, PB B, int ldb, int K, int lane) {
    const int fr = lane & 15, fq = lane >> 4;
#pragma unroll 1
    for (int k0 = 0; k0 < K; k0 += 32) {
        const bf16x8 a = ld8(A + fr * lda + k0 + 8 * fq);
#pragma unroll
        for (int t = 0; t < NT; ++t) { const bf16x8 b = ld8(B + (16 * t + fr) * ldb + k0 + 8 * fq); acc[t] = __builtin_amdgcn_mfma_f32_16x16x32_bf16(b, a, acc[t], 0, 0, 0); }
    }
}
template <int NT> DI void zero_acc(f32x4 (&acc)[NT]) {
#pragma unroll
    for (int t = 0; t < NT; ++t) acc[t] = (f32x4){0.f, 0.f, 0.f, 0.f};
}

DI void p0_gemv(Frame& F, int cb) {
    LAS float* sv = (LAS float*)F.lds;
    LAS float* red = sv + 4096;
    for (int i = F.tid; i < 2048; i += 512) { const float a = F.c()[i], b = F.c_ctx()[i]; sv[i] = a / (1.f + expf(-a)); sv[2048 + i] = b / (1.f + expf(-b)); }
    __syncthreads();
    const int l16 = F.tid & 15, rl = F.tid >> 4;
    f32x4 a1 = (f32x4){0.f, 0.f, 0.f, 0.f}, a2 = a1;
    const float* wp = F.w_ada() + (size_t)rl * 12288 + 64 * cb + 4 * l16;
#pragma unroll 8
    for (int it = 0; it < 64; ++it) { const f32x4 w = *(const GAS f32x4*)(wp + (size_t)it * 32 * 12288); const float s1 = sv[rl + 32 * it], s2 = sv[2048 + rl + 32 * it]; a1 += w * s1; a2 += w * s2; }
    *(LAS f32x4*)(red + (rl * 16 + l16) * 8) = a1; *(LAS f32x4*)(red + (rl * 16 + l16) * 8 + 4) = a2;
    __syncthreads();
    if (F.tid < 128) { const int v = F.tid >> 6, col = F.tid & 63, q16 = col >> 2, j = col & 3; float s = 0.f;
        for (int r = 0; r < 32; ++r) s += red[(r * 16 + q16) * 8 + v * 4 + j];
        F.MOD()[v * 12288 + 64 * cb + col] = s + F.b_ada()[64 * cb + col]; }
    __syncthreads();
}
struct TrItem { const float* src; u16* dst; int ldn, ldk; bool ok; };
DI void tr_load(const TrItem& t, f32x4 (&v)[8], int lane) {
#pragma unroll
    for (int i = 0; i < 8; ++i) { const int kk = 8 * i + (lane >> 3); v[i] = t.ok ? *(const GAS f32x4*)(t.src + (size_t)kk * t.ldn + 4 * (lane & 7)) : (f32x4){0.f, 0.f, 0.f, 0.f}; }
}
DI void tr_store(const TrItem& t, const f32x4 (&v)[8], LAS float* scr, int lane) {
#pragma unroll
    for (int i = 0; i < 8; ++i) { const int kk = 8 * i + (lane >> 3); LAS float* d = scr + kk * 33 + 4 * (lane & 7); d[0] = v[i][0]; d[1] = v[i][1]; d[2] = v[i][2]; d[3] = v[i][3]; }
    LDS_WAIT(); asm volatile("" ::: "memory");
    const int c = lane & 7;
#pragma unroll
    for (int j = 0; j < 4; ++j) { const int nn = (lane >> 3) + 8 * j; const LAS float* s = scr + (8 * c) * 33 + nn;
        u32x4 o; o.x = cvt_pk_bf16(s[0 * 33], s[1 * 33]); o.y = cvt_pk_bf16(s[2 * 33], s[3 * 33]); o.z = cvt_pk_bf16(s[4 * 33], s[5 * 33]); o.w = cvt_pk_bf16(s[6 * 33], s[7 * 33]);
        *(GAS u32x4*)(t.dst + (size_t)nn * t.ldk + 8 * c) = o; }
    LDS_WAIT(); asm volatile("" ::: "memory");
}
constexpr int I_IN = 32 * (NPAD / 32), I_PA = 16 * 64, I_WO = 32 * 64, I_W1 = 32 * 1024, I_W2 = 32 * 1024, I_QK = 8 * 8;
constexpr int NITEMS = I_IN + 2 * I_PA + I_WO + 2 * I_W1 + I_W2 + 2 * I_QK;
DI TrItem tr_decode(Frame& F, int it) {
    TrItem t; t.ok = true; int r = it;
    if (r < I_IN) { const int nb = r % (NPAD / 32), kb = r / (NPAD / 32); t.ok = 32 * nb < DIN; t.src = F.w_in() + (size_t)(64 * kb) * DIN + 32 * nb; t.ldn = DIN; t.dst = F.WIN() + (size_t)(32 * nb) * 2048 + 64 * kb; t.ldk = 2048; return t; } r -= I_IN;
    if (r < I_PA) { const int nb = r % 64, kb = r / 64; t.src = F.p_a() + (size_t)(64 * kb) * 2048 + 32 * nb; t.ldn = 2048; t.dst = F.PAB() + (size_t)(32 * nb) * 2048 + 64 * kb; t.ldk = 2048; return t; } r -= I_PA;
    if (r < I_PA) { const int nb = r % 64, kb = r / 64; t.src = F.p_b() + (size_t)(64 * kb) * 2048 + 32 * nb; t.ldn = 2048; t.dst = F.PAB() + (size_t)(32 * nb) * 2048 + 1024 + 64 * kb; t.ldk = 2048; return t; } r -= I_PA;
    if (r < I_WO) { const int nb = r % 64, kb = r / 64; t.src = F.w_o() + (size_t)(64 * kb) * 2048 + 32 * nb; t.ldn = 2048; t.dst = F.WO() + (size_t)(32 * nb) * 2048 + 64 * kb; t.ldk = 2048; return t; } r -= I_WO;
    if (r < I_W1) { const int e = r >> 10, rr = r & 1023, nb = rr & 31, kb = rr >> 5, n0 = 32 * nb;
        t.src = F.w1() + (size_t)e * 2048 * 1024 + (size_t)(64 * kb) * 1024 + n0; t.ldn = 1024; t.dst = F.W13() + (size_t)e * 2048 * 2048 + (size_t)(256 * (n0 >> 7) + (n0 & 127)) * 2048 + 64 * kb; t.ldk = 2048; return t; } r -= I_W1;
    if (r < I_W1) { const int e = r >> 10, rr = r & 1023, nb = rr & 31, kb = rr >> 5, n0 = 32 * nb;
        t.src = F.w3() + (size_t)e * 2048 * 1024 + (size_t)(64 * kb) * 1024 + n0; t.ldn = 1024; t.dst = F.W13() + (size_t)e * 2048 * 2048 + (size_t)(256 * (n0 >> 7) + 128 + (n0 & 127)) * 2048 + 64 * kb; t.ldk = 2048; return t; } r -= I_W1;
    if (r < I_W2) { const int e = r >> 10, rr = r & 1023, nb = rr & 63, kb = rr >> 6;
        t.src = F.w2() + (size_t)e * 1024 * 2048 + (size_t)(64 * kb) * 2048 + 32 * nb; t.ldn = 2048; t.dst = F.W2() + (size_t)e * 2048 * 1024 + (size_t)(32 * nb) * 1024 + 64 * kb; t.ldk = 1024; return t; } r -= I_W2;
    if (r < I_QK) { const int h = r >> 3, rr = r & 7, nb = rr & 3, kb = rr >> 2;
        t.src = F.w_q() + (size_t)h * 16384 + (size_t)(64 * kb) * 128 + 32 * nb; t.ldn = 128; t.dst = F.WQK() + (size_t)h * 32768 + (size_t)(32 * nb) * 128 + 64 * kb; t.ldk = 128; return t; } r -= I_QK;
    { const int h = r >> 3, rr = r & 7, nb = rr & 3, kb = rr >> 2;
        t.src = F.w_k() + (size_t)h * 16384 + (size_t)(64 * kb) * 128 + 32 * nb; t.ldn = 128; t.dst = F.WQK() + (size_t)h * 32768 + (size_t)(128 + 32 * nb) * 128 + 64 * kb; t.ldk = 128; return t; }
}
DI void p0_prologue(Frame& F) {
    for (int cb = F.bid; cb < 192; cb += F.G) p0_gemv(F, cb);
    LAS float* scr = (LAS float*)(F.lds + F.wave * 16384);
    const int gw = F.bid * 8 + F.wave, NGW = F.G * 8;
    if (gw < NITEMS) {
        TrItem cur = tr_decode(F, gw); f32x4 v[8]; tr_load(cur, v, F.lane);
#pragma unroll 1
        for (int it = gw; it < NITEMS; it += NGW) {
            const bool hn = it + NGW < NITEMS; TrItem nxt = cur; f32x4 vn[8];
            if (hn) { nxt = tr_decode(F, it + NGW); tr_load(nxt, vn, F.lane); }
            tr_store(cur, v, scr, F.lane);
            if (hn) {
#pragma unroll
                for (int i = 0; i < 8; ++i) v[i] = vn[i];
                cur = nxt; }
        }
    }
    const int gt = F.bid * 512 + F.tid, NGT = F.G * 512;
    for (int i = gt; i < 48 * 2048; i += NGT) { const int j = i >> 11, k = i & 2047; const float w = (j < 4) ? F.w_rg()[k * 4 + j] : (j < 36 ? F.w_re()[k * 32 + (j - 4)] : 0.f);
        const unsigned hi = f2bf(w); const unsigned lo = f2bf(w - __uint_as_float(hi << 16)); u16* wr = (u16*)F.WRT(); wr[i] = (u16)hi; wr[48 * 2048 + i] = (u16)lo; }
    for (int i = gt; i < 8 * 16384; i += NGT) F.WSB()[i] = (u16)f2bf(F.w_s()[i]);
}

DI void p1_rows(Frame& F) {
    const int gw = F.bid * 8 + F.wave, NGW = F.G * 8;
    for (int rr = gw; rr < TR; rr += 2 * NGW) {
        f32x4 v[2][8]; bool ok[2]; int rw[2];
#pragma unroll
        for (int q = 0; q < 2; ++q) { const int r = rr + q * NGW; ok[q] = r < TR; rw[q] = ok[q] ? r : rr;
            const float* src = rw[q] < T ? F.x() + (size_t)rw[q] * D : F.ctx() + (size_t)(rw[q] - T) * D; const GAS f32x4* xr = (const GAS f32x4*)src + F.lane;
#pragma unroll
            for (int j = 0; j < 8; ++j) v[q][j] = xr[64 * j]; }
#pragma unroll
        for (int q = 0; q < 2; ++q) { if (!ok[q]) continue;
            const float* mod = F.MOD() + (rw[q] < T ? 0 : 12288);
            float s = 0.f;
#pragma unroll
            for (int j = 0; j < 8; ++j) s += (v[q][j][0] + v[q][j][1]) + (v[q][j][2] + v[q][j][3]);
            const float mean = wave_sum(s) * (1.f / D); float s2 = 0.f;
#pragma unroll
            for (int j = 0; j < 8; ++j) { v[q][j] = v[q][j] - mean; s2 += (v[q][j][0] * v[q][j][0] + v[q][j][1] * v[q][j][1]) + (v[q][j][2] * v[q][j][2] + v[q][j][3] * v[q][j][3]); }
            const float rstd = 1.f / sqrtf(wave_sum(s2) * (1.f / D) + LN_EPS);
            GAS u32x2* o = (GAS u32x2*)(F.U() + (size_t)rw[q] * D) + F.lane;
#pragma unroll
            for (int j = 0; j < 8; ++j) { const f32x4 sh = *(const f32x4*)(mod + 4 * F.lane + 256 * j), sc = *(const f32x4*)(mod + 2048 + 4 * F.lane + 256 * j);
                o[64 * j] = pack4(v[q][j] * rstd * (sc + 1.f) + sh); } }
    }
}

template <int NT, class PA, class PB>
DI void wave_mm128(f32x4 (&acc)[NT], PA A, int lda, PB B, int ldb, int lane) {
    const int fr = lane & 15, fq = lane >> 4;
    bf16x8 a[4];
#pragma unroll
    for (int ks = 0; ks < 4; ++ks) a[ks] = ld8(A + fr * lda + 32 * ks + 8 * fq);
#pragma unroll
    for (int kp = 0; kp < 2; ++kp) {
        bf16x8 b[2][NT];
#pragma unroll
        for (int kk = 0; kk < 2; ++kk)
#pragma unroll
            for (int t = 0; t < NT; ++t) b[kk][t] = ld8(B + (16 * t + fr) * ldb + 32 * (2 * kp + kk) + 8 * fq);
#pragma unroll
        for (int kk = 0; kk < 2; ++kk)
#pragma unroll
            for (int t = 0; t < NT; ++t) acc[t] = __builtin_amdgcn_mfma_f32_16x16x32_bf16(b[kk][t], a[2 * kp + kk], acc[t], 0, 0, 0);
        __builtin_amdgcn_sched_barrier(0);
    }
}
template <int NT, class PB>
DI void wave_mm128_areg(f32x4 (&acc)[NT], const bf16x8 (&a)[4], PB B, int ldb, int lane) {
    const int fr = lane & 15, fq = lane >> 4;
#pragma unroll
    for (int kp = 0; kp < 2; ++kp) {
        bf16x8 b[2][NT];
#pragma unroll
        for (int kk = 0; kk < 2; ++kk)
#pragma unroll
            for (int t = 0; t < NT; ++t) b[kk][t] = ld8(B + (16 * t + fr) * ldb + 32 * (2 * kp + kk) + 8 * fq);
#pragma unroll
        for (int kk = 0; kk < 2; ++kk)
#pragma unroll
            for (int t = 0; t < NT; ++t) acc[t] = __builtin_amdgcn_mfma_f32_16x16x32_bf16(b[kk][t], a[2 * kp + kk], acc[t], 0, 0, 0);
        __builtin_amdgcn_sched_barrier(0);
    }
}
DI float wave_incl_scan(float v, int lane) {
#pragma unroll
    for (int o = 1; o < 64; o <<= 1) { const float t = __shfl_up(v, o); v = (lane >= o) ? v + t : v; }
    return v;
}
DI float fexp(float x) { return __builtin_amdgcn_exp2f(x * 1.4426950408889634f); }

DI void gmlp_unit(Frame& F, int c, int g, int& cur_g) {
    LAS float* MU = (LAS float*)(F.lds + 140288); LAS float* RS = MU + 128;
    LAS u16* VNT = (LAS u16*)F.lds;
    LAS u16* WSs = (LAS u16*)(F.lds + 34816);
    if (g != cur_g) { cur_g = g;
#pragma unroll
        for (int i = 0; i < 4; ++i) { const int idx = F.tid + 512 * i; *(LAS u32x4*)(WSs + (idx >> 4) * 136 + 8 * (idx & 15)) = *(const GAS u32x4*)(F.WSB() + g * 16384 + (idx >> 4) * 128 + 8 * (idx & 15)); } }
    const int r0 = 128 * c, fr = F.lane & 15, fq = F.lane >> 4;
    if (F.tid < 128) {
        const GAS f32x4* sp = (const GAS f32x4*)((const float*)(F.ws + WS_STATP) + (size_t)(r0 + F.tid) * 32); float sa = 0.f, qa = 0.f;
#pragma unroll
        for (int i = 0; i < 8; ++i) { const f32x4 v = sp[i]; sa += v[0] + v[2]; qa += v[1] + v[3]; }
        const float mean = sa * (1.f / 1024.f), var = fmaxf(qa * (1.f / 1024.f) - mean * mean, 0.f);
        MU[F.tid] = mean; RS[F.tid] = 1.f / sqrtf(var + LN_EPS); }
    __syncthreads();
    {
        const int c8 = F.tid & 15;
        u32x4 vq[4];
#pragma unroll
        for (int i = 0; i < 4; ++i) vq[i] = *(const GAS u32x4*)(F.PROJ() + (size_t)(r0 + ((F.tid + 512 * i) >> 4)) * NPJ + OFF_VA + 128 * g + 8 * c8);
        const f32x4 g0 = *(const f32x4*)(F.sgu_g() + 128 * g + 8 * c8), g1 = *(const f32x4*)(F.sgu_g() + 128 * g + 8 * c8 + 4), b0 = *(const f32x4*)(F.sgu_b() + 128 * g + 8 * c8), b1 = *(const f32x4*)(F.sgu_b() + 128 * g + 8 * c8 + 4);
        const float gg[8] = {g0[0], g0[1], g0[2], g0[3], g1[0], g1[1], g1[2], g1[3]}, bb[8] = {b0[0], b0[1], b0[2], b0[3], b1[0], b1[1], b1[2], b1[3]};
#pragma unroll
        for (int i = 0; i < 4; ++i) { const int p = (F.tid + 512 * i) >> 4; const u32x4 v = vq[i]; const float mu = MU[p], rs = RS[p];
            const float x[8] = {bflo(v.x), bfhi(v.x), bflo(v.y), bfhi(v.y), bflo(v.z), bfhi(v.z), bflo(v.w), bfhi(v.w)};
#pragma unroll
            for (int j = 0; j < 8; ++j) VNT[(8 * c8 + j) * 136 + p] = (u16)f2bf((x[j] - mu) * rs * gg[j] + bb[j]); }
    }
    __syncthreads();
    const int q = 16 * F.wave + fr; const float bsq = F.b_s()[g * 128 + q];
    u32x2 uaq[8];
#pragma unroll
    for (int t = 0; t < 8; ++t) uaq[t] = *(const GAS u32x2*)(F.PROJ() + (size_t)(r0 + q) * NPJ + OFF_UA + 128 * g + 16 * t + 4 * fq);
    f32x4 acc[8]; zero_acc<8>(acc);
    wave_mm128<8>(acc, (const LAS u16*)(WSs + 16 * F.wave * 136), 136, (const LAS u16*)VNT, 136, F.lane);
#pragma unroll
    for (int t = 0; t < 8; ++t) *(GAS u32x2*)(F.AB() + (size_t)(r0 + q) * 2048 + 128 * g + 16 * t + 4 * fq) = pack4(unpack4(uaq[t]) * (acc[t] + bsq));
    __syncthreads();
}

DI void mprep_unit(Frame& F, int c, int h, int& cur_h) {
    const int r0 = (c < 2) ? T + 128 * c : 128 * (c - 2);
    const int seq_lo = (c < 2) ? T : 0, seq_hi = (c < 2) ? TR - 1 : T - 1;
    LAS u16* XCs = (LAS u16*)F.lds;
    LAS u16* KT = (LAS u16*)(F.lds + 34816);
    LAS u16* WQs = (LAS u16*)(F.lds + 2 * 34816);
    LAS float* GS = (LAS float*)(F.lds + 4 * 34816);
    const int fr = F.lane & 15, fq = F.lane >> 4;
    if (h != cur_h) { cur_h = h;
#pragma unroll
        for (int i = 0; i < 8; ++i) { const int idx = F.tid + 512 * i; *(LAS u32x4*)(WQs + (idx >> 4) * 136 + 8 * (idx & 15)) = *(const GAS u32x4*)(F.WQK() + (size_t)h * 32768 + (idx >> 4) * 128 + 8 * (idx & 15)); } }
    u32x4 vtq[4];
#pragma unroll
    for (int i = 0; i < 4; ++i) { const int idx = F.tid + 512 * i; vtq[i] = *(const GAS u32x4*)(F.PROJ() + (size_t)(r0 + (idx >> 4)) * NPJ + OFF_VB + 128 * h + 8 * (idx & 15)); }
    if (F.wave < 2) {
        const int dir = F.wave; const int s0 = dir ? 127 - 2 * F.lane : 2 * F.lane, s1 = dir ? 126 - 2 * F.lane : 2 * F.lane + 1;
        const float* g0 = F.GATES() + (size_t)(r0 + s0) * 32 + 16 * dir + h; const float* g1 = F.GATES() + (size_t)(r0 + s1) * 32 + 16 * dir + h;
        const float li0 = g0[0], lf0 = logsig(g0[8]), li1 = g1[0], lf1 = logsig(g1[8]);
        const float incl = wave_incl_scan(lf0 + lf1, F.lane);
        const float b1 = incl, b0 = incl - lf1;
        const float bs = __shfl(incl, 63);
        const float l0 = bs - b0 + li0, l1 = bs - b1 + li1;
        const float ml = wave_max(fmaxf(l0, l1));
        GS[128 * dir + s0] = expf(l0 - ml); GS[128 * dir + s1] = expf(l1 - ml);
        if (F.lane == 0) { float* sc = F.SC() + (size_t)((dir * 8 + h) * NCH + c) * 4; sc[0] = ml; sc[1] = bs; }
        float* gb0 = F.GB() + ((size_t)h * TR + r0 + s0) * 4 + 2 * dir; float* gb1 = F.GB() + ((size_t)h * TR + r0 + s1) * 4 + 2 * dir;
        *(f32x2*)gb0 = (f32x2){li0, b0}; *(f32x2*)gb1 = (f32x2){li1, b1};
    }
    const int cch = 128 * h + 8 * (F.tid & 15);
    f32x4 cw0[2], cw1[2], cw2[2], cbb[2];
#pragma unroll
    for (int hh = 0; hh < 2; ++hh) { cw0[hh] = *(const f32x4*)(F.conv_w() + cch + 4 * hh); cw1[hh] = *(const f32x4*)(F.conv_w() + 1024 + cch + 4 * hh); cw2[hh] = *(const f32x4*)(F.conv_w() + 2048 + cch + 4 * hh); cbb[hh] = *(const f32x4*)(F.conv_b() + cch + 4 * hh); }
    u32x4 xmq[4], xpq[4], xnq[4];
#pragma unroll
    for (int i = 0; i < 4; ++i) { const int row = r0 + ((F.tid + 512 * i) >> 4); const GAS u16* p = (const GAS u16*)(F.PROJ() + (size_t)row * NPJ + OFF_XM + cch); const u32x4 z4 = (u32x4){0u, 0u, 0u, 0u};
        xmq[i] = *(const GAS u32x4*)p; xpq[i] = (row > seq_lo) ? *(const GAS u32x4*)(p - NPJ) : z4; xnq[i] = (row < seq_hi) ? *(const GAS u32x4*)(p + NPJ) : z4; }
#pragma unroll
    for (int i = 0; i < 4; ++i) { const int idx = F.tid + 512 * i, s = idx >> 4, c8 = idx & 15, row = r0 + s, ch = 128 * h + 8 * c8;
        const u32x4 xm = xmq[i], xp = xpq[i], xn = xnq[i];
        float y[8];
#pragma unroll
        for (int hh = 0; hh < 2; ++hh) { const f32x4 w0 = cw0[hh], w1 = cw1[hh], w2 = cw2[hh], cb = cbb[hh];
            const unsigned a0 = hh ? xp.z : xp.x, a1 = hh ? xp.w : xp.y, m0 = hh ? xm.z : xm.x, m1 = hh ? xm.w : xm.y, n0 = hh ? xn.z : xn.x, n1 = hh ? xn.w : xn.y;
            y[4 * hh + 0] = w0[0] * bflo(a0) + w1[0] * bflo(m0) + w2[0] * bflo(n0) + cb[0];
            y[4 * hh + 1] = w0[1] * bfhi(a0) + w1[1] * bfhi(m0) + w2[1] * bfhi(n0) + cb[1];
            y[4 * hh + 2] = w0[2] * bflo(a1) + w1[2] * bflo(m1) + w2[2] * bflo(n1) + cb[2];
            y[4 * hh + 3] = w0[3] * bfhi(a1) + w1[3] * bfhi(m1) + w2[3] * bfhi(n1) + cb[3]; }
#pragma unroll
        for (int j = 0; j < 8; ++j) y[j] = y[j] * sigmoid_fast(y[j]);
        u32x4 o; o.x = cvt_pk_bf16(y[0], y[1]); o.y = cvt_pk_bf16(y[2], y[3]); o.z = cvt_pk_bf16(y[4], y[5]); o.w = cvt_pk_bf16(y[6], y[7]);
        *(LAS u32x4*)(XCs + s * 136 + 8 * c8) = o; *(GAS u32x4*)(F.XC() + (size_t)row * 1024 + ch) = o; }
    __syncthreads();
    {
        f32x4 aq[8]; zero_acc<8>(aq);
        wave_mm128<8>(aq, (const LAS u16*)(XCs + 16 * F.wave * 136), 136, (const LAS u16*)WQs, 136, F.lane);
        const int s = 16 * F.wave + fr;
#pragma unroll
        for (int t = 0; t < 8; ++t) *(GAS u32x2*)(F.Q() + (size_t)(r0 + s) * 1024 + 128 * h + 16 * t + 4 * fq) = pack4(aq[t]);
        zero_acc<8>(aq);
        wave_mm128<8>(aq, (const LAS u16*)(XCs + 16 * F.wave * 136), 136, (const LAS u16*)(WQs + 128 * 136), 136, F.lane);
#pragma unroll
        for (int t = 0; t < 8; ++t) *(GAS u32x2*)(F.K() + (size_t)(r0 + s) * 1024 + 128 * h + 16 * t + 4 * fq) = pack4(aq[t] * 0.08838834764831845f);
        zero_acc<8>(aq);
        wave_mm128<8>(aq, (const LAS u16*)(WQs + (128 + 16 * F.wave) * 136), 136, (const LAS u16*)XCs, 136, F.lane);
        const int d = 16 * F.wave + fr;
#pragma unroll
        for (int t = 0; t < 8; ++t) *(LAS u32x2*)(KT + d * 136 + 16 * t + 4 * fq) = pack4(aq[t] * 0.08838834764831845f);
    }
    __syncthreads();
#pragma unroll
    for (int i = 0; i < 4; ++i) { const int idx = F.tid + 512 * i, s = idx >> 4, c8 = idx & 15;
        const unsigned w[4] = {vtq[i].x, vtq[i].y, vtq[i].z, vtq[i].w};
#pragma unroll
        for (int j = 0; j < 4; ++j) { XCs[(8 * c8 + 2 * j) * 136 + s] = (u16)(w[j] & 0xffffu); XCs[(8 * c8 + 2 * j + 1) * 136 + s] = (u16)(w[j] >> 16); } }
    __syncthreads();
#pragma unroll
    for (int dir = 0; dir < 2; ++dir) {
        f32x4 cf[8]; zero_acc<8>(cf);
#pragma unroll
        for (int ks = 0; ks < 4; ++ks) {
            const u32x4 av = *(const LAS u32x4*)(XCs + (16 * F.wave + fr) * 136 + 32 * ks + 8 * fq);
            const f32x4 w0 = *(const LAS f32x4*)(GS + 128 * dir + 32 * ks + 8 * fq), w1 = *(const LAS f32x4*)(GS + 128 * dir + 32 * ks + 8 * fq + 4);
            u32x4 sv; sv.x = cvt_pk_bf16(bflo(av.x) * w0[0], bfhi(av.x) * w0[1]); sv.y = cvt_pk_bf16(bflo(av.y) * w0[2], bfhi(av.y) * w0[3]);
            sv.z = cvt_pk_bf16(bflo(av.z) * w1[0], bfhi(av.z) * w1[1]); sv.w = cvt_pk_bf16(bflo(av.w) * w1[2], bfhi(av.w) * w1[3]);
            const bf16x8 a = __builtin_bit_cast(bf16x8, sv);
#pragma unroll
            for (int t = 0; t < 8; ++t) { const bf16x8 b = ld8((const LAS u16*)(KT + (16 * t + fr) * 136 + 32 * ks + 8 * fq)); cf[t] = __builtin_amdgcn_mfma_f32_16x16x32_bf16(b, a, cf[t], 0, 0, 0); }
        }
        u16* st = F.ST() + ((size_t)((dir * 8 + h) * NCH + c) * 16384) + (16 * F.wave + fr) * 128;
#pragma unroll
        for (int t = 0; t < 8; ++t) *(GAS u32x2*)(st + 16 * t + 4 * fq) = pack4(cf[t]);
    }
    if (F.tid < 256) { const int dir = F.tid >> 7, d = F.tid & 127; const LAS u16* kt = KT + d * 136; const LAS float* w = GS + 128 * dir; float s = 0.f;
#pragma unroll
        for (int i = 0; i < 16; ++i) { const u32x4 v = *(const LAS u32x4*)(kt + 8 * i); const f32x4 w0 = *(const LAS f32x4*)(w + 8 * i), w1 = *(const LAS f32x4*)(w + 8 * i + 4);
            s += ((bflo(v.x) * w0[0] + bfhi(v.x) * w0[1]) + (bflo(v.y) * w0[2] + bfhi(v.y) * w0[3])) + ((bflo(v.z) * w1[0] + bfhi(v.z) * w1[1]) + (bflo(v.w) * w1[2] + bfhi(v.w) * w1[3])); }
        F.NL()[(size_t)((dir * 8 + h) * NCH + c) * 128 + d] = s; }
    __syncthreads();
}

DI int scan_order(int dir, int j) { return dir == 0 ? j : (j == 0 ? 1 : (j == 1 ? 0 : 131 - j)); }
DI void scan_item(Frame& F, int dh, int blk) {
    const int dir = dh >> 3;
    LAS float* ML = (LAS float*)F.lds; LAS float* BS = ML + 136; LAS float* DEC = ML + 272; LAS float* SCL = ML + 408; LAS float* MB = ML + 544;
    if (F.tid < NCH) { const int cj = scan_order(dir, F.tid); const float* sc = F.SC() + (size_t)(dh * NCH + cj) * 4; ML[F.tid] = sc[0]; BS[F.tid] = sc[1]; }
    __syncthreads();
    if (F.tid == 0) { float m = NEGF; for (int j = 0; j < NCH; ++j) { MB[j] = m; const float mn = fmaxf(BS[j] + m, ML[j]); DEC[j] = fexp(BS[j] + m - mn); SCL[j] = fexp(ML[j] - mn); m = mn; } }
    __syncthreads();
    GAS unsigned* base = (GAS unsigned*)(F.ST() + (size_t)dh * NCH * 16384) + blk * 512 + F.tid;
    float c0 = 0.f, c1 = 0.f;
#pragma unroll 1
    for (int j0 = 0; j0 < NCH; j0 += 26) {
        unsigned kv[26];
#pragma unroll
        for (int jj = 0; jj < 26; ++jj) kv[jj] = base[(size_t)scan_order(dir, j0 + jj) * 8192];
#pragma unroll
        for (int jj = 0; jj < 26; ++jj) { base[(size_t)scan_order(dir, j0 + jj) * 8192] = cvt_pk_bf16(c0, c1);
            const float de = DEC[j0 + jj], sc = SCL[j0 + jj]; c0 = de * c0 + sc * bflo(kv[jj]); c1 = de * c1 + sc * bfhi(kv[jj]); }
    }
    if (blk == 0) {
        if (F.tid < 128) { float n = 0.f; GAS float* nl = (GAS float*)(F.NL() + (size_t)dh * NCH * 128 + F.tid);
#pragma unroll 1
            for (int j0 = 0; j0 < NCH; j0 += 26) { float nv[26];
#pragma unroll
                for (int jj = 0; jj < 26; ++jj) nv[jj] = nl[scan_order(dir, j0 + jj) * 128];
#pragma unroll
                for (int jj = 0; jj < 26; ++jj) { nl[scan_order(dir, j0 + jj) * 128] = n; n = DEC[j0 + jj] * n + SCL[j0 + jj] * nv[jj]; } } }
        if (F.tid >= 256 && F.tid < 256 + NCH) { const int j = F.tid - 256; F.SC()[(size_t)(dh * NCH + scan_order(dir, j)) * 4 + 2] = MB[j]; }
    }
    __syncthreads();
}

DI void x3_unit(Frame& F, int lc, int h) {
    const int c = lc + 2, r0 = 128 * lc, fr = F.lane & 15, fq = F.lane >> 4;
    LAS u16* VT = (LAS u16*)F.lds;
    LAS u16* KS = (LAS u16*)(F.lds + 34816);
    LAS u16* PW = KS + F.wave * 16 * 136;
    LAS u16* SF = (LAS u16*)(F.lds + 2 * 34816);
    LAS u16* SB = (LAS u16*)(F.lds + 3 * 34816);
    LAS float* GS = (LAS float*)(F.lds + 4 * 34816);
    const int ql = 16 * F.wave + fr;
    bf16x8 qa[4];
#pragma unroll
    for (int ks = 0; ks < 4; ++ks) qa[ks] = ld8((const GAS u16*)(F.Q() + (size_t)(r0 + ql) * 1024 + 128 * h + 32 * ks + 8 * fq));
    if (F.tid < 128) { const f32x4 g = *(const GAS f32x4*)(F.GB() + ((size_t)h * TR + r0 + F.tid) * 4); GS[F.tid] = g[0]; GS[128 + F.tid] = g[1]; GS[256 + F.tid] = g[2]; GS[384 + F.tid] = g[3]; }
    else if (F.tid < 384) { const int i = F.tid - 128, dir = i >> 7, d = i & 127; GS[512 + i] = F.NL()[(size_t)((dir * 8 + h) * NCH + c) * 128 + d]; }
    const float mf = F.SC()[(size_t)(h * NCH + c) * 4 + 2], mb = F.SC()[(size_t)((8 + h) * NCH + c) * 4 + 2];
    {
        u32x4 vv[4], s0[4], s1[4], kq[4];
        const GAS u16* stf = (const GAS u16*)(F.ST() + (size_t)(h * NCH + c) * 16384); const GAS u16* stb = (const GAS u16*)(F.ST() + (size_t)((8 + h) * NCH + c) * 16384);
#pragma unroll
        for (int i = 0; i < 4; ++i) { const int idx = F.tid + 512 * i, s = idx >> 4, c8 = idx & 15;
            vv[i] = *(const GAS u32x4*)(F.PROJ() + (size_t)(r0 + s) * NPJ + OFF_VB + 128 * h + 8 * c8); s0[i] = *(const GAS u32x4*)(stf + s * 128 + 8 * c8); s1[i] = *(const GAS u32x4*)(stb + s * 128 + 8 * c8);
            kq[i] = *(const GAS u32x4*)(F.K() + (size_t)(r0 + s) * 1024 + 128 * h + 8 * c8); }
#pragma unroll
        for (int i = 0; i < 4; ++i) { const int idx = F.tid + 512 * i, s = idx >> 4, c8 = idx & 15;
            *(LAS u32x4*)(SF + s * 136 + 8 * c8) = s0[i]; *(LAS u32x4*)(SB + s * 136 + 8 * c8) = s1[i]; *(LAS u32x4*)(KS + s * 136 + 8 * c8) = kq[i];
            const unsigned w[4] = {vv[i].x, vv[i].y, vv[i].z, vv[i].w};
#pragma unroll
            for (int j = 0; j < 4; ++j) { VT[(8 * c8 + 2 * j) * 136 + s] = (u16)(w[j] & 0xffffu); VT[(8 * c8 + 2 * j + 1) * 136 + s] = (u16)(w[j] >> 16); } }
    }
    __syncthreads();
    f32x4 sf[8], sb[8]; zero_acc<8>(sf);
    wave_mm128_areg<8>(sf, qa, (const LAS u16*)KS, 136, F.lane);
    __syncthreads();
    const float bqf = GS[128 + ql], bqb = GS[384 + ql];
    float mxf = -3.0e38f, mxb = -3.0e38f;
#pragma unroll
    for (int t = 0; t < 8; ++t)
#pragma unroll
        for (int r = 0; r < 4; ++r) { const int s = 16 * t + 4 * fq + r; const float df = bqf - GS[128 + s] + GS[s], db = bqb - GS[384 + s] + GS[256 + s];
            mxf = (s <= ql) ? fmaxf(mxf, df) : mxf; mxb = (s >= ql) ? fmaxf(mxb, db) : mxb; }
    mxf = fmaxf(mxf, __shfl_xor(mxf, 16)); mxf = fmaxf(mxf, __shfl_xor(mxf, 32)); mxb = fmaxf(mxb, __shfl_xor(mxb, 16)); mxb = fmaxf(mxb, __shfl_xor(mxb, 32));
    const float mrf = fmaxf(bqf + mf, mxf), mrb = fmaxf(bqb + mb, mxb);
    float rsf = 0.f, rsb = 0.f;
#pragma unroll
    for (int t = 0; t < 8; ++t)
#pragma unroll
        for (int r = 0; r < 4; ++r) { const int s = 16 * t + 4 * fq + r; const float df = bqf - GS[128 + s] + GS[s], db = bqb - GS[384 + s] + GS[256 + s];
            const float ef = (s <= ql) ? fexp(df - mrf) : 0.f, eb = (s >= ql) ? fexp(db - mrb) : 0.f; const float s0 = sf[t][r];
            sf[t][r] = s0 * ef; sb[t][r] = s0 * eb; rsf += sf[t][r]; rsb += sb[t][r]; }
    rsf += __shfl_xor(rsf, 16); rsf += __shfl_xor(rsf, 32); rsb += __shfl_xor(rsb, 16); rsb += __shfl_xor(rsb, 32);
    float qnf = 0.f, qnb = 0.f;
#pragma unroll
    for (int i = 0; i < 4; ++i) { const u32x4 qv = __builtin_bit_cast(u32x4, qa[i]); const int d0 = 32 * i + 8 * fq;
        const float qq[8] = {bflo(qv.x), bfhi(qv.x), bflo(qv.y), bfhi(qv.y), bflo(qv.z), bfhi(qv.z), bflo(qv.w), bfhi(qv.w)};
#pragma unroll
        for (int j = 0; j < 8; ++j) { qnf += qq[j] * GS[512 + d0 + j]; qnb += qq[j] * GS[640 + d0 + j]; } }
    qnf += __shfl_xor(qnf, 16); qnf += __shfl_xor(qnf, 32); qnb += __shfl_xor(qnb, 16); qnb += __shfl_xor(qnb, 32);
    const float af = fexp(bqf + mf - mrf), ab = fexp(bqb + mb - mrb);
    const float dnf = fmaxf(fabsf(af * qnf + rsf), fexp(-mrf)), dnb = fmaxf(fabsf(ab * qnb + rsb), fexp(-mrb));
    const float ivf = 1.f / dnf, ivb = 1.f / dnb, rf = af * ivf, rb = ab * ivb;
#pragma unroll
    for (int t = 0; t < 8; ++t) *(LAS u32x2*)(PW + fr * 136 + 16 * t + 4 * fq) = pack4(sf[t] * ivf + sb[t] * ivb);
    LDS_WAIT(); asm volatile("" ::: "memory");
    f32x4 hv[8]; zero_acc<8>(hv);
    wave_mm<8>(hv, (const LAS u16*)PW, 136, (const LAS u16*)VT, 136, 128, F.lane);
    zero_acc<8>(sf);
    wave_mm128_areg<8>(sf, qa, (const LAS u16*)SF, 136, F.lane);
#pragma unroll
    for (int t = 0; t < 8; ++t) hv[t] += sf[t] * rf;
    zero_acc<8>(sb);
    wave_mm128_areg<8>(sb, qa, (const LAS u16*)SB, 136, F.lane);
    float s1 = 0.f;
#pragma unroll
    for (int t = 0; t < 8; ++t) { hv[t] += sb[t] * rb; s1 += (hv[t][0] + hv[t][1]) + (hv[t][2] + hv[t][3]); }
    s1 += __shfl_xor(s1, 16); s1 += __shfl_xor(s1, 32);
    const float mean = s1 * (1.f / 128.f); float s2 = 0.f;
#pragma unroll
    for (int t = 0; t < 8; ++t) { hv[t] = hv[t] - mean; s2 += (hv[t][0] * hv[t][0] + hv[t][1] * hv[t][1]) + (hv[t][2] * hv[t][2] + hv[t][3] * hv[t][3]); }
    s2 += __shfl_xor(s2, 16); s2 += __shfl_xor(s2, 32);
    const float rstd = 1.f / sqrtf(s2 * (1.f / 128.f) + LN_EPS);
    const size_t row = (size_t)(r0 + ql);
#pragma unroll
    for (int hb = 0; hb < 2; ++hb) {
        f32x4 mg[4], sk[4]; u32x2 xcq[4], soq[4];
#pragma unroll
        for (int tt = 0; tt < 4; ++tt) { const int e0 = 128 * h + 16 * (4 * hb + tt) + 4 * fq;
            mg[tt] = *(const f32x4*)(F.mh_g() + e0); sk[tt] = *(const f32x4*)(F.skip() + e0); xcq[tt] = *(const GAS u32x2*)(F.XC() + row * 1024 + e0); soq[tt] = *(const GAS u32x2*)(F.PROJ() + row * NPJ + OFF_OB + e0); }
#pragma unroll
        for (int tt = 0; tt < 4; ++tt) { const int e0 = 128 * h + 16 * (4 * hb + tt) + 4 * fq;
            *(GAS u32x2*)(F.AB() + row * 2048 + 1024 + e0) = pack4(unpack4(soq[tt]) * (hv[4 * hb + tt] * rstd * mg[tt] + sk[tt] * unpack4(xcq[tt]))); }
    }
    __syncthreads();
}

DI void p8_rows(Frame& F) {
    LAS int* HC = (LAS int*)F.lds; LAS int* HB = HC + 32;
    LAS float* ST2 = (LAS float*)(F.lds + 256);
    LAS float* SCP = (LAS float*)(F.lds + 1024);
    LAS float* SHP = SCP + 2048;
    LAS float* LGP = SHP + 2048;
    const float* mod = F.MOD();
    const int fr = F.lane & 15, fq = F.lane >> 4;
    for (int i = F.tid; i < 2048; i += 512) { SCP[i] = 1.f + mod[4 * 2048 + i]; SHP[i] = mod[3 * 2048 + i]; }
    const u16* WRH = (const u16*)F.WRT(); const u16* WRL = WRH + 48 * 2048;
    for (int rb = F.bid; rb < T / 64; rb += F.G) {
        if (F.tid < 32) HC[F.tid] = 0;
        for (int i = 0; i < 8; ++i) {
            const int rl = 8 * F.wave + i, r = 64 * rb + rl;
            GAS u32x2* xr = (GAS u32x2*)(F.X1() + (size_t)r * D) + F.lane;
            f32x4 v[8]; float s = 0.f;
#pragma unroll
            for (int j = 0; j < 8; ++j) { v[j] = unpack4(xr[64 * j]); s += (v[j][0] + v[j][1]) + (v[j][2] + v[j][3]); }
            float mean = wave_sum(s) * (1.f / D), s2 = 0.f;
#pragma unroll
            for (int j = 0; j < 8; ++j) { v[j] = v[j] - mean; s2 += (v[j][0] * v[j][0] + v[j][1] * v[j][1]) + (v[j][2] * v[j][2] + v[j][3] * v[j][3]); }
            float rstd = 1.f / sqrtf(wave_sum(s2) * (1.f / D) + LN_EPS);
            s = 0.f;
#pragma unroll
            for (int j = 0; j < 8; ++j) { const f32x4 g = *(const f32x4*)(F.ln1_g() + 4 * F.lane + 256 * j), b = *(const f32x4*)(F.ln1_b() + 4 * F.lane + 256 * j);
                const u32x2 pk = pack4(v[j] * rstd * g + b); xr[64 * j] = pk; v[j] = unpack4(pk); s += (v[j][0] + v[j][1]) + (v[j][2] + v[j][3]); }
            mean = wave_sum(s) * (1.f / D); s2 = 0.f;
#pragma unroll
            for (int j = 0; j < 8; ++j) { const f32x4 d = v[j] - mean; s2 += (d[0] * d[0] + d[1] * d[1]) + (d[2] * d[2] + d[3] * d[3]); }
            rstd = 1.f / sqrtf(wave_sum(s2) * (1.f / D) + LN_EPS);
            if (F.lane == 0) { ST2[2 * rl] = mean; ST2[2 * rl + 1] = rstd; }
        }
        asm volatile("s_waitcnt vmcnt(0)" ::: "memory");
        __syncthreads();
        {
            const int tile = F.wave & 3, kh = F.wave >> 2, rl = 16 * tile + fr; const size_t r = (size_t)(64 * rb + rl);
            const float mean2 = ST2[2 * rl], rstd2 = ST2[2 * rl + 1];
            f32x4 acc[3]; zero_acc<3>(acc);
#pragma unroll 2
            for (int ks = 0; ks < 32; ++ks) {
                const int k = 1024 * kh + 32 * ks + 8 * fq;
                const u32x4 ax = *(const GAS u32x4*)(F.X1() + r * D + k); const f32x4 a0 = (f32x4){bflo(ax.x), bfhi(ax.x), bflo(ax.y), bfhi(ax.y)}, a1 = (f32x4){bflo(ax.z), bfhi(ax.z), bflo(ax.w), bfhi(ax.w)};
                const f32x4 u0 = (a0 - mean2) * rstd2 * *(const LAS f32x4*)(SCP + k) + *(const LAS f32x4*)(SHP + k);
                const f32x4 u1 = (a1 - mean2) * rstd2 * *(const LAS f32x4*)(SCP + k + 4) + *(const LAS f32x4*)(SHP + k + 4);
                u32x4 hi; hi.x = cvt_pk_bf16(u0[0], u0[1]); hi.y = cvt_pk_bf16(u0[2], u0[3]); hi.z = cvt_pk_bf16(u1[0], u1[1]); hi.w = cvt_pk_bf16(u1[2], u1[3]);
                u32x4 lo; lo.x = cvt_pk_bf16(u0[0] - bflo(hi.x), u0[1] - bfhi(hi.x)); lo.y = cvt_pk_bf16(u0[2] - bflo(hi.y), u0[3] - bfhi(hi.y));
                lo.z = cvt_pk_bf16(u1[0] - bflo(hi.z), u1[1] - bfhi(hi.z)); lo.w = cvt_pk_bf16(u1[2] - bflo(hi.w), u1[3] - bfhi(hi.w));
                *(GAS u32x4*)(F.U2() + r * D + k) = hi;
                const bf16x8 ah = __builtin_bit_cast(bf16x8, hi), al = __builtin_bit_cast(bf16x8, lo);
#pragma unroll
                for (int t = 0; t < 3; ++t) { const bf16x8 bh = ld8((const GAS u16*)(WRH + (16 * t + fr) * 2048 + k)), bl = ld8((const GAS u16*)(WRL + (16 * t + fr) * 2048 + k));
                    acc[t] = __builtin_amdgcn_mfma_f32_16x16x32_bf16(bh, ah, acc[t], 0, 0, 0);
                    acc[t] = __builtin_amdgcn_mfma_f32_16x16x32_bf16(bh, al, acc[t], 0, 0, 0);
                    acc[t] = __builtin_amdgcn_mfma_f32_16x16x32_bf16(bl, ah, acc[t], 0, 0, 0); }
            }
#pragma unroll
            for (int t = 0; t < 3; ++t) *(LAS f32x4*)(LGP + (kh * 64 + rl) * 48 + 16 * t + 4 * fq) = acc[t];
        }
        __syncthreads();
        if (F.tid < 64) {
            const int rl = F.tid, r = 64 * rb + rl; const LAS float* l0 = LGP + rl * 48; const LAS float* l1 = LGP + (64 + rl) * 48;
            float gl[4];
#pragma unroll
            for (int g = 0; g < 4; ++g) gl[g] = l0[g] + l1[g] + F.b_rg()[g];
            int gs = 0; float gm = gl[0];
#pragma unroll
            for (int g = 1; g < 4; ++g) if (gl[g] > gm) { gm = gl[g]; gs = g; }
            float gsum = 0.f;
#pragma unroll
            for (int g = 0; g < 4; ++g) gsum += expf(gl[g] - gm);
            const float pg = 1.f / gsum;
            float el[8];
#pragma unroll
            for (int j = 0; j < 8; ++j) el[j] = l0[4 + 8 * gs + j] + l1[4 + 8 * gs + j] + F.b_re()[8 * gs + j];
            int i0 = 0; float m0 = el[0];
#pragma unroll
            for (int j = 1; j < 8; ++j) if (el[j] > m0) { m0 = el[j]; i0 = j; }
            int i1 = -1; float m1 = -3.0e38f;
#pragma unroll
            for (int j = 0; j < 8; ++j) if (j != i0 && el[j] > m1) { m1 = el[j]; i1 = j; }
            const float x1 = expf(m1 - m0), w0 = pg / (1.f + x1), w1 = pg * x1 / (1.f + x1);
            const int e0 = gs * 8 + i0, e1 = gs * 8 + i1;
            const int sl0 = __hip_atomic_fetch_add(&HC[e0], 1, __ATOMIC_RELAXED, __HIP_MEMORY_SCOPE_WORKGROUP), sl1 = __hip_atomic_fetch_add(&HC[e1], 1, __ATOMIC_RELAXED, __HIP_MEMORY_SCOPE_WORKGROUP);
            F.TOKE()[2 * r] = e0; F.TOKE()[2 * r + 1] = e1; F.TOKW()[2 * r] = w0; F.TOKW()[2 * r + 1] = w1; F.TOKS()[2 * r] = sl0; F.TOKS()[2 * r + 1] = sl1;
        }
        __syncthreads();
        if (F.tid < 32) HB[F.tid] = (int)__hip_atomic_fetch_add(F.ctl() + CW_CNT + F.tid, (unsigned)HC[F.tid], __ATOMIC_RELAXED, __HIP_MEMORY_SCOPE_AGENT);
        __syncthreads();
        if (F.tid < 64) { const int r = 64 * rb + F.tid; F.TOKS()[2 * r] += HB[F.TOKE()[2 * r]]; F.TOKS()[2 * r + 1] += HB[F.TOKE()[2 * r + 1]]; }
        __syncthreads();
    }
}

DI int moe_tables(Frame& F) {
    LAS int* TE = (LAS int*)(F.lds + TILEE_OFF); LAS int* RB = TE + XS_TILES; LAS int* NTp = RB + 32;
    __syncthreads();
    if (F.tid == 0) { int tb = 0; for (int e = 0; e < NE; ++e) { const int cnt = (int)__hip_atomic_load(F.ctl() + CW_CNT + e, __ATOMIC_RELAXED, __HIP_MEMORY_SCOPE_AGENT); int nt = (cnt + 255) >> 8; if (tb + nt > XS_TILES) nt = XS_TILES - tb;
            RB[e] = tb * 256; for (int i = 0; i < nt; ++i) TE[tb + i] = e; tb += nt; } NTp[0] = tb; }
    __syncthreads();
    return NTp[0];
}
DI void p9_gather(Frame& F) {
    (void)moe_tables(F);
    const LAS int* RB = (const LAS int*)(F.lds + TILEE_OFF) + XS_TILES;
    const int gw = F.bid * 8 + F.wave, NGW = F.G * 8;
    for (int a0 = gw; a0 < 2 * T; a0 += 4 * NGW) {
        int pos[4]; u32x4 d[4][4];
#pragma unroll
        for (int q = 0; q < 4; ++q) { const int a = a0 + q * NGW; const bool ok = a < 2 * T; const int aa = ok ? a : a0; pos[q] = ok ? RB[F.TOKE()[aa]] + F.TOKS()[aa] : -1; }
#pragma unroll
        for (int q = 0; q < 4; ++q) { const int a = (a0 + q * NGW) < 2 * T ? a0 + q * NGW : a0; const GAS u32x4* src = (const GAS u32x4*)(F.U2() + (size_t)(a >> 1) * D) + F.lane;
#pragma unroll
            for (int j = 0; j < 4; ++j) d[q][j] = src[64 * j]; }
#pragma unroll
        for (int q = 0; q < 4; ++q) { if (pos[q] < 0) continue; if (F.lane == 0) F.TOKP()[a0 + q * NGW] = pos[q];
            GAS u32x4* dst = (GAS u32x4*)(F.XS() + (size_t)pos[q] * D) + F.lane;
#pragma unroll
            for (int j = 0; j < 4; ++j) dst[64 * j] = d[q][j]; }
    }
}
DI void p12_rows(Frame& F) {
    const int gw = F.bid * 8 + F.wave, NGW = F.G * 8; const float* g2 = F.MOD() + 5 * 2048;
    for (int rr = gw; rr < T; rr += 2 * NGW) {
        u32x2 xq[2][8], ya[2][8], yb[2][8]; f32x4 v[2][8]; float w0[2], w1[2]; bool ok[2]; int rw[2];
#pragma unroll
        for (int q = 0; q < 2; ++q) { const int r = rr + q * NGW; ok[q] = r < T; rw[q] = ok[q] ? r : rr;
            const int p0 = F.TOKP()[2 * rw[q]], p1 = F.TOKP()[2 * rw[q] + 1]; w0[q] = F.TOKW()[2 * rw[q]]; w1[q] = F.TOKW()[2 * rw[q] + 1];
            const GAS u32x2* xr = (const GAS u32x2*)(F.X1() + (size_t)rw[q] * D) + F.lane;
            const GAS u32x2* y0 = (const GAS u32x2*)(F.YS() + (size_t)p0 * D) + F.lane; const GAS u32x2* y1 = (const GAS u32x2*)(F.YS() + (size_t)p1 * D) + F.lane;
#pragma unroll
            for (int j = 0; j < 8; ++j) { xq[q][j] = xr[64 * j]; ya[q][j] = y0[64 * j]; yb[q][j] = y1[64 * j]; } }
#pragma unroll
        for (int q = 0; q < 2; ++q) { if (!ok[q]) continue;
            float s = 0.f;
#pragma unroll
            for (int j = 0; j < 8; ++j) { const f32x4 f = unpack4(ya[q][j]) * w0[q] + unpack4(yb[q][j]) * w1[q]; const f32x4 g = *(const f32x4*)(g2 + 4 * F.lane + 256 * j);
                v[q][j] = unpack4(xq[q][j]) * ALPHA + g * f; s += (v[q][j][0] + v[q][j][1]) + (v[q][j][2] + v[q][j][3]); }
            const float mean = wave_sum(s) * (1.f / D); float s2 = 0.f;
#pragma unroll
            for (int j = 0; j < 8; ++j) { v[q][j] = v[q][j] - mean; s2 += (v[q][j][0] * v[q][j][0] + v[q][j][1] * v[q][j][1]) + (v[q][j][2] * v[q][j][2] + v[q][j][3] * v[q][j][3]); }
            const float rstd = 1.f / sqrtf(wave_sum(s2) * (1.f / D) + LN_EPS);
            GAS f32x4* xo = (GAS f32x4*)(F.out() + (size_t)rw[q] * D) + F.lane;
#pragma unroll
            for (int j = 0; j < 8; ++j) { const f32x4 g = *(const f32x4*)(F.ln2_g() + 4 * F.lane + 256 * j), b = *(const f32x4*)(F.ln2_b() + 4 * F.lane + 256 * j); xo[64 * j] = v[q][j] * rstd * g + b; } }
    }
}

__global__ void __launch_bounds__(512, 2) mk_fwd(Args args) {
    extern __shared__ __attribute__((aligned(16))) unsigned char lds[];
    Frame F;
    F.lds = (LAS unsigned char*)lds;
    F.tid = threadIdx.x; F.lane = F.tid & 63; F.wave = __builtin_amdgcn_readfirstlane(F.tid >> 6); F.bid = blockIdx.x; F.G = gridDim.x;
    F.a = &args; F.ws = args.ws;
    for (int u = F.tid; u < (LDS_BYTES - LDSCTL_OFF) / 4; u += 512) ((LAS unsigned*)(F.lds + LDSCTL_OFF))[u] = 0u;
    __syncthreads();
    const int lo = args.ph_lo, hi = args.ph_hi;
    const bool fused = (hi - lo) > 1;
    XcdBarrier bar; bar.bar = F.ctl() + CW_BAR; bar.x = 0; bar.st = nullptr;
    if (fused) bar = xcd_barrier_post(F.ctl() + CW_BAR, (volatile LAS unsigned*)(F.lds + MISC_OFF));
#ifndef PH_MASK
#define PH_MASK 0x1fff
#endif
#define IN(k) (((PH_MASK >> (k)) & 1) && lo <= (k) && (k) < hi)
#define SEAM(k) do { if (IN(k) && IN((k) + 1)) xcd_barrier(bar); PEND(k); PSTART((k) + 1); } while (0)
#ifdef PROBE_MASK
    unsigned long long p_t = __builtin_amdgcn_s_memrealtime(), p_acc = 0;
#define PSTART(k) do { if ((PROBE_MASK >> (k)) & 1) p_t = __builtin_amdgcn_s_memrealtime(); } while (0)
#define PEND(k) do { if ((PROBE_MASK >> (k)) & 1) p_acc += __builtin_amdgcn_s_memrealtime() - p_t; } while (0)
#else
#define PSTART(k) do { } while (0)
#define PEND(k) do { } while (0)
#endif

    if (IN(0)) { p0_prologue(F); } SEAM(0);
    if (IN(1)) { p1_rows(F); } SEAM(1);
    if (IN(2)) {
        pg8::SchedGrid<0> S; S.nM = TR / 256; S.nN = NPAD / 256; S.nwg = S.nM * S.nN; S.G = F.G; S.c = F.bid; S.A = (const char*)F.U(); S.B = (const char*)F.WIN(); S.a_tile = (size_t)256 * 2048 * 2; S.b_tile = (size_t)256 * 2048 * 2; S.a_split = 0; S.b_split = 0;
        pg8::EpiProj E{F.PROJ(), F.GATES(), F.b_in(), (float*)(F.ws + WS_STATP)};
        pg8::gemm_phase<pg8::EpiProj, pg8::SchedGrid<0>, true>(F.lds, 2048, 2048, 2048, S, E);
    } SEAM(2);
    if (IN(3)) {
        int cur_g = -1, cur_h = -1;
        for (int u = F.bid; u < 1024 + NCH * 8; u += F.G) { if (u < 1024) { PSTART(13); gmlp_unit(F, u >> 3, u & 7, cur_g); PEND(13); } else { const int v = u - 1024; PSTART(14); mprep_unit(F, v >> 3, v & 7, cur_h); PEND(14); } }
    } SEAM(3);
    if (IN(4)) { for (int u = F.bid; u < 256; u += F.G) scan_item(F, u >> 4, u & 15); } SEAM(4);
    if (IN(5)) { for (int u = F.bid; u < 1024; u += F.G) x3_unit(F, u >> 3, u & 7); } SEAM(5);
    if (IN(6)) {
        pg8::SchedGrid<1> S; S.nM = T / 256; S.nN = 8; S.nwg = S.nM * S.nN; S.G = F.G; S.c = F.bid; S.A = (const char*)F.AB(); S.B = (const char*)F.PAB(); S.a_tile = (size_t)256 * 2048 * 2; S.b_tile = (size_t)256 * 2048 * 2; S.a_split = 2048; S.b_split = 2048;
        pg8::EpiMerge E{F.Z(), F.PROJ()};
        pg8::gemm_phase<pg8::EpiMerge, pg8::SchedGrid<1>, true>(F.lds, 1024, 2048, 2048, S, E);
    } SEAM(6);
    if (IN(7)) {
        pg8::SchedGrid<0> S; S.nM = T / 256; S.nN = 8; S.nwg = S.nM * S.nN; S.G = F.G; S.c = F.bid; S.A = (const char*)F.Z(); S.B = (const char*)F.WO(); S.a_tile = (size_t)256 * 2048 * 2; S.b_tile = (size_t)256 * 2048 * 2; S.a_split = 0; S.b_split = 0;
        pg8::EpiWo E{F.x(), F.X1(), F.MOD() + 2 * 2048};
        pg8::gemm_phase<pg8::EpiWo, pg8::SchedGrid<0>, true>(F.lds, 2048, 2048, 2048, S, E);
    } SEAM(7);
    if (IN(8)) { p8_rows(F); } SEAM(8);
    if (IN(9)) { p9_gather(F); } SEAM(9);
    if (IN(10)) {
        const int NT = moe_tables(F);
        pg8::SchedMoe S; S.nwg = NT * 8; S.G = F.G; S.c = F.bid; S.tile_e = (const LAS int*)(F.lds + TILEE_OFF); S.A = (const char*)F.XS(); S.B = (const char*)F.W13(); S.a_tile = (size_t)256 * 2048 * 2; S.b_exp = (size_t)2048 * 2048 * 2; S.b_tile = (size_t)256 * 2048 * 2;
        pg8::EpiMoeUp E{F.H()};
        pg8::gemm_phase<pg8::EpiMoeUp, pg8::SchedMoe, true>(F.lds, 2048, 2048, 2048, S, E);
    } SEAM(10);
    if (IN(11)) {
        const int NT = moe_tables(F);
        pg8::SchedMoe S; S.nwg = NT * 8; S.G = F.G; S.c = F.bid; S.tile_e = (const LAS int*)(F.lds + TILEE_OFF); S.A = (const char*)F.H(); S.B = (const char*)F.W2(); S.a_tile = (size_t)256 * 1024 * 2; S.b_exp = (size_t)2048 * 1024 * 2; S.b_tile = (size_t)256 * 1024 * 2;
        pg8::EpiMoeDown E{F.YS()};
        pg8::gemm_phase<pg8::EpiMoeDown, pg8::SchedMoe, true>(F.lds, 1024, 1024, 1024, S, E);
    } SEAM(11);
    if (IN(12)) { p12_rows(F); }
    PEND(12);
#ifdef PROBE_MASK
    if (fused) xcd_barrier(bar);
    if (F.bid == 0 && F.tid == 0) { const unsigned long long t0 = __builtin_amdgcn_s_memrealtime(); while (__builtin_amdgcn_s_memrealtime() - t0 < p_acc * PROBE_MUL) __builtin_amdgcn_s_sleep(8); }
#endif
#undef IN
#undef SEAM
}

extern "C" void kernel_launch(void* const* d_in, const int* in_sizes, int n_in, void* d_out, int out_size, void* d_ws, size_t ws_size, hipStream_t stream) {
    static int grid = 0;
    if (grid == 0) {
        if (n_in != 32 || out_size != T * D || ws_size < WS_END) { fprintf(stderr, "kernel_launch: unexpected shapes (n_in %d, out %d, ws %zu; need ws >= %zu); nothing launched\n", n_in, out_size, ws_size, (size_t)WS_END); grid = -1; return; }
        int dev = 0, cus = 0, per_cu = 0;
        if (hipGetDevice(&dev) != hipSuccess || hipDeviceGetAttribute(&cus, hipDeviceAttributeMultiprocessorCount, dev) != hipSuccess) { grid = -1; return; }
        if (hipFuncSetAttribute((const void*)mk_fwd, hipFuncAttributeMaxDynamicSharedMemorySize, LDS_BYTES) != hipSuccess) { fprintf(stderr, "kernel_launch: hipFuncSetAttribute failed\n"); grid = -1; return; }
        if (hipOccupancyMaxActiveBlocksPerMultiprocessor(&per_cu, (const void*)mk_fwd, 512, LDS_BYTES) != hipSuccess || per_cu < 1) { fprintf(stderr, "kernel_launch: occupancy query reports %d\n", per_cu); }
        (void)hipGetLastError();
        grid = cus;
    }
    if (grid < 0) return;
    (void)hipMemsetAsync((char*)d_ws + WS_CTL, 0, CTL_ZERO_BYTES, stream);
    Args a{};
    for (int i = 0; i < 32; ++i) a.in[i] = (const float*)d_in[i];
    a.outp = (float*)d_out; a.ws = (unsigned char*)d_ws;
    if (MK_N_LAUNCHES == 1) { a.ph_lo = 0; a.ph_hi = NPHASE; hipLaunchKernelGGL(mk_fwd, dim3(grid), dim3(512), LDS_BYTES, stream, a); }
    else for (int p = 0; p < NPHASE; ++p) { a.ph_lo = p; a.ph_hi = p + 1; hipLaunchKernelGGL(mk_fwd, dim3(grid), dim3(512), LDS_BYTES, stream, a); }
}
```

```cpp
#include <hip/hip_runtime.h>
#include <cstdio>
#include <cstdint>

#ifndef MK_N_LAUNCHES
#define MK_N_LAUNCHES 1
#endif

#define GAS __attribute__((address_space(1)))
#define LAS __attribute__((address_space(3)))
#define DI __device__ __forceinline__
typedef unsigned short u16;
typedef short bf16x8 __attribute__((ext_vector_type(8)));
typedef float f32x4 __attribute__((ext_vector_type(4)));
typedef float f32x2 __attribute__((ext_vector_type(2)));
typedef unsigned u32x4 __attribute__((ext_vector_type(4)));
typedef unsigned u32x2 __attribute__((ext_vector_type(2)));

constexpr int T = 16384, TC = 256, TR = T + TC, D = 2048, DIN = 9248, NPJ = 9216, NPAD = 9472;
constexpr int OFF_UA = 0, OFF_VA = 1024, OFF_XM = 2048, OFF_VB = 3072, OFF_OB = 4096, OFF_GA = 5120, OFF_GB = 7168, OFF_GATES = 9216;
constexpr int NCH = 130;
constexpr int NE = 32, DE = 1024;
constexpr int XS_TILES = 160;
constexpr float LN_EPS = 1e-5f, NEGF = -1e30f, ALPHA = 1.189207115002721f;
constexpr int NPHASE = 13;

constexpr size_t MiB = 1u << 20;
constexpr size_t WS_CTL = 0, CTL_ZERO_BYTES = 1 * MiB;
constexpr size_t WS_MOD = 1 * MiB;
constexpr size_t WS_WRT = 1 * MiB + 512 * 1024;
constexpr size_t WS_WQK = 2 * MiB;
constexpr size_t WS_WSB = 2 * MiB + 512 * 1024;
constexpr size_t WS_GB = 3 * MiB;
constexpr size_t WS_NL = 6 * MiB;
constexpr size_t WS_SC = 7 * MiB + 512 * 1024;
constexpr size_t WS_TOKE = 8 * MiB;
constexpr size_t WS_TOKW = 8 * MiB + 128 * 1024;
constexpr size_t WS_TOKS = 8 * MiB + 256 * 1024;
constexpr size_t WS_TOKP = 8 * MiB + 384 * 1024;
constexpr size_t WS_GATES = 9 * MiB;
constexpr size_t WS_STATP = 12 * MiB;
constexpr size_t WS_WIN = 16 * MiB;
constexpr size_t WS_PAB = 53 * MiB;
constexpr size_t WS_WO = 61 * MiB;
constexpr size_t WS_W13 = 69 * MiB;
constexpr size_t WS_W2 = 325 * MiB;
constexpr size_t WS_R1 = 453 * MiB;
constexpr size_t WS_XS = WS_R1, WS_H = WS_R1 + 160 * MiB;
constexpr size_t WS_R2 = 746 * MiB;
constexpr size_t WS_R3 = 811 * MiB;
constexpr size_t WS_R4 = 875 * MiB;
constexpr size_t WS_R5 = 940 * MiB;
constexpr size_t WS_YS = WS_R2;
constexpr size_t WS_END = 1004 * MiB;
static_assert(WS_R1 + (size_t)TR * NPJ * 2 <= WS_R2 && WS_H + (size_t)XS_TILES * 256 * 1024 * 2 <= WS_R2, "R1");
static_assert(WS_R2 + (size_t)TR * 2048 * 2 <= WS_R3 && WS_R3 + (size_t)T * 2048 * 2 <= WS_R4 && WS_R4 + (size_t)16 * NCH * 16384 * 2 <= WS_R5 && WS_R5 + (size_t)T * 2048 * 2 <= WS_END, "R2-5");
static_assert(WS_YS + (size_t)XS_TILES * 256 * 2048 * 2 <= WS_R5, "YS");
static_assert(WS_WIN + (size_t)NPAD * 2048 * 2 <= WS_PAB && WS_W13 + (size_t)32 * 2048 * 2048 * 2 <= WS_W2 && WS_W2 + (size_t)32 * 2048 * 1024 * 2 <= WS_R1, "weights");
static_assert(WS_GB + (size_t)8 * TR * 16 <= WS_NL && WS_NL + (size_t)16 * NCH * 128 * 4 <= WS_SC && WS_GATES + (size_t)TR * 32 * 4 <= WS_WIN, "small");
constexpr int CW_CNT = 64;
constexpr int CW_BAR = 4096;

constexpr int RING_BYTES = 131072;
constexpr int LDSCTL_OFF = 147456;
constexpr int MISC_OFF = LDSCTL_OFF + 64;
constexpr int TILEE_OFF = LDSCTL_OFF + 256;
constexpr int LDS_BYTES = 149504;

DI unsigned cvt_pk_bf16(float lo, float hi) { unsigned r; asm volatile("v_cvt_pk_bf16_f32 %0, %1, %2" : "=v"(r) : "v"(lo), "v"(hi)); return r; }
DI unsigned f2bf(float f) { return cvt_pk_bf16(f, 0.f) & 0xffffu; }
DI float bflo(unsigned w) { return __uint_as_float(w << 16); }
DI float bfhi(unsigned w) { return __uint_as_float(w & 0xffff0000u); }
DI u32x2 pack4(f32x4 v) { u32x2 o; o.x = cvt_pk_bf16(v[0], v[1]); o.y = cvt_pk_bf16(v[2], v[3]); return o; }
DI f32x4 unpack4(u32x2 w) { return (f32x4){bflo(w.x), bfhi(w.x), bflo(w.y), bfhi(w.y)}; }
DI float sigmoid_fast(float x) { return __builtin_amdgcn_rcpf(1.f + __builtin_amdgcn_exp2f(-1.4426950408889634f * x)); }
DI float gelu_tanh_fast(float x) { const float y = 1.5957691216057308f * (x + 0.044715f * x * x * x); return x * sigmoid_fast(y); }
DI float logsig(float x) { return x < 0.f ? x - log1pf(expf(x)) : -log1pf(expf(-x)); }
DI float wave_sum(float v) {
#pragma unroll
    for (int o = 1; o < 64; o <<= 1) v += __shfl_xor(v, o);
    return v;
}
DI float wave_max(float v) {
#pragma unroll
    for (int o = 1; o < 64; o <<= 1) v = fmaxf(v, __shfl_xor(v, o));
    return v;
}
#define LDS_WAIT() asm volatile("s_waitcnt lgkmcnt(0)" ::: "memory")

namespace pg8 {
constexpr int BM = 256, BK = 64, HALF = 128, HTB = HALF * BK * 2, STAGE_BYTES = 8 * HTB, NXCD = 8, WGM = 8;
__host__ __device__ __forceinline__ int lds_byte(int r, int c) { const int st = (r >> 4) * 2 + (c >> 5), rr = r & 15, cc = c & 31, ob = rr * 64 + cc * 2; return st * 1024 + (ob ^ (((ob >> 9) & 1) << 5)); }
__host__ __device__ __forceinline__ void stage_rc(int b, int& R, int& C) { const int st = b / 1024, sb = b % 1024, swz = sb ^ (((sb >> 9) & 1) << 5); R = (st >> 1) * 16 + swz / 64; C = (st & 1) * 32 + (swz % 64) / 2; }
__host__ __device__ __forceinline__ int perm32(int rho) { const int n = rho >> 4, i = rho & 15; return 8 * (i >> 2) + 4 * n + (i & 3); }
struct Unit { int pm, pn, ex; };
DI int xcd_remap(int wgid, int nwg) { const int q = nwg / NXCD, r = nwg % NXCD, xcd = wgid % NXCD, off = wgid / NXCD; return (xcd < r ? xcd * (q + 1) : r * (q + 1) + (xcd - r) * q) + off; }

template <int SPLIT> struct SchedGrid {
    int nM, nN, nwg, G, c; const char* A; const char* B; size_t a_tile, b_tile, a_split, b_split;
    DI bool next(int i, Unit& u) const {
        const int j = SPLIT ? (i >> 1) : i; u.ex = SPLIT ? (i & 1) : 0;
        const long L = (long)j * G + c; if (L >= nwg) return false;
        const int wgid = xcd_remap((int)L, nwg);
        const int nig = WGM * nN, gid = wgid / nig, fm = gid * WGM, gsz = (nM - fm) < WGM ? (nM - fm) : WGM;
        u.pm = fm + ((wgid % nig) % gsz); u.pn = (wgid % nig) / gsz; return true;
    }
    DI const char* a_base(const Unit& u) const { return A + (size_t)u.pm * a_tile + (size_t)u.ex * a_split; }
    DI const char* b_base(const Unit& u) const { return B + (size_t)u.pn * b_tile + (size_t)u.ex * b_split; }
    DI void a_ready(const Unit&) const {}
    DI void done(const Unit&) const {}
};
struct SchedMoe {
    int nwg, G, c; const LAS int* tile_e; const char* A; const char* B; size_t a_tile, b_exp, b_tile;
    DI bool next(int i, Unit& u) const {
        const long L = (long)i * G + c; if (L >= nwg) return false;
        const int w = xcd_remap((int)L, nwg); u.pm = w >> 3; u.pn = w & 7; u.ex = __builtin_amdgcn_readfirstlane(tile_e[u.pm]); return true;
    }
    DI const char* a_base(const Unit& u) const { return A + (size_t)u.pm * a_tile; }
    DI const char* b_base(const Unit& u) const { return B + (size_t)u.ex * b_exp + (size_t)u.pn * b_tile; }
    DI void a_ready(const Unit&) const {}
    DI void done(const Unit&) const {}
};

DI void glds16_saddr(const char* sbase, unsigned voff, unsigned lds_dst) {
    unsigned keep;
    asm volatile("s_mov_b32 %0, m0\n\ts_mov_b32 m0, %3\n\ts_nop 2\n\tglobal_load_lds_dwordx4 %1, %2\n\ts_mov_b32 m0, %0" : "=&s"(keep) : "v"(voff), "s"(sbase), "s"(lds_dst) : "memory");
}
template <class Epi, class Sched, bool ALIGN_EPI>
DI void gemm_phase(LAS unsigned char* lds, const int K, const int lda, const int ldb, const Sched& S, const Epi& E) {
    const int tid = threadIdx.x, wid = __builtin_amdgcn_readfirstlane(tid >> 6), lane = tid & 63, wr = wid >> 2, wc = wid & 3, fr = lane & 15, fq = lane >> 4;
    const int nt = K / BK;
    unsigned voffA[2], voffB[2];
#pragma unroll
    for (int i = 0; i < 2; ++i) { int R, C; stage_rc(tid * 16 + i * 8192, R, C); const int Rb = Epi::PERM ? ((R & ~31) + perm32(R & 31)) : R;
        voffA[i] = (unsigned)(R * lda + C) * 2u; voffB[i] = (unsigned)(Rb * ldb + C) * 2u; }
    const size_t kstep = (size_t)(BK * 2);
    const size_t hstepA = (size_t)HALF * lda * 2, hstepB = (size_t)HALF * ldb * 2;
    const unsigned ldsb = (unsigned)(size_t)lds + (unsigned)wid * 1024u;
    const int aoff = lds_byte(wr * 64 + fr, fq * 8), boff = lds_byte(wc * 32 + fr, fq * 8);
#define PG8_SA(b, h) (((b) * 2 + (h)) * HTB)
#define PG8_SB(b, h) ((4 + (b) * 2 + (h)) * HTB)
#define PG8_STAGE(bufoff, gbase, voff) do { _Pragma("unroll") for (int _i = 0; _i < 2; ++_i) glds16_saddr((const char*)(gbase), (voff)[_i], ldsb + (unsigned)((bufoff) + _i * 8192)); } while (0)
#define PG8_LDA(dst, b, h) do { _Pragma("unroll") for (int m = 0; m < 4; ++m) _Pragma("unroll") for (int k = 0; k < 2; ++k) dst[m][k] = *(const LAS bf16x8*)(lds + PG8_SA(b, h) + aoff + m * 2048 + k * 1024); } while (0)
#define PG8_LDB(dst, b, h) do { _Pragma("unroll") for (int n = 0; n < 2; ++n) _Pragma("unroll") for (int k = 0; k < 2; ++k) dst[n][k] = *(const LAS bf16x8*)(lds + PG8_SB(b, h) + boff + n * 2048 + k * 1024); } while (0)
#define PG8_MMA(ai, bj, At, Bt) do { __builtin_amdgcn_s_setprio(1); _Pragma("unroll") for (int m = 0; m < 4; ++m) _Pragma("unroll") for (int n = 0; n < 2; ++n) _Pragma("unroll") for (int k = 0; k < 2; ++k) \
        acc[ai][bj][m][n] = __builtin_amdgcn_mfma_f32_16x16x32_bf16(Bt[n][k], At[m][k], acc[ai][bj][m][n], 0, 0, 0); __builtin_amdgcn_s_setprio(0); } while (0)
#define PG8_WAIT_V(n) asm volatile("s_waitcnt vmcnt(" #n ")" ::: "memory")
#define PG8_WAIT_L(n) asm volatile("s_waitcnt lgkmcnt(" #n ")" ::: "memory")
#define PG8_BAR __builtin_amdgcn_s_barrier()
#define PG8_SCHED __builtin_amdgcn_sched_barrier(0)
    Unit cur, nxt; int ui = 0;
    if (!S.next(0, cur)) return;
    f32x4 acc[2][2][4][2];
#pragma unroll
    for (int a = 0; a < 2; ++a)
#pragma unroll
        for (int b = 0; b < 2; ++b)
#pragma unroll
            for (int m = 0; m < 4; ++m)
#pragma unroll
                for (int n = 0; n < 2; ++n) acc[a][b][m][n] = (f32x4){0.f, 0.f, 0.f, 0.f};
    bf16x8 At[4][2], B0[2][2], B1[2][2];
    const char* cA = S.a_base(cur); const char* cB = S.b_base(cur);
    S.a_ready(cur);
    PG8_STAGE(PG8_SB(0, 0), cB, voffB); PG8_STAGE(PG8_SB(0, 1), cB + hstepB, voffB); PG8_STAGE(PG8_SA(0, 0), cA, voffA); PG8_STAGE(PG8_SA(0, 1), cA + hstepA, voffA);
    if (wr == 1) PG8_BAR;
    PG8_WAIT_V(2); PG8_BAR;
    PG8_STAGE(PG8_SB(1, 0), cB + kstep, voffB); PG8_STAGE(PG8_SA(1, 0), cA + kstep, voffA); PG8_STAGE(PG8_SB(1, 1), cB + hstepB + kstep, voffB);
    PG8_WAIT_V(6); PG8_BAR;
    for (;;) {
        const bool has_next = S.next(ui + 1, nxt);
        const char* nA = has_next ? S.a_base(nxt) : cA; const char* nB = has_next ? S.b_base(nxt) : cB;
#pragma unroll 1
        for (int t = 0; t < nt; t += 2) {
            const bool last = (t == nt - 2);
            const char* a1 = cA + (size_t)(t + 1) * kstep;
            const char* a2 = last ? nA : cA + (size_t)(t + 2) * kstep; const char* b2 = last ? nB : cB + (size_t)(t + 2) * kstep;
            const char* a3 = a2 + kstep; const char* b3 = b2 + kstep;
            if (last && has_next) S.a_ready(nxt);
            PG8_LDB(B0, 0, 0); PG8_LDB(B1, 0, 1); PG8_SCHED; PG8_LDA(At, 0, 0); PG8_STAGE(PG8_SA(1, 1), a1 + hstepA, voffA);
            PG8_WAIT_V(8); PG8_WAIT_L(0); PG8_BAR; PG8_MMA(0, 0, At, B0); PG8_MMA(0, 1, At, B1); PG8_BAR; PG8_SCHED;
            PG8_LDA(At, 0, 1); PG8_STAGE(PG8_SB(0, 0), b2, voffB); PG8_STAGE(PG8_SB(0, 1), b2 + hstepB, voffB); PG8_STAGE(PG8_SA(0, 0), a2, voffA);
            PG8_WAIT_V(8); PG8_WAIT_L(0); PG8_BAR; PG8_MMA(1, 0, At, B0); PG8_MMA(1, 1, At, B1); PG8_BAR; PG8_SCHED;
            PG8_LDB(B0, 1, 0); PG8_LDB(B1, 1, 1); PG8_SCHED; PG8_LDA(At, 1, 0); PG8_STAGE(PG8_SA(0, 1), a2 + hstepA, voffA);
            PG8_WAIT_V(8); PG8_WAIT_L(0); PG8_BAR; PG8_MMA(0, 0, At, B0); PG8_MMA(0, 1, At, B1); PG8_BAR; PG8_SCHED;
            PG8_LDA(At, 1, 1); PG8_STAGE(PG8_SB(1, 0), b3, voffB); PG8_STAGE(PG8_SB(1, 1), b3 + hstepB, voffB); PG8_STAGE(PG8_SA(1, 0), a3, voffA);
            PG8_WAIT_V(8); PG8_WAIT_L(0); PG8_BAR; PG8_MMA(1, 0, At, B0); PG8_MMA(1, 1, At, B1); PG8_BAR; PG8_SCHED;
        }
        if constexpr (ALIGN_EPI) { if (wr == 0) PG8_BAR; }
        E(acc, cur, wr, wc, fr, fq); S.done(cur);
        if (!has_next) break;
#pragma unroll
        for (int a = 0; a < 2; ++a)
#pragma unroll
            for (int b = 0; b < 2; ++b)
#pragma unroll
                for (int m = 0; m < 4; ++m)
#pragma unroll
                    for (int n = 0; n < 2; ++n) acc[a][b][m][n] = (f32x4){0.f, 0.f, 0.f, 0.f};
        cur = nxt; cA = nA; cB = nB; ++ui;
        if constexpr (ALIGN_EPI) { if (wr == 1) PG8_BAR; }
    }
    PG8_WAIT_V(0);
    if constexpr (!ALIGN_EPI) { if (wr == 0) PG8_BAR; }
    PG8_BAR;
#undef PG8_SA
#undef PG8_SB
#undef PG8_STAGE
#undef PG8_LDA
#undef PG8_LDB
#undef PG8_MMA
#undef PG8_WAIT_V
#undef PG8_WAIT_L
#undef PG8_BAR
#undef PG8_SCHED
}

struct EpiProj {
    static constexpr bool PERM = true;
    u16* P; float* gates; const float* bias; float* statp;
    DI void operator()(const f32x4 (&acc)[2][2][4][2], const Unit& u, int wr, int wc, int fr, int fq) const {
        const int row0 = u.pm * BM + wr * 64 + fr;
        if (u.pn == 36) {
            if (wc == 0) {
                const int c0 = 8 * fq; const f32x4 b0 = *(const f32x4*)(bias + OFF_GATES + c0), b1 = *(const f32x4*)(bias + OFF_GATES + c0 + 4);
#pragma unroll
                for (int ai = 0; ai < 2; ++ai)
#pragma unroll
                    for (int m = 0; m < 4; ++m) { float* g = gates + (size_t)(row0 + ai * HALF + m * 16) * 32 + c0;
                        *(f32x4*)g = acc[ai][0][m][0] + b0; *(f32x4*)(g + 4) = acc[ai][0][m][1] + b1; }
            }
            return;
        }
        const int seg = u.pn >> 2; const int mode = (seg <= 1) ? 1 : ((seg <= 3) ? 0 : 2);
        const int col0 = u.pn * BM + wc * 32 + 8 * fq;
        f32x4 bv[2][2];
#pragma unroll
        for (int bj = 0; bj < 2; ++bj)
#pragma unroll
            for (int n = 0; n < 2; ++n) bv[bj][n] = *(const f32x4*)(bias + col0 + bj * HALF + 4 * n);
        float ps[2][4], pq[2][4];
#pragma unroll
        for (int ai = 0; ai < 2; ++ai)
#pragma unroll
            for (int m = 0; m < 4; ++m) { ps[ai][m] = 0.f; pq[ai][m] = 0.f; }
#pragma unroll
        for (int ai = 0; ai < 2; ++ai)
#pragma unroll
            for (int m = 0; m < 4; ++m) { u16* rowp = P + (size_t)(row0 + ai * HALF + m * 16) * NPJ + col0;
#pragma unroll
                for (int bj = 0; bj < 2; ++bj) { f32x4 v0 = acc[ai][bj][m][0] + bv[bj][0], v1 = acc[ai][bj][m][1] + bv[bj][1];
                    if (mode == 1) {
#pragma unroll
                        for (int j = 0; j < 4; ++j) { v0[j] = gelu_tanh_fast(v0[j]); v1[j] = gelu_tanh_fast(v1[j]); } }
                    else if (mode == 2) {
#pragma unroll
                        for (int j = 0; j < 4; ++j) { v0[j] = sigmoid_fast(v0[j]); v1[j] = sigmoid_fast(v1[j]); } }
                    u32x4 w; w.x = cvt_pk_bf16(v0[0], v0[1]); w.y = cvt_pk_bf16(v0[2], v0[3]); w.z = cvt_pk_bf16(v1[0], v1[1]); w.w = cvt_pk_bf16(v1[2], v1[3]);
                    *(u32x4*)(rowp + bj * HALF) = w;
                    if (seg == 1) {
                        const float r8[8] = {bflo(w.x), bfhi(w.x), bflo(w.y), bfhi(w.y), bflo(w.z), bfhi(w.z), bflo(w.w), bfhi(w.w)};
#pragma unroll
                        for (int j = 0; j < 8; ++j) { ps[ai][m] += r8[j]; pq[ai][m] += r8[j] * r8[j]; } } } }
        if (seg == 1) {
#pragma unroll
            for (int ai = 0; ai < 2; ++ai)
#pragma unroll
                for (int m = 0; m < 4; ++m) { float a = ps[ai][m], b = pq[ai][m]; a += __shfl_xor(a, 16); a += __shfl_xor(a, 32); b += __shfl_xor(b, 16); b += __shfl_xor(b, 32);
                    if (fq == 0) *(f32x2*)(statp + (size_t)(row0 + ai * HALF + m * 16) * 32 + ((u.pn & 3) * 4 + wc) * 2) = (f32x2){a, b}; }
        }
    }
};
struct EpiMerge {
    static constexpr bool PERM = true;
    u16* Z; const u16* P;
    DI void operator()(const f32x4 (&acc)[2][2][4][2], const Unit& u, int wr, int wc, int fr, int fq) const {
        const int row0 = u.pm * BM + wr * 64 + fr, col0 = u.pn * BM + wc * 32 + 8 * fq, goff = u.ex ? OFF_GB : OFF_GA;
#pragma unroll
        for (int ai = 0; ai < 2; ++ai) {
            u32x4 gq[4][2], zq[4][2];
#pragma unroll
            for (int m = 0; m < 4; ++m) { const size_t row = (size_t)(row0 + ai * HALF + m * 16); const u16* zp = Z + row * 2048 + col0; const u16* gp = P + row * NPJ + goff + col0;
#pragma unroll
                for (int bj = 0; bj < 2; ++bj) { gq[m][bj] = *(const u32x4*)(gp + bj * HALF); zq[m][bj] = u.ex ? *(const u32x4*)(zp + bj * HALF) : (u32x4){0u, 0u, 0u, 0u}; } }
#pragma unroll
            for (int m = 0; m < 4; ++m) { const size_t row = (size_t)(row0 + ai * HALF + m * 16); u16* zp = Z + row * 2048 + col0;
#pragma unroll
                for (int bj = 0; bj < 2; ++bj) { const u32x4 g = gq[m][bj], z = zq[m][bj];
                    const f32x4 v0 = acc[ai][bj][m][0] * (f32x4){bflo(g.x), bfhi(g.x), bflo(g.y), bfhi(g.y)} + (f32x4){bflo(z.x), bfhi(z.x), bflo(z.y), bfhi(z.y)};
                    const f32x4 v1 = acc[ai][bj][m][1] * (f32x4){bflo(g.z), bfhi(g.z), bflo(g.w), bfhi(g.w)} + (f32x4){bflo(z.z), bfhi(z.z), bflo(z.w), bfhi(z.w)};
                    u32x4 w; w.x = cvt_pk_bf16(v0[0], v0[1]); w.y = cvt_pk_bf16(v0[2], v0[3]); w.z = cvt_pk_bf16(v1[0], v1[1]); w.w = cvt_pk_bf16(v1[2], v1[3]);
                    *(u32x4*)(zp + bj * HALF) = w; } }
        }
    }
};
struct EpiWo {
    static constexpr bool PERM = true;
    const float* x; u16* R; const float* g1;
    DI void operator()(const f32x4 (&acc)[2][2][4][2], const Unit& u, int wr, int wc, int fr, int fq) const {
        const int row0 = u.pm * BM + wr * 64 + fr, col0 = u.pn * BM + wc * 32 + 8 * fq;
        f32x4 gv[2][2];
#pragma unroll
        for (int bj = 0; bj < 2; ++bj)
#pragma unroll
            for (int n = 0; n < 2; ++n) gv[bj][n] = *(const f32x4*)(g1 + col0 + bj * HALF + 4 * n);
#pragma unroll
        for (int ai = 0; ai < 2; ++ai) {
            f32x4 xs[4][2][2];
#pragma unroll
            for (int m = 0; m < 4; ++m) { const size_t off = (size_t)(row0 + ai * HALF + m * 16) * 2048 + col0;
#pragma unroll
                for (int bj = 0; bj < 2; ++bj)
#pragma unroll
                    for (int n = 0; n < 2; ++n) xs[m][bj][n] = *(const f32x4*)(x + off + bj * HALF + 4 * n); }
#pragma unroll
            for (int m = 0; m < 4; ++m) { const size_t off = (size_t)(row0 + ai * HALF + m * 16) * 2048 + col0;
#pragma unroll
                for (int bj = 0; bj < 2; ++bj) { const f32x4 v0 = xs[m][bj][0] * ALPHA + gv[bj][0] * acc[ai][bj][m][0], v1 = xs[m][bj][1] * ALPHA + gv[bj][1] * acc[ai][bj][m][1];
                    u32x4 w; w.x = cvt_pk_bf16(v0[0], v0[1]); w.y = cvt_pk_bf16(v0[2], v0[3]); w.z = cvt_pk_bf16(v1[0], v1[1]); w.w = cvt_pk_bf16(v1[2], v1[3]);
                    *(u32x4*)(R + off + bj * HALF) = w; } }
        }
    }
};
struct EpiMoeUp {
    static constexpr bool PERM = true;
    u16* H;
    DI void operator()(const f32x4 (&acc)[2][2][4][2], const Unit& u, int wr, int wc, int fr, int fq) const {
        const int row0 = u.pm * BM + wr * 64 + fr, col0 = u.pn * HALF + wc * 32 + 8 * fq;
#pragma unroll
        for (int ai = 0; ai < 2; ++ai)
#pragma unroll
            for (int m = 0; m < 4; ++m) { u16* hp = H + (size_t)(row0 + ai * HALF + m * 16) * DE + col0; f32x4 o[2];
#pragma unroll
                for (int n = 0; n < 2; ++n)
#pragma unroll
                    for (int j = 0; j < 4; ++j) { const float a = acc[ai][0][m][n][j]; o[n][j] = a * sigmoid_fast(a) * acc[ai][1][m][n][j]; }
                u32x4 w; w.x = cvt_pk_bf16(o[0][0], o[0][1]); w.y = cvt_pk_bf16(o[0][2], o[0][3]); w.z = cvt_pk_bf16(o[1][0], o[1][1]); w.w = cvt_pk_bf16(o[1][2], o[1][3]);
                *(u32x4*)hp = w; }
    }
};
struct EpiMoeDown {
    static constexpr bool PERM = true;
    u16* Y;
    DI void operator()(const f32x4 (&acc)[2][2][4][2], const Unit& u, int wr, int wc, int fr, int fq) const {
        const int row0 = u.pm * BM + wr * 64 + fr, col0 = u.pn * BM + wc * 32 + 8 * fq;
#pragma unroll
        for (int ai = 0; ai < 2; ++ai)
#pragma unroll
            for (int m = 0; m < 4; ++m) { u16* yp = Y + (size_t)(row0 + ai * HALF + m * 16) * 2048 + col0;
#pragma unroll
                for (int bj = 0; bj < 2; ++bj) { const f32x4 v0 = acc[ai][bj][m][0], v1 = acc[ai][bj][m][1];
                    u32x4 w; w.x = cvt_pk_bf16(v0[0], v0[1]); w.y = cvt_pk_bf16(v0[2], v0[3]); w.z = cvt_pk_bf16(v1[0], v1[1]); w.w = cvt_pk_bf16(v1[2], v1[3]);
                    *(u32x4*)(yp + bj * HALF) = w; } }
    }
};
}

#define XB_TMO      128
#define XB_XCNT(j)  (256  + 64 * (j))
#define XB_XSUB(j)  (1280 + 64 * (j))
#define XB_XGEN(j)  (2304 + 64 * (j))
#define XB_TOP      3328
#define XB_TOPGEN   3392
#define XCD_BAR_WORDS 3456
#define XB_SPIN_CAP (1u << 18)
__device__ __forceinline__ unsigned xb_ld(unsigned* p)              { return __hip_atomic_load(p, __ATOMIC_RELAXED, __HIP_MEMORY_SCOPE_AGENT); }
__device__ __forceinline__ unsigned xb_add(unsigned* p, unsigned v) { return __hip_atomic_fetch_add(p, v, __ATOMIC_RELAXED, __HIP_MEMORY_SCOPE_AGENT); }
__device__ __forceinline__ unsigned xb_xcc_id() { return (unsigned)__builtin_amdgcn_s_getreg((3 << 11) | 20) & 0xFu; }
#define XB_SPIN(cond, bar) do { unsigned _sp = 0; while (cond) { __builtin_amdgcn_s_sleep(1); \
    if ((++_sp & 255u) == 0u) { if (xb_ld(&(bar)[XB_TMO])) break; if (_sp > XB_SPIN_CAP) { atomicAdd(&(bar)[XB_TMO], 1u); break; } } } } while (0)
struct XcdBarrier { unsigned* bar; unsigned x; volatile LAS unsigned* st; };
__device__ __forceinline__ XcdBarrier xcd_barrier_post(unsigned* bar, volatile LAS unsigned* st) {
    XcdBarrier b; b.bar = bar; b.x = xb_xcc_id(); b.st = st;
    if (threadIdx.x == 0) (void)xb_add(&bar[XB_XCNT(b.x)], 1u);
    return b;
}
__device__ __forceinline__ void xcd_barrier_complete(unsigned* bar, unsigned x, unsigned& nloc, unsigned& nx) {
    const unsigned G = gridDim.x * gridDim.y * gridDim.z;
    unsigned sum, cnt, mine, sp = 0u;
    for (;;) {
        sum = 0u; cnt = 0u; mine = 0u;
#pragma unroll
        for (unsigned j = 0; j < 16; ++j) { const unsigned c = xb_ld(&bar[XB_XCNT(j)]); sum += c; cnt += (c > 0u) ? 1u : 0u; mine = (j == x) ? c : mine; }
        if (sum == G) break;
        __builtin_amdgcn_s_sleep(1);
        if ((++sp & 255u) == 0u) { if (xb_ld(&bar[XB_TMO])) break; if (sp > XB_SPIN_CAP) { atomicAdd(&bar[XB_TMO], 1u); break; } }
    }
    nloc = mine > 0u ? mine : 1u; nx = cnt > 0u ? cnt : 1u;
}
__device__ __forceinline__ void xcd_barrier(const XcdBarrier& b) {
    asm volatile("s_waitcnt vmcnt(0)" ::: "memory");
    __syncthreads();
    if (threadIdx.x == 0) {
        unsigned* bar = b.bar;
        __builtin_amdgcn_s_waitcnt(0);
        unsigned nloc = b.st[0], nx = b.st[1];
        if (nloc == 0u) { xcd_barrier_complete(bar, b.x, nloc, nx); b.st[0] = nloc; b.st[1] = nx; }
        const unsigned old = xb_add(&bar[XB_XSUB(b.x)], 1u);
        const unsigned gen = old / nloc;
        if (old + 1u == (gen + 1u) * nloc) {
            __builtin_amdgcn_fence(__ATOMIC_RELEASE, "agent");
            asm volatile("s_waitcnt vmcnt(0)" ::: "memory");
            const unsigned og = xb_add(&bar[XB_TOP], 1u);
            const unsigned tg = og / nx;
            if (og + 1u == (tg + 1u) * nx) xb_add(&bar[XB_TOPGEN], 1u);
            else XB_SPIN(xb_ld(&bar[XB_TOPGEN]) == tg, bar);
            __builtin_amdgcn_fence(__ATOMIC_ACQUIRE, "agent");
            xb_add(&bar[XB_XGEN(b.x)], 1u);
            asm volatile("s_waitcnt vmcnt(0)" ::: "memory");
        } else {
            XB_SPIN(xb_ld(&bar[XB_XGEN(b.x)]) == gen, bar);
            __builtin_amdgcn_fence(__ATOMIC_ACQUIRE, "agent");
            asm volatile("s_waitcnt vmcnt(0)" ::: "memory");
        }
    }
    __syncthreads();
}

struct Args { const float* in[32]; float* outp; unsigned char* ws; int ph_lo, ph_hi; };
struct Frame {
    LAS unsigned char* lds;
    int tid, lane, wave, bid, G;
    const Args* a; unsigned char* ws;
    DI const float* in(int i) const { asm("" : "+s"(i)); return a->in[i]; }
    DI const float* x() const { return in(0); }
    DI const float* c() const { return in(1); }
    DI const float* ctx() const { return in(2); }
    DI const float* c_ctx() const { return in(3); }
    DI const float* w_ada() const { return in(4); }
    DI const float* b_ada() const { return in(5); }
    DI const float* w_in() const { return in(6); }
    DI const float* b_in() const { return in(7); }
    DI const float* w_s() const { return in(8); }
    DI const float* b_s() const { return in(9); }
    DI const float* sgu_g() const { return in(10); }
    DI const float* sgu_b() const { return in(11); }
    DI const float* conv_w() const { return in(12); }
    DI const float* conv_b() const { return in(13); }
    DI const float* w_q() const { return in(14); }
    DI const float* w_k() const { return in(15); }
    DI const float* mh_g() const { return in(16); }
    DI const float* skip() const { return in(17); }
    DI const float* p_a() const { return in(18); }
    DI const float* p_b() const { return in(19); }
    DI const float* w_o() const { return in(20); }
    DI const float* ln1_g() const { return in(21); }
    DI const float* ln1_b() const { return in(22); }
    DI const float* w_rg() const { return in(23); }
    DI const float* b_rg() const { return in(24); }
    DI const float* w_re() const { return in(25); }
    DI const float* b_re() const { return in(26); }
    DI const float* w1() const { return in(27); }
    DI const float* w3() const { return in(28); }
    DI const float* w2() const { return in(29); }
    DI const float* ln2_g() const { return in(30); }
    DI const float* ln2_b() const { return in(31); }
    DI unsigned* ctl() const { return (unsigned*)(ws + WS_CTL); }
    DI float* MOD() const { return (float*)(ws + WS_MOD); }
    DI float* WRT() const { return (float*)(ws + WS_WRT); }
    DI float* GB() const { return (float*)(ws + WS_GB); }
    DI float* NL() const { return (float*)(ws + WS_NL); }
    DI float* SC() const { return (float*)(ws + WS_SC); }
    DI float* TOKW() const { return (float*)(ws + WS_TOKW); }
    DI float* GATES() const { return (float*)(ws + WS_GATES); }
    DI int* TOKE() const { return (int*)(ws + WS_TOKE); }
    DI int* TOKS() const { return (int*)(ws + WS_TOKS); }
    DI int* TOKP() const { return (int*)(ws + WS_TOKP); }
    DI u16* WQK() const { return (u16*)(ws + WS_WQK); }
    DI u16* WSB() const { return (u16*)(ws + WS_WSB); }
    DI u16* WIN() const { return (u16*)(ws + WS_WIN); }
    DI u16* PAB() const { return (u16*)(ws + WS_PAB); }
    DI u16* WO() const { return (u16*)(ws + WS_WO); }
    DI u16* W13() const { return (u16*)(ws + WS_W13); }
    DI u16* W2() const { return (u16*)(ws + WS_W2); }
    DI u16* PROJ() const { return (u16*)(ws + WS_R1); }
    DI u16* XS() const { return (u16*)(ws + WS_XS); }
    DI u16* H() const { return (u16*)(ws + WS_H); }
    DI u16* U() const { return (u16*)(ws + WS_R2); }
    DI u16* Q() const { return (u16*)(ws + WS_R2); }
    DI u16* K() const { return (u16*)(ws + WS_R2) + (size_t)TR * 1024; }
    DI u16* U2() const { return (u16*)(ws + WS_R2); }
    DI u16* XC() const { return (u16*)(ws + WS_R3); }
    DI u16* Z() const { return (u16*)(ws + WS_R3); }
    DI u16* ST() const { return (u16*)(ws + WS_R4); }
    DI u16* AB() const { return (u16*)(ws + WS_R5); }
    DI u16* X1() const { return (u16*)(ws + WS_R5); }
    DI u16* YS() const { return (u16*)(ws + WS_YS); }
    DI float* out() const { return a->outp; }
};

DI bf16x8 ld8(const LAS u16* p) { return *(const LAS bf16x8*)p; }
DI bf16x8 ld8(const GAS u16* p) { return *(const GAS bf16x8*)p; }
template <int NT, class PA, class PB>
DI void wave_mm(f32x4 (&acc)[NT], PA A, int lda, PB B, int ldb, int K, int lane) {
    const int fr = lane & 15, fq = lane >> 4;
#pragma unroll 1
    for (int k0 = 0; k0 < K; k0 += 32) {
        const bf16x8 a = ld8(A + fr * lda + k0 + 8 * fq);
#pragma unroll
        for (int t = 0; t < NT; ++t) { const bf16x8 b = ld8(B + (16 * t + fr) * ldb + k0 + 8 * fq); acc[t] = __builtin_amdgcn_mfma_f32_16x16x32_bf16(b, a, acc[t], 0, 0, 0); }
    }
}
template <int NT> DI void zero_acc(f32x4 (&acc)[NT]) {
#pragma unroll
    for (int t = 0; t < NT; ++t) acc[t] = (f32x4){0.f, 0.f, 0.f, 0.f};
}

DI void p0_gemv(Frame& F, int cb) {
    LAS float* sv = (LAS float*)F.lds;
    LAS float* red = sv + 4096;
    for (int i = F.tid; i < 2048; i += 512) { const float a = F.c()[i], b = F.c_ctx()[i]; sv[i] = a / (1.f + expf(-a)); sv[2048 + i] = b / (1.f + expf(-b)); }
    __syncthreads();
    const int l16 = F.tid & 15, rl = F.tid >> 4;
    f32x4 a1 = (f32x4){0.f, 0.f, 0.f, 0.f}, a2 = a1;
    const float* wp = F.w_ada() + (size_t)rl * 12288 + 64 * cb + 4 * l16;
#pragma unroll 8
    for (int it = 0; it < 64; ++it) { const f32x4 w = *(const GAS f32x4*)(wp + (size_t)it * 32 * 12288); const float s1 = sv[rl + 32 * it], s2 = sv[2048 + rl + 32 * it]; a1 += w * s1; a2 += w * s2; }
    *(LAS f32x4*)(red + (rl * 16 + l16) * 8) = a1; *(LAS f32x4*)(red + (rl * 16 + l16) * 8 + 4) = a2;
    __syncthreads();
    if (F.tid < 128) { const int v = F.tid >> 6, col = F.tid & 63, q16 = col >> 2, j = col & 3; float s = 0.f;
        for (int r = 0; r < 32; ++r) s += red[(r * 16 + q16) * 8 + v * 4 + j];
        F.MOD()[v * 12288 + 64 * cb + col] = s + F.b_ada()[64 * cb + col]; }
    __syncthreads();
}
struct TrItem { const float* src; u16* dst; int ldn, ldk; bool ok; };
DI void tr_load(const TrItem& t, f32x4 (&v)[8], int lane) {
#pragma unroll
    for (int i = 0; i < 8; ++i) { const int kk = 8 * i + (lane >> 3); v[i] = t.ok ? *(const GAS f32x4*)(t.src + (size_t)kk * t.ldn + 4 * (lane & 7)) : (f32x4){0.f, 0.f, 0.f, 0.f}; }
}
DI void tr_store(const TrItem& t, const f32x4 (&v)[8], LAS float* scr, int lane) {
#pragma unroll
    for (int i = 0; i < 8; ++i) { const int kk = 8 * i + (lane >> 3); LAS float* d = scr + kk * 33 + 4 * (lane & 7); d[0] = v[i][0]; d[1] = v[i][1]; d[2] = v[i][2]; d[3] = v[i][3]; }
    LDS_WAIT(); asm volatile("" ::: "memory");
    const int c = lane & 7;
#pragma unroll
    for (int j = 0; j < 4; ++j) { const int nn = (lane >> 3) + 8 * j; const LAS float* s = scr + (8 * c) * 33 + nn;
        u32x4 o; o.x = cvt_pk_bf16(s[0 * 33], s[1 * 33]); o.y = cvt_pk_bf16(s[2 * 33], s[3 * 33]); o.z = cvt_pk_bf16(s[4 * 33], s[5 * 33]); o.w = cvt_pk_bf16(s[6 * 33], s[7 * 33]);
        *(GAS u32x4*)(t.dst + (size_t)nn * t.ldk + 8 * c) = o; }
    LDS_WAIT(); asm volatile("" ::: "memory");
}
constexpr int I_IN = 32 * (NPAD / 32), I_PA = 16 * 64, I_WO = 32 * 64, I_W1 = 32 * 1024, I_W2 = 32 * 1024, I_QK = 8 * 8;
constexpr int NITEMS = I_IN + 2 * I_PA + I_WO + 2 * I_W1 + I_W2 + 2 * I_QK;
DI TrItem tr_decode(Frame& F, int it) {
    TrItem t; t.ok = true; int r = it;
    if (r < I_IN) { const int nb = r % (NPAD / 32), kb = r / (NPAD / 32); t.ok = 32 * nb < DIN; t.src = F.w_in() + (size_t)(64 * kb) * DIN + 32 * nb; t.ldn = DIN; t.dst = F.WIN() + (size_t)(32 * nb) * 2048 + 64 * kb; t.ldk = 2048; return t; } r -= I_IN;
    if (r < I_PA) { const int nb = r % 64, kb = r / 64; t.src = F.p_a() + (size_t)(64 * kb) * 2048 + 32 * nb; t.ldn = 2048; t.dst = F.PAB() + (size_t)(32 * nb) * 2048 + 64 * kb; t.ldk = 2048; return t; } r -= I_PA;
    if (r < I_PA) { const int nb = r % 64, kb = r / 64; t.src = F.p_b() + (size_t)(64 * kb) * 2048 + 32 * nb; t.ldn = 2048; t.dst = F.PAB() + (size_t)(32 * nb) * 2048 + 1024 + 64 * kb; t.ldk = 2048; return t; } r -= I_PA;
    if (r < I_WO) { const int nb = r % 64, kb = r / 64; t.src = F.w_o() + (size_t)(64 * kb) * 2048 + 32 * nb; t.ldn = 2048; t.dst = F.WO() + (size_t)(32 * nb) * 2048 + 64 * kb; t.ldk = 2048; return t; } r -= I_WO;
    if (r < I_W1) { const int e = r >> 10, rr = r & 1023, nb = rr & 31, kb = rr >> 5, n0 = 32 * nb;
        t.src = F.w1() + (size_t)e * 2048 * 1024 + (size_t)(64 * kb) * 1024 + n0; t.ldn = 1024; t.dst = F.W13() + (size_t)e * 2048 * 2048 + (size_t)(256 * (n0 >> 7) + (n0 & 127)) * 2048 + 64 * kb; t.ldk = 2048; return t; } r -= I_W1;
    if (r < I_W1) { const int e = r >> 10, rr = r & 1023, nb = rr & 31, kb = rr >> 5, n0 = 32 * nb;
        t.src = F.w3() + (size_t)e * 2048 * 1024 + (size_t)(64 * kb) * 1024 + n0; t.ldn = 1024; t.dst = F.W13() + (size_t)e * 2048 * 2048 + (size_t)(256 * (n0 >> 7) + 128 + (n0 & 127)) * 2048 + 64 * kb; t.ldk = 2048; return t; } r -= I_W1;
    if (r < I_W2) { const int e = r >> 10, rr = r & 1023, nb = rr & 63, kb = rr >> 6;
        t.src = F.w2() + (size_t)e * 1024 * 2048 + (size_t)(64 * kb) * 2048 + 32 * nb; t.ldn = 2048; t.dst = F.W2() + (size_t)e * 2048 * 1024 + (size_t)(32 * nb) * 1024 + 64 * kb; t.ldk = 1024; return t; } r -= I_W2;
    if (r < I_QK) { const int h = r >> 3, rr = r & 7, nb = rr & 3, kb = rr >> 2;
        t.src = F.w_q() + (size_t)h * 16384 + (size_t)(64 * kb) * 128 + 32 * nb; t.ldn = 128; t.dst = F.WQK() + (size_t)h * 32768 + (size_t)(32 * nb) * 128 + 64 * kb; t.ldk = 128; return t; } r -= I_QK;
    { const int h = r >> 3, rr = r & 7, nb = rr & 3, kb = rr >> 2;
        t.src = F.w_k() + (size_t)h * 16384 + (size_t)(64 * kb) * 128 + 32 * nb; t.ldn = 128; t.dst = F.WQK() + (size_t)h * 32768 + (size_t)(128 + 32 * nb) * 128 + 64 * kb; t.ldk = 128; return t; }
}
DI void p0_prologue(Frame& F) {
    for (int cb = F.bid; cb < 192; cb += F.G) p0_gemv(F, cb);
    LAS float* scr = (LAS float*)(F.lds + F.wave * 16384);
    const int gw = F.bid * 8 + F.wave, NGW = F.G * 8;
    if (gw < NITEMS) {
        TrItem cur = tr_decode(F, gw); f32x4 v[8]; tr_load(cur, v, F.lane);
#pragma unroll 1
        for (int it = gw; it < NITEMS; it += NGW) {
            const bool hn = it + NGW < NITEMS; TrItem nxt = cur; f32x4 vn[8];
            if (hn) { nxt = tr_decode(F, it + NGW); tr_load(nxt, vn, F.lane); }
            tr_store(cur, v, scr, F.lane);
            if (hn) {
#pragma unroll
                for (int i = 0; i < 8; ++i) v[i] = vn[i];
                cur = nxt; }
        }
    }
    const int gt = F.bid * 512 + F.tid, NGT = F.G * 512;
    for (int i = gt; i < 48 * 2048; i += NGT) { const int j = i >> 11, k = i & 2047; const float w = (j < 4) ? F.w_rg()[k * 4 + j] : (j < 36 ? F.w_re()[k * 32 + (j - 4)] : 0.f);
        const unsigned hi = f2bf(w); const unsigned lo = f2bf(w - __uint_as_float(hi << 16)); u16* wr = (u16*)F.WRT(); wr[i] = (u16)hi; wr[48 * 2048 + i] = (u16)lo; }
    for (int i = gt; i < 8 * 16384; i += NGT) F.WSB()[i] = (u16)f2bf(F.w_s()[i]);
}

DI void p1_rows(Frame& F) {
    const int gw = F.bid * 8 + F.wave, NGW = F.G * 8;
    for (int rr = gw; rr < TR; rr += 2 * NGW) {
        f32x4 v[2][8]; bool ok[2]; int rw[2];
#pragma unroll
        for (int q = 0; q < 2; ++q) { const int r = rr + q * NGW; ok[q] = r < TR; rw[q] = ok[q] ? r : rr;
            const float* src = rw[q] < T ? F.x() + (size_t)rw[q] * D : F.ctx() + (size_t)(rw[q] - T) * D; const GAS f32x4* xr = (const GAS f32x4*)src + F.lane;
#pragma unroll
            for (int j = 0; j < 8; ++j) v[q][j] = xr[64 * j]; }
#pragma unroll
        for (int q = 0; q < 2; ++q) { if (!ok[q]) continue;
            const float* mod = F.MOD() + (rw[q] < T ? 0 : 12288);
            float s = 0.f;
#pragma unroll
            for (int j = 0; j < 8; ++j) s += (v[q][j][0] + v[q][j][1]) + (v[q][j][2] + v[q][j][3]);
            const float mean = wave_sum(s) * (1.f / D); float s2 = 0.f;
#pragma unroll
            for (int j = 0; j < 8; ++j) { v[q][j] = v[q][j] - mean; s2 += (v[q][j][0] * v[q][j][0] + v[q][j][1] * v[q][j][1]) + (v[q][j][2] * v[q][j][2] + v[q][j][3] * v[q][j][3]); }
            const float rstd = 1.f / sqrtf(wave_sum(s2) * (1.f / D) + LN_EPS);
            GAS u32x2* o = (GAS u32x2*)(F.U() + (size_t)rw[q] * D) + F.lane;
#pragma unroll
            for (int j = 0; j < 8; ++j) { const f32x4 sh = *(const f32x4*)(mod + 4 * F.lane + 256 * j), sc = *(const f32x4*)(mod + 2048 + 4 * F.lane + 256 * j);
                o[64 * j] = pack4(v[q][j] * rstd * (sc + 1.f) + sh); } }
    }
}

template <int NT, class PA, class PB>
DI void wave_mm128(f32x4 (&acc)[NT], PA A, int lda, PB B, int ldb, int lane) {
    const int fr = lane & 15, fq = lane >> 4;
    bf16x8 a[4];
#pragma unroll
    for (int ks = 0; ks < 4; ++ks) a[ks] = ld8(A + fr * lda + 32 * ks + 8 * fq);
#pragma unroll
    for (int kp = 0; kp < 2; ++kp) {
        bf16x8 b[2][NT];
#pragma unroll
        for (int kk = 0; kk < 2; ++kk)
#pragma unroll
            for (int t = 0; t < NT; ++t) b[kk][t] = ld8(B + (16 * t + fr) * ldb + 32 * (2 * kp + kk) + 8 * fq);
#pragma unroll
        for (int kk = 0; kk < 2; ++kk)
#pragma unroll
            for (int t = 0; t < NT; ++t) acc[t] = __builtin_amdgcn_mfma_f32_16x16x32_bf16(b[kk][t], a[2 * kp + kk], acc[t], 0, 0, 0);
        __builtin_amdgcn_sched_barrier(0);
    }
}
template <int NT, class PB>
DI void wave_mm128_areg(f32x4 (&acc)[NT], const bf16x8 (&a)[4], PB B, int ldb, int lane) {
    const int fr = lane & 15, fq = lane >> 4;
#pragma unroll
    for (int kp = 0; kp < 2; ++kp) {
        bf16x8 b[2][NT];
#pragma unroll
        for (int kk = 0; kk < 2; ++kk)
#pragma unroll
            for (int t = 0; t < NT; ++t) b[kk][t] = ld8(B + (16 * t + fr) * ldb + 32 * (2 * kp + kk) + 8 * fq);
#pragma unroll
        for (int kk = 0; kk < 2; ++kk)
#pragma unroll
            for (int t = 0; t < NT; ++t) acc[t] = __builtin_amdgcn_mfma_f32_16x16x32_bf16(b[kk][t], a[2 * kp + kk], acc[t], 0, 0, 0);
        __builtin_amdgcn_sched_barrier(0);
    }
}
DI float wave_incl_scan(float v, int lane) {
#pragma unroll
    for (int o = 1; o < 64; o <<= 1) { const float t = __shfl_up(v, o); v = (lane >= o) ? v + t : v; }
    return v;
}
DI float fexp(float x) { return __builtin_amdgcn_exp2f(x * 1.4426950408889634f); }

DI void gmlp_unit(Frame& F, int c, int g, int& cur_g) {
    LAS float* MU = (LAS float*)(F.lds + 140288); LAS float* RS = MU + 128;
    LAS u16* VNT = (LAS u16*)F.lds;
    LAS u16* WSs = (LAS u16*)(F.lds + 34816);
    if (g != cur_g) { cur_g = g;
#pragma unroll
        for (int i = 0; i < 4; ++i) { const int idx = F.tid + 512 * i; *(LAS u32x4*)(WSs + (idx >> 4) * 136 + 8 * (idx & 15)) = *(const GAS u32x4*)(F.WSB() + g * 16384 + (idx >> 4) * 128 + 8 * (idx & 15)); } }
    const int r0 = 128 * c, fr = F.lane & 15, fq = F.lane >> 4;
    if (F.tid < 128) {
        const GAS f32x4* sp = (const GAS f32x4*)((const float*)(F.ws + WS_STATP) + (size_t)(r0 + F.tid) * 32); float sa = 0.f, qa = 0.f;
#pragma unroll
        for (int i = 0; i < 8; ++i) { const f32x4 v = sp[i]; sa += v[0] + v[2]; qa += v[1] + v[3]; }
        const float mean = sa * (1.f / 1024.f), var = fmaxf(qa * (1.f / 1024.f) - mean * mean, 0.f);
        MU[F.tid] = mean; RS[F.tid] = 1.f / sqrtf(var + LN_EPS); }
    __syncthreads();
    {
        const int c8 = F.tid & 15;
        u32x4 vq[4];
#pragma unroll
        for (int i = 0; i < 4; ++i) vq[i] = *(const GAS u32x4*)(F.PROJ() + (size_t)(r0 + ((F.tid + 512 * i) >> 4)) * NPJ + OFF_VA + 128 * g + 8 * c8);
        const f32x4 g0 = *(const f32x4*)(F.sgu_g() + 128 * g + 8 * c8), g1 = *(const f32x4*)(F.sgu_g() + 128 * g + 8 * c8 + 4), b0 = *(const f32x4*)(F.sgu_b() + 128 * g + 8 * c8), b1 = *(const f32x4*)(F.sgu_b() + 128 * g + 8 * c8 + 4);
        const float gg[8] = {g0[0], g0[1], g0[2], g0[3], g1[0], g1[1], g1[2], g1[3]}, bb[8] = {b0[0], b0[1], b0[2], b0[3], b1[0], b1[1], b1[2], b1[3]};
#pragma unroll
        for (int i = 0; i < 4; ++i) { const int p = (F.tid + 512 * i) >> 4; const u32x4 v = vq[i]; const float mu = MU[p], rs = RS[p];
            const float x[8] = {bflo(v.x), bfhi(v.x), bflo(v.y), bfhi(v.y), bflo(v.z), bfhi(v.z), bflo(v.w), bfhi(v.w)};
#pragma unroll
            for (int j = 0; j < 8; ++j) VNT[(8 * c8 + j) * 136 + p] = (u16)f2bf((x[j] - mu) * rs * gg[j] + bb[j]); }
    }
    __syncthreads();
    const int q = 16 * F.wave + fr; const float bsq = F.b_s()[g * 128 + q];
    u32x2 uaq[8];
#pragma unroll
    for (int t = 0; t < 8; ++t) uaq[t] = *(const GAS u32x2*)(F.PROJ() + (size_t)(r0 + q) * NPJ + OFF_UA + 128 * g + 16 * t + 4 * fq);
    f32x4 acc[8]; zero_acc<8>(acc);
    wave_mm128<8>(acc, (const LAS u16*)(WSs + 16 * F.wave * 136), 136, (const LAS u16*)VNT, 136, F.lane);
#pragma unroll
    for (int t = 0; t < 8; ++t) *(GAS u32x2*)(F.AB() + (size_t)(r0 + q) * 2048 + 128 * g + 16 * t + 4 * fq) = pack4(unpack4(uaq[t]) * (acc[t] + bsq));
    __syncthreads();
}

DI void mprep_unit(Frame& F, int c, int h, int& cur_h) {
    const int r0 = (c < 2) ? T + 128 * c : 128 * (c - 2);
    const int seq_lo = (c < 2) ? T : 0, seq_hi = (c < 2) ? TR - 1 : T - 1;
    LAS u16* XCs = (LAS u16*)F.lds;
    LAS u16* KT = (LAS u16*)(F.lds + 34816);
    LAS u16* WQs = (LAS u16*)(F.lds + 2 * 34816);
    LAS float* GS = (LAS float*)(F.lds + 4 * 34816);
    const int fr = F.lane & 15, fq = F.lane >> 4;
    if (h != cur_h) { cur_h = h;
#pragma unroll
        for (int i = 0; i < 8; ++i) { const int idx = F.tid + 512 * i; *(LAS u32x4*)(WQs + (idx >> 4) * 136 + 8 * (idx & 15)) = *(const GAS u32x4*)(F.WQK() + (size_t)h * 32768 + (idx >> 4) * 128 + 8 * (idx & 15)); } }
    u32x4 vtq[4];
#pragma unroll
    for (int i = 0; i < 4; ++i) { const int idx = F.tid + 512 * i; vtq[i] = *(const GAS u32x4*)(F.PROJ() + (size_t)(r0 + (idx >> 4)) * NPJ + OFF_VB + 128 * h + 8 * (idx & 15)); }
    if (F.wave < 2) {
        const int dir = F.wave; const int s0 = dir ? 127 - 2 * F.lane : 2 * F.lane, s1 = dir ? 126 - 2 * F.lane : 2 * F.lane + 1;
        const float* g0 = F.GATES() + (size_t)(r0 + s0) * 32 + 16 * dir + h; const float* g1 = F.GATES() + (size_t)(r0 + s1) * 32 + 16 * dir + h;
        const float li0 = g0[0], lf0 = logsig(g0[8]), li1 = g1[0], lf1 = logsig(g1[8]);
        const float incl = wave_incl_scan(lf0 + lf1, F.lane);
        const float b1 = incl, b0 = incl - lf1;
        const float bs = __shfl(incl, 63);
        const float l0 = bs - b0 + li0, l1 = bs - b1 + li1;
        const float ml = wave_max(fmaxf(l0, l1));
        GS[128 * dir + s0] = expf(l0 - ml); GS[128 * dir + s1] = expf(l1 - ml);
        if (F.lane == 0) { float* sc = F.SC() + (size_t)((dir * 8 + h) * NCH + c) * 4; sc[0] = ml; sc[1] = bs; }
        float* gb0 = F.GB() + ((size_t)h * TR + r0 + s0) * 4 + 2 * dir; float* gb1 = F.GB() + ((size_t)h * TR + r0 + s1) * 4 + 2 * dir;
        *(f32x2*)gb0 = (f32x2){li0, b0}; *(f32x2*)gb1 = (f32x2){li1, b1};
    }
    const int cch = 128 * h + 8 * (F.tid & 15);
    f32x4 cw0[2], cw1[2], cw2[2], cbb[2];
#pragma unroll
    for (int hh = 0; hh < 2; ++hh) { cw0[hh] = *(const f32x4*)(F.conv_w() + cch + 4 * hh); cw1[hh] = *(const f32x4*)(F.conv_w() + 1024 + cch + 4 * hh); cw2[hh] = *(const f32x4*)(F.conv_w() + 2048 + cch + 4 * hh); cbb[hh] = *(const f32x4*)(F.conv_b() + cch + 4 * hh); }
    u32x4 xmq[4], xpq[4], xnq[4];
#pragma unroll
    for (int i = 0; i < 4; ++i) { const int row = r0 + ((F.tid + 512 * i) >> 4); const GAS u16* p = (const GAS u16*)(F.PROJ() + (size_t)row * NPJ + OFF_XM + cch); const u32x4 z4 = (u32x4){0u, 0u, 0u, 0u};
        xmq[i] = *(const GAS u32x4*)p; xpq[i] = (row > seq_lo) ? *(const GAS u32x4*)(p - NPJ) : z4; xnq[i] = (row < seq_hi) ? *(const GAS u32x4*)(p + NPJ) : z4; }
#pragma unroll
    for (int i = 0; i < 4; ++i) { const int idx = F.tid + 512 * i, s = idx >> 4, c8 = idx & 15, row = r0 + s, ch = 128 * h + 8 * c8;
        const u32x4 xm = xmq[i], xp = xpq[i], xn = xnq[i];
        float y[8];
#pragma unroll
        for (int hh = 0; hh < 2; ++hh) { const f32x4 w0 = cw0[hh], w1 = cw1[hh], w2 = cw2[hh], cb = cbb[hh];
            const unsigned a0 = hh ? xp.z : xp.x, a1 = hh ? xp.w : xp.y, m0 = hh ? xm.z : xm.x, m1 = hh ? xm.w : xm.y, n0 = hh ? xn.z : xn.x, n1 = hh ? xn.w : xn.y;
            y[4 * hh + 0] = w0[0] * bflo(a0) + w1[0] * bflo(m0) + w2[0] * bflo(n0) + cb[0];
            y[4 * hh + 1] = w0[1] * bfhi(a0) + w1[1] * bfhi(m0) + w2[1] * bfhi(n0) + cb[1];
            y[4 * hh + 2] = w0[2] * bflo(a1) + w1[2] * bflo(m1) + w2[2] * bflo(n1) + cb[2];
            y[4 * hh + 3] = w0[3] * bfhi(a1) + w1[3] * bfhi(m1) + w2[3] * bfhi(n1) + cb[3]; }
#pragma unroll
        for (int j = 0; j < 8; ++j) y[j] = y[j] * sigmoid_fast(y[j]);
        u32x4 o; o.x = cvt_pk_bf16(y[0], y[1]); o.y = cvt_pk_bf16(y[2], y[3]); o.z = cvt_pk_bf16(y[4], y[5]); o.w = cvt_pk_bf16(y[6], y[7]);
        *(LAS u32x4*)(XCs + s * 136 + 8 * c8) = o; *(GAS u32x4*)(F.XC() + (size_t)row * 1024 + ch) = o; }
    __syncthreads();
    {
        f32x4 aq[8]; zero_acc<8>(aq);
        wave_mm128<8>(aq, (const LAS u16*)(XCs + 16 * F.wave * 136), 136, (const LAS u16*)WQs, 136, F.lane);
        const int s = 16 * F.wave + fr;
#pragma unroll
        for (int t = 0; t < 8; ++t) *(GAS u32x2*)(F.Q() + (size_t)(r0 + s) * 1024 + 128 * h + 16 * t + 4 * fq) = pack4(aq[t]);
        zero_acc<8>(aq);
        wave_mm128<8>(aq, (const LAS u16*)(XCs + 16 * F.wave * 136), 136, (const LAS u16*)(WQs + 128 * 136), 136, F.lane);
#pragma unroll
        for (int t = 0; t < 8; ++t) *(GAS u32x2*)(F.K() + (size_t)(r0 + s) * 1024 + 128 * h + 16 * t + 4 * fq) = pack4(aq[t] * 0.08838834764831845f);
        zero_acc<8>(aq);
        wave_mm128<8>(aq, (const LAS u16*)(WQs + (128 + 16 * F.wave) * 136), 136, (const LAS u16*)XCs, 136, F.lane);
        const int d = 16 * F.wave + fr;
#pragma unroll
        for (int t = 0; t < 8; ++t) *(LAS u32x2*)(KT + d * 136 + 16 * t + 4 * fq) = pack4(aq[t] * 0.08838834764831845f);
    }
    __syncthreads();
#pragma unroll
    for (int i = 0; i < 4; ++i) { const int idx = F.tid + 512 * i, s = idx >> 4, c8 = idx & 15;
        const unsigned w[4] = {vtq[i].x, vtq[i].y, vtq[i].z, vtq[i].w};
#pragma unroll
        for (int j = 0; j < 4; ++j) { XCs[(8 * c8 + 2 * j) * 136 + s] = (u16)(w[j] & 0xffffu); XCs[(8 * c8 + 2 * j + 1) * 136 + s] = (u16)(w[j] >> 16); } }
    __syncthreads();
#pragma unroll
    for (int dir = 0; dir < 2; ++dir) {
        f32x4 cf[8]; zero_acc<8>(cf);
#pragma unroll
        for (int ks = 0; ks < 4; ++ks) {
            const u32x4 av = *(const LAS u32x4*)(XCs + (16 * F.wave + fr) * 136 + 32 * ks + 8 * fq);
            const f32x4 w0 = *(const LAS f32x4*)(GS + 128 * dir + 32 * ks + 8 * fq), w1 = *(const LAS f32x4*)(GS + 128 * dir + 32 * ks + 8 * fq + 4);
            u32x4 sv; sv.x = cvt_pk_bf16(bflo(av.x) * w0[0], bfhi(av.x) * w0[1]); sv.y = cvt_pk_bf16(bflo(av.y) * w0[2], bfhi(av.y) * w0[3]);
            sv.z = cvt_pk_bf16(bflo(av.z) * w1[0], bfhi(av.z) * w1[1]); sv.w = cvt_pk_bf16(bflo(av.w) * w1[2], bfhi(av.w) * w1[3]);
            const bf16x8 a = __builtin_bit_cast(bf16x8, sv);
#pragma unroll
            for (int t = 0; t < 8; ++t) { const bf16x8 b = ld8((const LAS u16*)(KT + (16 * t + fr) * 136 + 32 * ks + 8 * fq)); cf[t] = __builtin_amdgcn_mfma_f32_16x16x32_bf16(b, a, cf[t], 0, 0, 0); }
        }
        u16* st = F.ST() + ((size_t)((dir * 8 + h) * NCH + c) * 16384) + (16 * F.wave + fr) * 128;
#pragma unroll
        for (int t = 0; t < 8; ++t) *(GAS u32x2*)(st + 16 * t + 4 * fq) = pack4(cf[t]);
    }
    if (F.tid < 256) { const int dir = F.tid >> 7, d = F.tid & 127; const LAS u16* kt = KT + d * 136; const LAS float* w = GS + 128 * dir; float s = 0.f;
#pragma unroll
        for (int i = 0; i < 16; ++i) { const u32x4 v = *(const LAS u32x4*)(kt + 8 * i); const f32x4 w0 = *(const LAS f32x4*)(w + 8 * i), w1 = *(const LAS f32x4*)(w + 8 * i + 4);
            s += ((bflo(v.x) * w0[0] + bfhi(v.x) * w0[1]) + (bflo(v.y) * w0[2] + bfhi(v.y) * w0[3])) + ((bflo(v.z) * w1[0] + bfhi(v.z) * w1[1]) + (bflo(v.w) * w1[2] + bfhi(v.w) * w1[3])); }
        F.NL()[(size_t)((dir * 8 + h) * NCH + c) * 128 + d] = s; }
    __syncthreads();
}

DI int scan_order(int dir, int j) { return dir == 0 ? j : (j == 0 ? 1 : (j == 1 ? 0 : 131 - j)); }
DI void scan_item(Frame& F, int dh, int blk) {
    const int dir = dh >> 3;
    LAS float* ML = (LAS float*)F.lds; LAS float* BS = ML + 136; LAS float* DEC = ML + 272; LAS float* SCL = ML + 408; LAS float* MB = ML + 544;
    if (F.tid < NCH) { const int cj = scan_order(dir, F.tid); const float* sc = F.SC() + (size_t)(dh * NCH + cj) * 4; ML[F.tid] = sc[0]; BS[F.tid] = sc[1]; }
    __syncthreads();
    if (F.tid == 0) { float m = NEGF; for (int j = 0; j < NCH; ++j) { MB[j] = m; const float mn = fmaxf(BS[j] + m, ML[j]); DEC[j] = fexp(BS[j] + m - mn); SCL[j] = fexp(ML[j] - mn); m = mn; } }
    __syncthreads();
    GAS unsigned* base = (GAS unsigned*)(F.ST() + (size_t)dh * NCH * 16384) + blk * 512 + F.tid;
    float c0 = 0.f, c1 = 0.f;
#pragma unroll 1
    for (int j0 = 0; j0 < NCH; j0 += 26) {
        unsigned kv[26];
#pragma unroll
        for (int jj = 0; jj < 26; ++jj) kv[jj] = base[(size_t)scan_order(dir, j0 + jj) * 8192];
#pragma unroll
        for (int jj = 0; jj < 26; ++jj) { base[(size_t)scan_order(dir, j0 + jj) * 8192] = cvt_pk_bf16(c0, c1);
            const float de = DEC[j0 + jj], sc = SCL[j0 + jj]; c0 = de * c0 + sc * bflo(kv[jj]); c1 = de * c1 + sc * bfhi(kv[jj]); }
    }
    if (blk == 0) {
        if (F.tid < 128) { float n = 0.f; GAS float* nl = (GAS float*)(F.NL() + (size_t)dh * NCH * 128 + F.tid);
#pragma unroll 1
            for (int j0 = 0; j0 < NCH; j0 += 26) { float nv[26];
#pragma unroll
                for (int jj = 0; jj < 26; ++jj) nv[jj] = nl[scan_order(dir, j0 + jj) * 128];
#pragma unroll
                for (int jj = 0; jj < 26; ++jj) { nl[scan_order(dir, j0 + jj) * 128] = n; n = DEC[j0 + jj] * n + SCL[j0 + jj] * nv[jj]; } } }
        if (F.tid >= 256 && F.tid < 256 + NCH) { const int j = F.tid - 256; F.SC()[(size_t)(dh * NCH + scan_order(dir, j)) * 4 + 2] = MB[j]; }
    }
    __syncthreads();
}

DI void x3_unit(Frame& F, int lc, int h) {
    const int c = lc + 2, r0 = 128 * lc, fr = F.lane & 15, fq = F.lane >> 4;
    LAS u16* VT = (LAS u16*)F.lds;
    LAS u16* KS = (LAS u16*)(F.lds + 34816);
    LAS u16* PW = KS + F.wave * 16 * 136;
    LAS u16* SF = (LAS u16*)(F.lds + 2 * 34816);
    LAS u16* SB = (LAS u16*)(F.lds + 3 * 34816);
    LAS float* GS = (LAS float*)(F.lds + 4 * 34816);
    const int ql = 16 * F.wave + fr;
    bf16x8 qa[4];
#pragma unroll
    for (int ks = 0; ks < 4; ++ks) qa[ks] = ld8((const GAS u16*)(F.Q() + (size_t)(r0 + ql) * 1024 + 128 * h + 32 * ks + 8 * fq));
    if (F.tid < 128) { const f32x4 g = *(const GAS f32x4*)(F.GB() + ((size_t)h * TR + r0 + F.tid) * 4); GS[F.tid] = g[0]; GS[128 + F.tid] = g[1]; GS[256 + F.tid] = g[2]; GS[384 + F.tid] = g[3]; }
    else if (F.tid < 384) { const int i = F.tid - 128, dir = i >> 7, d = i & 127; GS[512 + i] = F.NL()[(size_t)((dir * 8 + h) * NCH + c) * 128 + d]; }
    const float mf = F.SC()[(size_t)(h * NCH + c) * 4 + 2], mb = F.SC()[(size_t)((8 + h) * NCH + c) * 4 + 2];
    {
        u32x4 vv[4], s0[4], s1[4], kq[4];
        const GAS u16* stf = (const GAS u16*)(F.ST() + (size_t)(h * NCH + c) * 16384); const GAS u16* stb = (const GAS u16*)(F.ST() + (size_t)((8 + h) * NCH + c) * 16384);
#pragma unroll
        for (int i = 0; i < 4; ++i) { const int idx = F.tid + 512 * i, s = idx >> 4, c8 = idx & 15;
            vv[i] = *(const GAS u32x4*)(F.PROJ() + (size_t)(r0 + s) * NPJ + OFF_VB + 128 * h + 8 * c8); s0[i] = *(const GAS u32x4*)(stf + s * 128 + 8 * c8); s1[i] = *(const GAS u32x4*)(stb + s * 128 + 8 * c8);
            kq[i] = *(const GAS u32x4*)(F.K() + (size_t)(r0 + s) * 1024 + 128 * h + 8 * c8); }
#pragma unroll
        for (int i = 0; i < 4; ++i) { const int idx = F.tid + 512 * i, s = idx >> 4, c8 = idx & 15;
            *(LAS u32x4*)(SF + s * 136 + 8 * c8) = s0[i]; *(LAS u32x4*)(SB + s * 136 + 8 * c8) = s1[i]; *(LAS u32x4*)(KS + s * 136 + 8 * c8) = kq[i];
            const unsigned w[4] = {vv[i].x, vv[i].y, vv[i].z, vv[i].w};
#pragma unroll
            for (int j = 0; j < 4; ++j) { VT[(8 * c8 + 2 * j) * 136 + s] = (u16)(w[j] & 0xffffu); VT[(8 * c8 + 2 * j + 1) * 136 + s] = (u16)(w[j] >> 16); } }
    }
    __syncthreads();
    f32x4 sf[8], sb[8]; zero_acc<8>(sf);
    wave_mm128_areg<8>(sf, qa, (const LAS u16*)KS, 136, F.lane);
    __syncthreads();
    const float bqf = GS[128 + ql], bqb = GS[384 + ql];
    float mxf = -3.0e38f, mxb = -3.0e38f;
#pragma unroll
    for (int t = 0; t < 8; ++t)
#pragma unroll
        for (int r = 0; r < 4; ++r) { const int s = 16 * t + 4 * fq + r; const float df = bqf - GS[128 + s] + GS[s], db = bqb - GS[384 + s] + GS[256 + s];
            mxf = (s <= ql) ? fmaxf(mxf, df) : mxf; mxb = (s >= ql) ? fmaxf(mxb, db) : mxb; }
    mxf = fmaxf(mxf, __shfl_xor(mxf, 16)); mxf = fmaxf(mxf, __shfl_xor(mxf, 32)); mxb = fmaxf(mxb, __shfl_xor(mxb, 16)); mxb = fmaxf(mxb, __shfl_xor(mxb, 32));
    const float mrf = fmaxf(bqf + mf, mxf), mrb = fmaxf(bqb + mb, mxb);
    float rsf = 0.f, rsb = 0.f;
#pragma unroll
    for (int t = 0; t < 8; ++t)
#pragma unroll
        for (int r = 0; r < 4; ++r) { const int s = 16 * t + 4 * fq + r; const float df = bqf - GS[128 + s] + GS[s], db = bqb - GS[384 + s] + GS[256 + s];
            const float ef = (s <= ql) ? fexp(df - mrf) : 0.f, eb = (s >= ql) ? fexp(db - mrb) : 0.f; const float s0 = sf[t][r];
            sf[t][r] = s0 * ef; sb[t][r] = s0 * eb; rsf += sf[t][r]; rsb += sb[t][r]; }
    rsf += __shfl_xor(rsf, 16); rsf += __shfl_xor(rsf, 32); rsb += __shfl_xor(rsb, 16); rsb += __shfl_xor(rsb, 32);
    float qnf = 0.f, qnb = 0.f;
#pragma unroll
    for (int i = 0; i < 4; ++i) { const u32x4 qv = __builtin_bit_cast(u32x4, qa[i]); const int d0 = 32 * i + 8 * fq;
        const float qq[8] = {bflo(qv.x), bfhi(qv.x), bflo(qv.y), bfhi(qv.y), bflo(qv.z), bfhi(qv.z), bflo(qv.w), bfhi(qv.w)};
#pragma unroll
        for (int j = 0; j < 8; ++j) { qnf += qq[j] * GS[512 + d0 + j]; qnb += qq[j] * GS[640 + d0 + j]; } }
    qnf += __shfl_xor(qnf, 16); qnf += __shfl_xor(qnf, 32); qnb += __shfl_xor(qnb, 16); qnb += __shfl_xor(qnb, 32);
    const float af = fexp(bqf + mf - mrf), ab = fexp(bqb + mb - mrb);
    const float dnf = fmaxf(fabsf(af * qnf + rsf), fexp(-mrf)), dnb = fmaxf(fabsf(ab * qnb + rsb), fexp(-mrb));
    const float ivf = 1.f / dnf, ivb = 1.f / dnb, rf = af * ivf, rb = ab * ivb;
#pragma unroll
    for (int t = 0; t < 8; ++t) *(LAS u32x2*)(PW + fr * 136 + 16 * t + 4 * fq) = pack4(sf[t] * ivf + sb[t] * ivb);
    LDS_WAIT(); asm volatile("" ::: "memory");
    f32x4 hv[8]; zero_acc<8>(hv);
    wave_mm<8>(hv, (const LAS u16*)PW, 136, (const LAS u16*)VT, 136, 128, F.lane);
    zero_acc<8>(sf);
    wave_mm128_areg<8>(sf, qa, (const LAS u16*)SF, 136, F.lane);
#pragma unroll
    for (int t = 0; t < 8; ++t) hv[t] += sf[t] * rf;
    zero_acc<8>(sb);
    wave_mm128_areg<8>(sb, qa, (const LAS u16*)SB, 136, F.lane);
    float s1 = 0.f;
#pragma unroll
    for (int t = 0; t < 8; ++t) { hv[t] += sb[t] * rb; s1 += (hv[t][0] + hv[t][1]) + (hv[t][2] + hv[t][3]); }
    s1 += __shfl_xor(s1, 16); s1 += __shfl_xor(s1, 32);
    const float mean = s1 * (1.f / 128.f); float s2 = 0.f;
#pragma unroll
    for (int t = 0; t < 8; ++t) { hv[t] = hv[t] - mean; s2 += (hv[t][0] * hv[t][0] + hv[t][1] * hv[t][1]) + (hv[t][2] * hv[t][2] + hv[t][3] * hv[t][3]); }
    s2 += __shfl_xor(s2, 16); s2 += __shfl_xor(s2, 32);
    const float rstd = 1.f / sqrtf(s2 * (1.f / 128.f) + LN_EPS);
    const size_t row = (size_t)(r0 + ql);
#pragma unroll
    for (int hb = 0; hb < 2; ++hb) {
        f32x4 mg[4], sk[4]; u32x2 xcq[4], soq[4];
#pragma unroll
        for (int tt = 0; tt < 4; ++tt) { const int e0 = 128 * h + 16 * (4 * hb + tt) + 4 * fq;
            mg[tt] = *(const f32x4*)(F.mh_g() + e0); sk[tt] = *(const f32x4*)(F.skip() + e0); xcq[tt] = *(const GAS u32x2*)(F.XC() + row * 1024 + e0); soq[tt] = *(const GAS u32x2*)(F.PROJ() + row * NPJ + OFF_OB + e0); }
#pragma unroll
        for (int tt = 0; tt < 4; ++tt) { const int e0 = 128 * h + 16 * (4 * hb + tt) + 4 * fq;
            *(GAS u32x2*)(F.AB() + row * 2048 + 1024 + e0) = pack4(unpack4(soq[tt]) * (hv[4 * hb + tt] * rstd * mg[tt] + sk[tt] * unpack4(xcq[tt]))); }
    }
    __syncthreads();
}

DI void p8_rows(Frame& F) {
    LAS int* HC = (LAS int*)F.lds; LAS int* HB = HC + 32;
    LAS float* ST2 = (LAS float*)(F.lds + 256);
    LAS float* SCP = (LAS float*)(F.lds + 1024);
    LAS float* SHP = SCP + 2048;
    LAS float* LGP = SHP + 2048;
    const float* mod = F.MOD();
    const int fr = F.lane & 15, fq = F.lane >> 4;
    for (int i = F.tid; i < 2048; i += 512) { SCP[i] = 1.f + mod[4 * 2048 + i]; SHP[i] = mod[3 * 2048 + i]; }
    const u16* WRH = (const u16*)F.WRT(); const u16* WRL = WRH + 48 * 2048;
    for (int rb = F.bid; rb < T / 64; rb += F.G) {
        if (F.tid < 32) HC[F.tid] = 0;
        for (int i = 0; i < 8; ++i) {
            const int rl = 8 * F.wave + i, r = 64 * rb + rl;
            GAS u32x2* xr = (GAS u32x2*)(F.X1() + (size_t)r * D) + F.lane;
            f32x4 v[8]; float s = 0.f;
#pragma unroll
            for (int j = 0; j < 8; ++j) { v[j] = unpack4(xr[64 * j]); s += (v[j][0] + v[j][1]) + (v[j][2] + v[j][3]); }
            float mean = wave_sum(s) * (1.f / D), s2 = 0.f;
#pragma unroll
            for (int j = 0; j < 8; ++j) { v[j] = v[j] - mean; s2 += (v[j][0] * v[j][0] + v[j][1] * v[j][1]) + (v[j][2] * v[j][2] + v[j][3] * v[j][3]); }
            float rstd = 1.f / sqrtf(wave_sum(s2) * (1.f / D) + LN_EPS);
            s = 0.f;
#pragma unroll
            for (int j = 0; j < 8; ++j) { const f32x4 g = *(const f32x4*)(F.ln1_g() + 4 * F.lane + 256 * j), b = *(const f32x4*)(F.ln1_b() + 4 * F.lane + 256 * j);
                const u32x2 pk = pack4(v[j] * rstd * g + b); xr[64 * j] = pk; v[j] = unpack4(pk); s += (v[j][0] + v[j][1]) + (v[j][2] + v[j][3]); }
            mean = wave_sum(s) * (1.f / D); s2 = 0.f;
#pragma unroll
            for (int j = 0; j < 8; ++j) { const f32x4 d = v[j] - mean; s2 += (d[0] * d[0] + d[1] * d[1]) + (d[2] * d[2] + d[3] * d[3]); }
            rstd = 1.f / sqrtf(wave_sum(s2) * (1.f / D) + LN_EPS);
            if (F.lane == 0) { ST2[2 * rl] = mean; ST2[2 * rl + 1] = rstd; }
        }
        asm volatile("s_waitcnt vmcnt(0)" ::: "memory");
        __syncthreads();
        {
            const int tile = F.wave & 3, kh = F.wave >> 2, rl = 16 * tile + fr; const size_t r = (size_t)(64 * rb + rl);
            const float mean2 = ST2[2 * rl], rstd2 = ST2[2 * rl + 1];
            f32x4 acc[3]; zero_acc<3>(acc);
#pragma unroll 2
            for (int ks = 0; ks < 32; ++ks) {
                const int k = 1024 * kh + 32 * ks + 8 * fq;
                const u32x4 ax = *(const GAS u32x4*)(F.X1() + r * D + k); const f32x4 a0 = (f32x4){bflo(ax.x), bfhi(ax.x), bflo(ax.y), bfhi(ax.y)}, a1 = (f32x4){bflo(ax.z), bfhi(ax.z), bflo(ax.w), bfhi(ax.w)};
                const f32x4 u0 = (a0 - mean2) * rstd2 * *(const LAS f32x4*)(SCP + k) + *(const LAS f32x4*)(SHP + k);
                const f32x4 u1 = (a1 - mean2) * rstd2 * *(const LAS f32x4*)(SCP + k + 4) + *(const LAS f32x4*)(SHP + k + 4);
                u32x4 hi; hi.x = cvt_pk_bf16(u0[0], u0[1]); hi.y = cvt_pk_bf16(u0[2], u0[3]); hi.z = cvt_pk_bf16(u1[0], u1[1]); hi.w = cvt_pk_bf16(u1[2], u1[3]);
                u32x4 lo; lo.x = cvt_pk_bf16(u0[0] - bflo(hi.x), u0[1] - bfhi(hi.x)); lo.y = cvt_pk_bf16(u0[2] - bflo(hi.y), u0[3] - bfhi(hi.y));
                lo.z = cvt_pk_bf16(u1[0] - bflo(hi.z), u1[1] - bfhi(hi.z)); lo.w = cvt_pk_bf16(u1[2] - bflo(hi.w), u1[3] - bfhi(hi.w));
                *(GAS u32x4*)(F.U2() + r * D + k) = hi;
                const bf16x8 ah = __builtin_bit_cast(bf16x8, hi), al = __builtin_bit_cast(bf16x8, lo);
#pragma unroll
                for (int t = 0; t < 3; ++t) { const bf16x8 bh = ld8((const GAS u16*)(WRH + (16 * t + fr) * 2048 + k)), bl = ld8((const GAS u16*)(WRL + (16 * t + fr) * 2048 + k));
                    acc[t] = __builtin_amdgcn_mfma_f32_16x16x32_bf16(bh, ah, acc[t], 0, 0, 0);
                    acc[t] = __builtin_amdgcn_mfma_f32_16x16x32_bf16(bh, al, acc[t], 0, 0, 0);
                    acc[t] = __builtin_amdgcn_mfma_f32_16x16x32_bf16(bl, ah, acc[t], 0, 0, 0); }
            }
#pragma unroll
            for (int t = 0; t < 3; ++t) *(LAS f32x4*)(LGP + (kh * 64 + rl) * 48 + 16 * t + 4 * fq) = acc[t];
        }
        __syncthreads();
        if (F.tid < 64) {
            const int rl = F.tid, r = 64 * rb + rl; const LAS float* l0 = LGP + rl * 48; const LAS float* l1 = LGP + (64 + rl) * 48;
            float gl[4];
#pragma unroll
            for (int g = 0; g < 4; ++g) gl[g] = l0[g] + l1[g] + F.b_rg()[g];
            int gs = 0; float gm = gl[0];
#pragma unroll
            for (int g = 1; g < 4; ++g) if (gl[g] > gm) { gm = gl[g]; gs = g; }
            float gsum = 0.f;
#pragma unroll
            for (int g = 0; g < 4; ++g) gsum += expf(gl[g] - gm);
            const float pg = 1.f / gsum;
            float el[8];
#pragma unroll
            for (int j = 0; j < 8; ++j) el[j] = l0[4 + 8 * gs + j] + l1[4 + 8 * gs + j] + F.b_re()[8 * gs + j];
            int i0 = 0; float m0 = el[0];
#pragma unroll
            for (int j = 1; j < 8; ++j) if (el[j] > m0) { m0 = el[j]; i0 = j; }
            int i1 = -1; float m1 = -3.0e38f;
#pragma unroll
            for (int j = 0; j < 8; ++j) if (j != i0 && el[j] > m1) { m1 = el[j]; i1 = j; }
            const float x1 = expf(m1 - m0), w0 = pg / (1.f + x1), w1 = pg * x1 / (1.f + x1);
            const int e0 = gs * 8 + i0, e1 = gs * 8 + i1;
            const int sl0 = __hip_atomic_fetch_add(&HC[e0], 1, __ATOMIC_RELAXED, __HIP_MEMORY_SCOPE_WORKGROUP), sl1 = __hip_atomic_fetch_add(&HC[e1], 1, __ATOMIC_RELAXED, __HIP_MEMORY_SCOPE_WORKGROUP);
            F.TOKE()[2 * r] = e0; F.TOKE()[2 * r + 1] = e1; F.TOKW()[2 * r] = w0; F.TOKW()[2 * r + 1] = w1; F.TOKS()[2 * r] = sl0; F.TOKS()[2 * r + 1] = sl1;
        }
        __syncthreads();
        if (F.tid < 32) HB[F.tid] = (int)__hip_atomic_fetch_add(F.ctl() + CW_CNT + F.tid, (unsigned)HC[F.tid], __ATOMIC_RELAXED, __HIP_MEMORY_SCOPE_AGENT);
        __syncthreads();
        if (F.tid < 64) { const int r = 64 * rb + F.tid; F.TOKS()[2 * r] += HB[F.TOKE()[2 * r]]; F.TOKS()[2 * r + 1] += HB[F.TOKE()[2 * r + 1]]; }
        __syncthreads();
    }
}

DI int moe_tables(Frame& F) {
    LAS int* TE = (LAS int*)(F.lds + TILEE_OFF); LAS int* RB = TE + XS_TILES; LAS int* NTp = RB + 32;
    __syncthreads();
    if (F.tid == 0) { int tb = 0; for (int e = 0; e < NE; ++e) { const int cnt = (int)__hip_atomic_load(F.ctl() + CW_CNT + e, __ATOMIC_RELAXED, __HIP_MEMORY_SCOPE_AGENT); int nt = (cnt + 255) >> 8; if (tb + nt > XS_TILES) nt = XS_TILES - tb;
            RB[e] = tb * 256; for (int i = 0; i < nt; ++i) TE[tb + i] = e; tb += nt; } NTp[0] = tb; }
    __syncthreads();
    return NTp[0];
}
DI void p9_gather(Frame& F) {
    (void)moe_tables(F);
    const LAS int* RB = (const LAS int*)(F.lds + TILEE_OFF) + XS_TILES;
    const int gw = F.bid * 8 + F.wave, NGW = F.G * 8;
    for (int a0 = gw; a0 < 2 * T; a0 += 4 * NGW) {
        int pos[4]; u32x4 d[4][4];
#pragma unroll
        for (int q = 0; q < 4; ++q) { const int a = a0 + q * NGW; const bool ok = a < 2 * T; const int aa = ok ? a : a0; pos[q] = ok ? RB[F.TOKE()[aa]] + F.TOKS()[aa] : -1; }
#pragma unroll
        for (int q = 0; q < 4; ++q) { const int a = (a0 + q * NGW) < 2 * T ? a0 + q * NGW : a0; const GAS u32x4* src = (const GAS u32x4*)(F.U2() + (size_t)(a >> 1) * D) + F.lane;
#pragma unroll
            for (int j = 0; j < 4; ++j) d[q][j] = src[64 * j]; }
#pragma unroll
        for (int q = 0; q < 4; ++q) { if (pos[q] < 0) continue; if (F.lane == 0) F.TOKP()[a0 + q * NGW] = pos[q];
            GAS u32x4* dst = (GAS u32x4*)(F.XS() + (size_t)pos[q] * D) + F.lane;
#pragma unroll
            for (int j = 0; j < 4; ++j) dst[64 * j] = d[q][j]; }
    }
}
DI void p12_rows(Frame& F) {
    const int gw = F.bid * 8 + F.wave, NGW = F.G * 8; const float* g2 = F.MOD() + 5 * 2048;
    for (int rr = gw; rr < T; rr += 2 * NGW) {
        u32x2 xq[2][8], ya[2][8], yb[2][8]; f32x4 v[2][8]; float w0[2], w1[2]; bool ok[2]; int rw[2];
#pragma unroll
        for (int q = 0; q < 2; ++q) { const int r = rr + q * NGW; ok[q] = r < T; rw[q] = ok[q] ? r : rr;
            const int p0 = F.TOKP()[2 * rw[q]], p1 = F.TOKP()[2 * rw[q] + 1]; w0[q] = F.TOKW()[2 * rw[q]]; w1[q] = F.TOKW()[2 * rw[q] + 1];
            const GAS u32x2* xr = (const GAS u32x2*)(F.X1() + (size_t)rw[q] * D) + F.lane;
            const GAS u32x2* y0 = (const GAS u32x2*)(F.YS() + (size_t)p0 * D) + F.lane; const GAS u32x2* y1 = (const GAS u32x2*)(F.YS() + (size_t)p1 * D) + F.lane;
#pragma unroll
            for (int j = 0; j < 8; ++j) { xq[q][j] = xr[64 * j]; ya[q][j] = y0[64 * j]; yb[q][j] = y1[64 * j]; } }
#pragma unroll
        for (int q = 0; q < 2; ++q) { if (!ok[q]) continue;
            float s = 0.f;
#pragma unroll
            for (int j = 0; j < 8; ++j) { const f32x4 f = unpack4(ya[q][j]) * w0[q] + unpack4(yb[q][j]) * w1[q]; const f32x4 g = *(const f32x4*)(g2 + 4 * F.lane + 256 * j);
                v[q][j] = unpack4(xq[q][j]) * ALPHA + g * f; s += (v[q][j][0] + v[q][j][1]) + (v[q][j][2] + v[q][j][3]); }
            const float mean = wave_sum(s) * (1.f / D); float s2 = 0.f;
#pragma unroll
            for (int j = 0; j < 8; ++j) { v[q][j] = v[q][j] - mean; s2 += (v[q][j][0] * v[q][j][0] + v[q][j][1] * v[q][j][1]) + (v[q][j][2] * v[q][j][2] + v[q][j][3] * v[q][j][3]); }
            const float rstd = 1.f / sqrtf(wave_sum(s2) * (1.f / D) + LN_EPS);
            GAS f32x4* xo = (GAS f32x4*)(F.out() + (size_t)rw[q] * D) + F.lane;
#pragma unroll
            for (int j = 0; j < 8; ++j) { const f32x4 g = *(const f32x4*)(F.ln2_g() + 4 * F.lane + 256 * j), b = *(const f32x4*)(F.ln2_b() + 4 * F.lane + 256 * j); xo[64 * j] = v[q][j] * rstd * g + b; } }
    }
}

__global__ void __launch_bounds__(512, 2) mk_fwd(Args args) {
    extern __shared__ __attribute__((aligned(16))) unsigned char lds[];
    Frame F;
    F.lds = (LAS unsigned char*)lds;
    F.tid = threadIdx.x; F.lane = F.tid & 63; F.wave = __builtin_amdgcn_readfirstlane(F.tid >> 6); F.bid = blockIdx.x; F.G = gridDim.x;
    F.a = &args; F.ws = args.ws;
    for (int u = F.tid; u < (LDS_BYTES - LDSCTL_OFF) / 4; u += 512) ((LAS unsigned*)(F.lds + LDSCTL_OFF))[u] = 0u;
    __syncthreads();
    const int lo = args.ph_lo, hi = args.ph_hi;
    const bool fused = (hi - lo) > 1;
    XcdBarrier bar; bar.bar = F.ctl() + CW_BAR; bar.x = 0; bar.st = nullptr;
    if (fused) bar = xcd_barrier_post(F.ctl() + CW_BAR, (volatile LAS unsigned*)(F.lds + MISC_OFF));
#ifndef PH_MASK
#define PH_MASK 0x1fff
#endif
#define IN(k) (((PH_MASK >> (k)) & 1) && lo <= (k) && (k) < hi)
#define SEAM(k) do { if (IN(k) && IN((k) + 1)) xcd_barrier(bar); PEND(k); PSTART((k) + 1); } while (0)
#ifdef PROBE_MASK
    unsigned long long p_t = __builtin_amdgcn_s_memrealtime(), p_acc = 0;
#define PSTART(k) do { if ((PROBE_MASK >> (k)) & 1) p_t = __builtin_amdgcn_s_memrealtime(); } while (0)
#define PEND(k) do { if ((PROBE_MASK >> (k)) & 1) p_acc += __builtin_amdgcn_s_memrealtime() - p_t; } while (0)
#else
#define PSTART(k) do { } while (0)
#define PEND(k) do { } while (0)
#endif

    if (IN(0)) { p0_prologue(F); } SEAM(0);
    if (IN(1)) { p1_rows(F); } SEAM(1);
    if (IN(2)) {
        pg8::SchedGrid<0> S; S.nM = TR / 256; S.nN = NPAD / 256; S.nwg = S.nM * S.nN; S.G = F.G; S.c = F.bid; S.A = (const char*)F.U(); S.B = (const char*)F.WIN(); S.a_tile = (size_t)256 * 2048 * 2; S.b_tile = (size_t)256 * 2048 * 2; S.a_split = 0; S.b_split = 0;
        pg8::EpiProj E{F.PROJ(), F.GATES(), F.b_in(), (float*)(F.ws + WS_STATP)};
        pg8::gemm_phase<pg8::EpiProj, pg8::SchedGrid<0>, true>(F.lds, 2048, 2048, 2048, S, E);
    } SEAM(2);
    if (IN(3)) {
        int cur_g = -1, cur_h = -1;
        const int ng = (F.G > 16 && (F.G - 16) % 8 == 0) ? F.G - 16 : F.G, g0 = (ng == F.G) ? 0 : 16;
        if (F.bid >= g0) for (int u = F.bid - g0; u < 1024; u += ng) { PSTART(13); gmlp_unit(F, u >> 3, u & 7, cur_g); PEND(13); }
        for (int v = F.bid; v < NCH * 8; v += F.G) { PSTART(14); mprep_unit(F, v >> 3, v & 7, cur_h); PEND(14); }
    } SEAM(3);
    if (IN(4)) { for (int u = F.bid; u < 256; u += F.G) scan_item(F, u >> 4, u & 15); } SEAM(4);
    if (IN(5)) { for (int u = F.bid; u < 1024; u += F.G) x3_unit(F, u >> 3, u & 7); } SEAM(5);
    if (IN(6)) {
        pg8::SchedGrid<1> S; S.nM = T / 256; S.nN = 8; S.nwg = S.nM * S.nN; S.G = F.G; S.c = F.bid; S.A = (const char*)F.AB(); S.B = (const char*)F.PAB(); S.a_tile = (size_t)256 * 2048 * 2; S.b_tile = (size_t)256 * 2048 * 2; S.a_split = 2048; S.b_split = 2048;
        pg8::EpiMerge E{F.Z(), F.PROJ()};
        pg8::gemm_phase<pg8::EpiMerge, pg8::SchedGrid<1>, true>(F.lds, 1024, 2048, 2048, S, E);
    } SEAM(6);
    if (IN(7)) {
        pg8::SchedGrid<0> S; S.nM = T / 256; S.nN = 8; S.nwg = S.nM * S.nN; S.G = F.G; S.c = F.bid; S.A = (const char*)F.Z(); S.B = (const char*)F.WO(); S.a_tile = (size_t)256 * 2048 * 2; S.b_tile = (size_t)256 * 2048 * 2; S.a_split = 0; S.b_split = 0;
        pg8::EpiWo E{F.x(), F.X1(), F.MOD() + 2 * 2048};
        pg8::gemm_phase<pg8::EpiWo, pg8::SchedGrid<0>, true>(F.lds, 2048, 2048, 2048, S, E);
    } SEAM(7);
    if (IN(8)) { p8_rows(F); } SEAM(8);
    if (IN(9)) { p9_gather(F); } SEAM(9);
    if (IN(10)) {
        const int NT = moe_tables(F);
        pg8::SchedMoe S; S.nwg = NT * 8; S.G = F.G; S.c = F.bid; S.tile_e = (const LAS int*)(F.lds + TILEE_OFF); S.A = (const char*)F.XS(); S.B = (const char*)F.W13(); S.a_tile = (size_t)256 * 2048 * 2; S.b_exp = (size_t)2048 * 2048 * 2; S.b_tile = (size_t)256 * 2048 * 2;
        pg8::EpiMoeUp E{F.H()};
        pg8::gemm_phase<pg8::EpiMoeUp, pg8::SchedMoe, true>(F.lds, 2048, 2048, 2048, S, E);
    } SEAM(10);
    if (IN(11)) {
        const int NT = moe_tables(F);
        pg8::SchedMoe S; S.nwg = NT * 8; S.G = F.G; S.c = F.bid; S.tile_e = (const LAS int*)(F.lds + TILEE_OFF); S.A = (const char*)F.H(); S.B = (const char*)F.W2(); S.a_tile = (size_t)256 * 1024 * 2; S.b_exp = (size_t)2048 * 1024 * 2; S.b_tile = (size_t)256 * 1024 * 2;
        pg8::EpiMoeDown E{F.YS()};
        pg8::gemm_phase<pg8::EpiMoeDown, pg8::SchedMoe, true>(F.lds, 1024, 1024, 1024, S, E);
    } SEAM(11);
    if (IN(12)) { p12_rows(F); }
    PEND(12);
#ifdef PROBE_MASK
    if (fused) xcd_barrier(bar);
    if (F.bid == 0 && F.tid == 0) { const unsigned long long t0 = __builtin_amdgcn_s_memrealtime(); while (__builtin_amdgcn_s_memrealtime() - t0 < p_acc * PROBE_MUL) __builtin_amdgcn_s_sleep(8); }
#endif
#undef IN
#undef SEAM
}

extern "C" void kernel_launch(void* const* d_in, const int* in_sizes, int n_in, void* d_out, int out_size, void* d_ws, size_t ws_size, hipStream_t stream) {
    static int grid = 0;
    if (grid == 0) {
        if (n_in != 32 || out_size != T * D || ws_size < WS_END) { fprintf(stderr, "kernel_launch: unexpected shapes (n_in %d, out %d, ws %zu; need ws >= %zu); nothing launched\n", n_in, out_size, ws_size, (size_t)WS_END); grid = -1; return; }
        int dev = 0, cus = 0, per_cu = 0;
        if (hipGetDevice(&dev) != hipSuccess || hipDeviceGetAttribute(&cus, hipDeviceAttributeMultiprocessorCount, dev) != hipSuccess) { grid = -1; return; }
        if (hipFuncSetAttribute((const void*)mk_fwd, hipFuncAttributeMaxDynamicSharedMemorySize, LDS_BYTES) != hipSuccess) { fprintf(stderr, "kernel_launch: hipFuncSetAttribute failed\n"); grid = -1; return; }
        if (hipOccupancyMaxActiveBlocksPerMultiprocessor(&per_cu, (const void*)mk_fwd, 512, LDS_BYTES) != hipSuccess || per_cu < 1) { fprintf(stderr, "kernel_launch: occupancy query reports %d\n", per_cu); }
        (void)hipGetLastError();
        grid = cus;
    }
    if (grid < 0) return;
    (void)hipMemsetAsync((char*)d_ws + WS_CTL, 0, CTL_ZERO_BYTES, stream);
    Args a{};
    for (int i = 0; i < 32; ++i) a.in[i] = (const float*)d_in[i];
    a.outp = (float*)d_out; a.ws = (unsigned char*)d_ws;
    if (MK_N_LAUNCHES == 1) { a.ph_lo = 0; a.ph_hi = NPHASE; hipLaunchKernelGGL(mk_fwd, dim3(grid), dim3(512), LDS_BYTES, stream, a); }
    else for (int p = 0; p < NPHASE; ++p) { a.ph_lo = p; a.ph_hi = p + 1; hipLaunchKernelGGL(mk_fwd, dim3(grid), dim3(512), LDS_BYTES, stream, a); }
}
```

```cpp
#include <hip/hip_runtime.h>
#include <cstdio>
#include <cstdint>

#ifndef MK_N_LAUNCHES
#define MK_N_LAUNCHES 1
#endif

#define GAS __attribute__((address_space(1)))
#define LAS __attribute__((address_space(3)))
#define DI __device__ __forceinline__
typedef unsigned short u16;
typedef short bf16x8 __attribute__((ext_vector_type(8)));
typedef float f32x4 __attribute__((ext_vector_type(4)));
typedef float f32x2 __attribute__((ext_vector_type(2)));
typedef unsigned u32x4 __attribute__((ext_vector_type(4)));
typedef unsigned u32x2 __attribute__((ext_vector_type(2)));

constexpr int T = 16384, TC = 256, TR = T + TC, D = 2048, DIN = 9248, NPJ = 9216, NPAD = 9472;
constexpr int OFF_UA = 0, OFF_VA = 1024, OFF_XM = 2048, OFF_VB = 3072, OFF_OB = 4096, OFF_GA = 5120, OFF_GB = 7168, OFF_GATES = 9216;
constexpr int NCH = 130;
constexpr int NE = 32, DE = 1024;
constexpr int XS_TILES = 160;
constexpr float LN_EPS = 1e-5f, NEGF = -1e30f, ALPHA = 1.189207115002721f;
constexpr int NPHASE = 13;

constexpr size_t MiB = 1u << 20;
constexpr size_t WS_CTL = 0, CTL_ZERO_BYTES = 1 * MiB;
constexpr size_t WS_MOD = 1 * MiB;
constexpr size_t WS_WRT = 1 * MiB + 512 * 1024;
constexpr size_t WS_WQK = 2 * MiB;
constexpr size_t WS_WSB = 2 * MiB + 512 * 1024;
constexpr size_t WS_GB = 3 * MiB;
constexpr size_t WS_NL = 6 * MiB;
constexpr size_t WS_SC = 7 * MiB + 512 * 1024;
constexpr size_t WS_TOKE = 8 * MiB;
constexpr size_t WS_TOKW = 8 * MiB + 128 * 1024;
constexpr size_t WS_TOKS = 8 * MiB + 256 * 1024;
constexpr size_t WS_TOKP = 8 * MiB + 384 * 1024;
constexpr size_t WS_GATES = 9 * MiB;
constexpr size_t WS_STATP = 12 * MiB;
constexpr size_t WS_WIN = 16 * MiB;
constexpr size_t WS_PAB = 53 * MiB;
constexpr size_t WS_WO = 61 * MiB;
constexpr size_t WS_W13 = 69 * MiB;
constexpr size_t WS_W2 = 325 * MiB;
constexpr size_t WS_R1 = 453 * MiB;
constexpr size_t WS_XS = WS_R1, WS_H = WS_R1 + 160 * MiB;
constexpr size_t WS_R2 = 746 * MiB;
constexpr size_t WS_R3 = 811 * MiB;
constexpr size_t WS_R4 = 875 * MiB;
constexpr size_t WS_R5 = 940 * MiB;
constexpr size_t WS_YS = WS_R2;
constexpr size_t WS_END = 1004 * MiB;
static_assert(WS_R1 + (size_t)TR * NPJ * 2 <= WS_R2 && WS_H + (size_t)XS_TILES * 256 * 1024 * 2 <= WS_R2, "R1");
static_assert(WS_R2 + (size_t)TR * 2048 * 2 <= WS_R3 && WS_R3 + (size_t)T * 2048 * 2 <= WS_R4 && WS_R4 + (size_t)16 * NCH * 16384 * 2 <= WS_R5 && WS_R5 + (size_t)T * 2048 * 2 <= WS_END, "R2-5");
static_assert(WS_YS + (size_t)XS_TILES * 256 * 2048 * 2 <= WS_R5, "YS");
static_assert(WS_WIN + (size_t)NPAD * 2048 * 2 <= WS_PAB && WS_W13 + (size_t)32 * 2048 * 2048 * 2 <= WS_W2 && WS_W2 + (size_t)32 * 2048 * 1024 * 2 <= WS_R1, "weights");
static_assert(WS_GB + (size_t)8 * TR * 16 <= WS_NL && WS_NL + (size_t)16 * NCH * 128 * 4 <= WS_SC && WS_GATES + (size_t)TR * 32 * 4 <= WS_WIN, "small");
constexpr int CW_CNT = 64;
constexpr int CW_BAR = 4096;

constexpr int RING_BYTES = 131072;
constexpr int LDSCTL_OFF = 147456;
constexpr int MISC_OFF = LDSCTL_OFF + 64;
constexpr int TILEE_OFF = LDSCTL_OFF + 256;
constexpr int LDS_BYTES = 149504;

DI unsigned cvt_pk_bf16(float lo, float hi) { unsigned r; asm volatile("v_cvt_pk_bf16_f32 %0, %1, %2" : "=v"(r) : "v"(lo), "v"(hi)); return r; }
DI unsigned f2bf(float f) { return cvt_pk_bf16(f, 0.f) & 0xffffu; }
DI float bflo(unsigned w) { return __uint_as_float(w << 16); }
DI float bfhi(unsigned w) { return __uint_as_float(w & 0xffff0000u); }
DI u32x2 pack4(f32x4 v) { u32x2 o; o.x = cvt_pk_bf16(v[0], v[1]); o.y = cvt_pk_bf16(v[2], v[3]); return o; }
DI f32x4 unpack4(u32x2 w) { return (f32x4){bflo(w.x), bfhi(w.x), bflo(w.y), bfhi(w.y)}; }
DI float sigmoid_fast(float x) { return __builtin_amdgcn_rcpf(1.f + __builtin_amdgcn_exp2f(-1.4426950408889634f * x)); }
DI float gelu_tanh_fast(float x) { const float y = 1.5957691216057308f * (x + 0.044715f * x * x * x); return x * sigmoid_fast(y); }
DI float logsig(float x) { return x < 0.f ? x - log1pf(expf(x)) : -log1pf(expf(-x)); }
DI float wave_sum(float v) {
#pragma unroll
    for (int o = 1; o < 64; o <<= 1) v += __shfl_xor(v, o);
    return v;
}
DI float wave_max(float v) {
#pragma unroll
    for (int o = 1; o < 64; o <<= 1) v = fmaxf(v, __shfl_xor(v, o));
    return v;
}
#define LDS_WAIT() asm volatile("s_waitcnt lgkmcnt(0)" ::: "memory")

namespace pg8 {
constexpr int BM = 256, BK = 64, HALF = 128, HTB = HALF * BK * 2, STAGE_BYTES = 8 * HTB, NXCD = 8, WGM = 8;
__host__ __device__ __forceinline__ int lds_byte(int r, int c) { const int st = (r >> 4) * 2 + (c >> 5), rr = r & 15, cc = c & 31, ob = rr * 64 + cc * 2; return st * 1024 + (ob ^ (((ob >> 9) & 1) << 5)); }
__host__ __device__ __forceinline__ void stage_rc(int b, int& R, int& C) { const int st = b / 1024, sb = b % 1024, swz = sb ^ (((sb >> 9) & 1) << 5); R = (st >> 1) * 16 + swz / 64; C = (st & 1) * 32 + (swz % 64) / 2; }
__host__ __device__ __forceinline__ int perm32(int rho) { const int n = rho >> 4, i = rho & 15; return 8 * (i >> 2) + 4 * n + (i & 3); }
struct Unit { int pm, pn, ex; };
DI int xcd_remap(int wgid, int nwg) { const int q = nwg / NXCD, r = nwg % NXCD, xcd = wgid % NXCD, off = wgid / NXCD; return (xcd < r ? xcd * (q + 1) : r * (q + 1) + (xcd - r) * q) + off; }

template <int SPLIT> struct SchedGrid {
    int nM, nN, nwg, G, c; const char* A; const char* B; size_t a_tile, b_tile, a_split, b_split;
    DI bool next(int i, Unit& u) const {
        const int j = SPLIT ? (i >> 1) : i; u.ex = SPLIT ? (i & 1) : 0;
        const long L = (long)j * G + c; if (L >= nwg) return false;
        const int wgid = xcd_remap((int)L, nwg);
        const int nig = WGM * nN, gid = wgid / nig, fm = gid * WGM, gsz = (nM - fm) < WGM ? (nM - fm) : WGM;
        u.pm = fm + ((wgid % nig) % gsz); u.pn = (wgid % nig) / gsz; return true;
    }
    DI const char* a_base(const Unit& u) const { return A + (size_t)u.pm * a_tile + (size_t)u.ex * a_split; }
    DI const char* b_base(const Unit& u) const { return B + (size_t)u.pn * b_tile + (size_t)u.ex * b_split; }
    DI void a_ready(const Unit&) const {}
    DI void done(const Unit&) const {}
};
struct SchedMoe {
    int nwg, G, c; const LAS int* tile_e; const char* A; const char* B; size_t a_tile, b_exp, b_tile;
    DI bool next(int i, Unit& u) const {
        const long L = (long)i * G + c; if (L >= nwg) return false;
        const int w = xcd_remap((int)L, nwg); u.pm = w >> 3; u.pn = w & 7; u.ex = __builtin_amdgcn_readfirstlane(tile_e[u.pm]); return true;
    }
    DI const char* a_base(const Unit& u) const { return A + (size_t)u.pm * a_tile; }
    DI const char* b_base(const Unit& u) const { return B + (size_t)u.ex * b_exp + (size_t)u.pn * b_tile; }
    DI void a_ready(const Unit&) const {}
    DI void done(const Unit&) const {}
};

DI void glds16_saddr(const char* sbase, unsigned voff, unsigned lds_dst) {
    unsigned keep;
    asm volatile("s_mov_b32 %0, m0\n\ts_mov_b32 m0, %3\n\ts_nop 2\n\tglobal_load_lds_dwordx4 %1, %2\n\ts_mov_b32 m0, %0" : "=&s"(keep) : "v"(voff), "s"(sbase), "s"(lds_dst) : "memory");
}
template <class Epi, class Sched, bool ALIGN_EPI>
DI void gemm_phase(LAS unsigned char* lds, const int K, const int lda, const int ldb, const Sched& S, const Epi& E) {
    const int tid = threadIdx.x, wid = __builtin_amdgcn_readfirstlane(tid >> 6), lane = tid & 63, wr = wid >> 2, wc = wid & 3, fr = lane & 15, fq = lane >> 4;
    const int nt = K / BK;
    unsigned voffA[2], voffB[2];
#pragma unroll
    for (int i = 0; i < 2; ++i) { int R, C; stage_rc(tid * 16 + i * 8192, R, C); const int Rb = Epi::PERM ? ((R & ~31) + perm32(R & 31)) : R;
        voffA[i] = (unsigned)(R * lda + C) * 2u; voffB[i] = (unsigned)(Rb * ldb + C) * 2u; }
    const size_t kstep = (size_t)(BK * 2);
    const size_t hstepA = (size_t)HALF * lda * 2, hstepB = (size_t)HALF * ldb * 2;
    const unsigned ldsb = (unsigned)(size_t)lds + (unsigned)wid * 1024u;
    const int aoff = lds_byte(wr * 64 + fr, fq * 8), boff = lds_byte(wc * 32 + fr, fq * 8);
#define PG8_SA(b, h) (((b) * 2 + (h)) * HTB)
#define PG8_SB(b, h) ((4 + (b) * 2 + (h)) * HTB)
#define PG8_STAGE(bufoff, gbase, voff) do { _Pragma("unroll") for (int _i = 0; _i < 2; ++_i) glds16_saddr((const char*)(gbase), (voff)[_i], ldsb + (unsigned)((bufoff) + _i * 8192)); } while (0)
#define PG8_LDA(dst, b, h) do { _Pragma("unroll") for (int m = 0; m < 4; ++m) _Pragma("unroll") for (int k = 0; k < 2; ++k) dst[m][k] = *(const LAS bf16x8*)(lds + PG8_SA(b, h) + aoff + m * 2048 + k * 1024); } while (0)
#define PG8_LDB(dst, b, h) do { _Pragma("unroll") for (int n = 0; n < 2; ++n) _Pragma("unroll") for (int k = 0; k < 2; ++k) dst[n][k] = *(const LAS bf16x8*)(lds + PG8_SB(b, h) + boff + n * 2048 + k * 1024); } while (0)
#define PG8_MMA(ai, bj, At, Bt) do { __builtin_amdgcn_s_setprio(1); _Pragma("unroll") for (int m = 0; m < 4; ++m) _Pragma("unroll") for (int n = 0; n < 2; ++n) _Pragma("unroll") for (int k = 0; k < 2; ++k) \
        acc[ai][bj][m][n] = __builtin_amdgcn_mfma_f32_16x16x32_bf16(Bt[n][k], At[m][k], acc[ai][bj][m][n], 0, 0, 0); __builtin_amdgcn_s_setprio(0); } while (0)
#define PG8_WAIT_V(n) asm volatile("s_waitcnt vmcnt(" #n ")" ::: "memory")
#define PG8_WAIT_L(n) asm volatile("s_waitcnt lgkmcnt(" #n ")" ::: "memory")
#define PG8_BAR __builtin_amdgcn_s_barrier()
#define PG8_SCHED __builtin_amdgcn_sched_barrier(0)
    Unit cur, nxt; int ui = 0;
    if (!S.next(0, cur)) return;
    f32x4 acc[2][2][4][2];
#pragma unroll
    for (int a = 0; a < 2; ++a)
#pragma unroll
        for (int b = 0; b < 2; ++b)
#pragma unroll
            for (int m = 0; m < 4; ++m)
#pragma unroll
                for (int n = 0; n < 2; ++n) acc[a][b][m][n] = (f32x4){0.f, 0.f, 0.f, 0.f};
    bf16x8 At[4][2], B0[2][2], B1[2][2];
    const char* cA = S.a_base(cur); const char* cB = S.b_base(cur);
    S.a_ready(cur);
    PG8_STAGE(PG8_SB(0, 0), cB, voffB); PG8_STAGE(PG8_SB(0, 1), cB + hstepB, voffB); PG8_STAGE(PG8_SA(0, 0), cA, voffA); PG8_STAGE(PG8_SA(0, 1), cA + hstepA, voffA);
    if (wr == 1) PG8_BAR;
    PG8_WAIT_V(2); PG8_BAR;
    PG8_STAGE(PG8_SB(1, 0), cB + kstep, voffB); PG8_STAGE(PG8_SA(1, 0), cA + kstep, voffA); PG8_STAGE(PG8_SB(1, 1), cB + hstepB + kstep, voffB);
    PG8_WAIT_V(6); PG8_BAR;
    for (;;) {
        const bool has_next = S.next(ui + 1, nxt);
        const char* nA = has_next ? S.a_base(nxt) : cA; const char* nB = has_next ? S.b_base(nxt) : cB;
#pragma unroll 1
        for (int t = 0; t < nt; t += 2) {
            const bool last = (t == nt - 2);
            const char* a1 = cA + (size_t)(t + 1) * kstep;
            const char* a2 = last ? nA : cA + (size_t)(t + 2) * kstep; const char* b2 = last ? nB : cB + (size_t)(t + 2) * kstep;
            const char* a3 = a2 + kstep; const char* b3 = b2 + kstep;
            if (last && has_next) S.a_ready(nxt);
            PG8_LDB(B0, 0, 0); PG8_LDB(B1, 0, 1); PG8_SCHED; PG8_LDA(At, 0, 0); PG8_STAGE(PG8_SA(1, 1), a1 + hstepA, voffA);
            PG8_WAIT_V(8); PG8_WAIT_L(0); PG8_BAR; PG8_MMA(0, 0, At, B0); PG8_MMA(0, 1, At, B1); PG8_BAR; PG8_SCHED;
            PG8_LDA(At, 0, 1); PG8_STAGE(PG8_SB(0, 0), b2, voffB); PG8_STAGE(PG8_SB(0, 1), b2 + hstepB, voffB); PG8_STAGE(PG8_SA(0, 0), a2, voffA);
            PG8_WAIT_V(8); PG8_WAIT_L(0); PG8_BAR; PG8_MMA(1, 0, At, B0); PG8_MMA(1, 1, At, B1); PG8_BAR; PG8_SCHED;
            PG8_LDB(B0, 1, 0); PG8_LDB(B1, 1, 1); PG8_SCHED; PG8_LDA(At, 1, 0); PG8_STAGE(PG8_SA(0, 1), a2 + hstepA, voffA);
            PG8_WAIT_V(8); PG8_WAIT_L(0); PG8_BAR; PG8_MMA(0, 0, At, B0); PG8_MMA(0, 1, At, B1); PG8_BAR; PG8_SCHED;
            PG8_LDA(At, 1, 1); PG8_STAGE(PG8_SB(1, 0), b3, voffB); PG8_STAGE(PG8_SB(1, 1), b3 + hstepB, voffB); PG8_STAGE(PG8_SA(1, 0), a3, voffA);
            PG8_WAIT_V(8); PG8_WAIT_L(0); PG8_BAR; PG8_MMA(1, 0, At, B0); PG8_MMA(1, 1, At, B1); PG8_BAR; PG8_SCHED;
        }
        if constexpr (ALIGN_EPI) { if (wr == 0) PG8_BAR; }
        E(acc, cur, wr, wc, fr, fq); S.done(cur);
        if (!has_next) break;
#pragma unroll
        for (int a = 0; a < 2; ++a)
#pragma unroll
            for (int b = 0; b < 2; ++b)
#pragma unroll
                for (int m = 0; m < 4; ++m)
#pragma unroll
                    for (int n = 0; n < 2; ++n) acc[a][b][m][n] = (f32x4){0.f, 0.f, 0.f, 0.f};
        cur = nxt; cA = nA; cB = nB; ++ui;
        if constexpr (ALIGN_EPI) { if (wr == 1) PG8_BAR; }
    }
    PG8_WAIT_V(0);
    if constexpr (!ALIGN_EPI) { if (wr == 0) PG8_BAR; }
    PG8_BAR;
#undef PG8_SA
#undef PG8_SB
#undef PG8_STAGE
#undef PG8_LDA
#undef PG8_LDB
#undef PG8_MMA
#undef PG8_WAIT_V
#undef PG8_WAIT_L
#undef PG8_BAR
#undef PG8_SCHED
}

struct EpiProj {
    static constexpr bool PERM = true;
    u16* P; float* gates; const float* bias; float* statp;
    DI void operator()(const f32x4 (&acc)[2][2][4][2], const Unit& u, int wr, int wc, int fr, int fq) const {
        const int row0 = u.pm * BM + wr * 64 + fr;
        if (u.pn == 36) {
            if (wc == 0) {
                const int c0 = 8 * fq; const f32x4 b0 = *(const f32x4*)(bias + OFF_GATES + c0), b1 = *(const f32x4*)(bias + OFF_GATES + c0 + 4);
#pragma unroll
                for (int ai = 0; ai < 2; ++ai)
#pragma unroll
                    for (int m = 0; m < 4; ++m) { float* g = gates + (size_t)(row0 + ai * HALF + m * 16) * 32 + c0;
                        *(f32x4*)g = acc[ai][0][m][0] + b0; *(f32x4*)(g + 4) = acc[ai][0][m][1] + b1; }
            }
            return;
        }
        const int seg = u.pn >> 2; const int mode = (seg <= 1) ? 1 : ((seg <= 3) ? 0 : 2);
        const int col0 = u.pn * BM + wc * 32 + 8 * fq;
        f32x4 bv[2][2];
#pragma unroll
        for (int bj = 0; bj < 2; ++bj)
#pragma unroll
            for (int n = 0; n < 2; ++n) bv[bj][n] = *(const f32x4*)(bias + col0 + bj * HALF + 4 * n);
        float ps[2][4], pq[2][4];
#pragma unroll
        for (int ai = 0; ai < 2; ++ai)
#pragma unroll
            for (int m = 0; m < 4; ++m) { ps[ai][m] = 0.f; pq[ai][m] = 0.f; }
#pragma unroll
        for (int ai = 0; ai < 2; ++ai)
#pragma unroll
            for (int m = 0; m < 4; ++m) { u16* rowp = P + (size_t)(row0 + ai * HALF + m * 16) * NPJ + col0;
#pragma unroll
                for (int bj = 0; bj < 2; ++bj) { f32x4 v0 = acc[ai][bj][m][0] + bv[bj][0], v1 = acc[ai][bj][m][1] + bv[bj][1];
                    if (mode == 1) {
#pragma unroll
                        for (int j = 0; j < 4; ++j) { v0[j] = gelu_tanh_fast(v0[j]); v1[j] = gelu_tanh_fast(v1[j]); } }
                    else if (mode == 2) {
#pragma unroll
                        for (int j = 0; j < 4; ++j) { v0[j] = sigmoid_fast(v0[j]); v1[j] = sigmoid_fast(v1[j]); } }
                    u32x4 w; w.x = cvt_pk_bf16(v0[0], v0[1]); w.y = cvt_pk_bf16(v0[2], v0[3]); w.z = cvt_pk_bf16(v1[0], v1[1]); w.w = cvt_pk_bf16(v1[2], v1[3]);
                    *(u32x4*)(rowp + bj * HALF) = w;
                    if (seg == 1) {
                        const float r8[8] = {bflo(w.x), bfhi(w.x), bflo(w.y), bfhi(w.y), bflo(w.z), bfhi(w.z), bflo(w.w), bfhi(w.w)};
#pragma unroll
                        for (int j = 0; j < 8; ++j) { ps[ai][m] += r8[j]; pq[ai][m] += r8[j] * r8[j]; } } } }
        if (seg == 1) {
#pragma unroll
            for (int ai = 0; ai < 2; ++ai)
#pragma unroll
                for (int m = 0; m < 4; ++m) { float a = ps[ai][m], b = pq[ai][m]; a += __shfl_xor(a, 16); a += __shfl_xor(a, 32); b += __shfl_xor(b, 16); b += __shfl_xor(b, 32);
                    if (fq == 0) *(f32x2*)(statp + (size_t)(row0 + ai * HALF + m * 16) * 32 + ((u.pn & 3) * 4 + wc) * 2) = (f32x2){a, b}; }
        }
    }
};
struct EpiMerge {
    static constexpr bool PERM = true;
    u16* Z; const u16* P;
    DI void operator()(const f32x4 (&acc)[2][2][4][2], const Unit& u, int wr, int wc, int fr, int fq) const {
        const int row0 = u.pm * BM + wr * 64 + fr, col0 = u.pn * BM + wc * 32 + 8 * fq, goff = u.ex ? OFF_GB : OFF_GA;
#pragma unroll
        for (int ai = 0; ai < 2; ++ai) {
            u32x4 gq[4][2], zq[4][2];
#pragma unroll
            for (int m = 0; m < 4; ++m) { const size_t row = (size_t)(row0 + ai * HALF + m * 16); const u16* zp = Z + row * 2048 + col0; const u16* gp = P + row * NPJ + goff + col0;
#pragma unroll
                for (int bj = 0; bj < 2; ++bj) { gq[m][bj] = *(const u32x4*)(gp + bj * HALF); zq[m][bj] = u.ex ? *(const u32x4*)(zp + bj * HALF) : (u32x4){0u, 0u, 0u, 0u}; } }
#pragma unroll
            for (int m = 0; m < 4; ++m) { const size_t row = (size_t)(row0 + ai * HALF + m * 16); u16* zp = Z + row * 2048 + col0;
#pragma unroll
                for (int bj = 0; bj < 2; ++bj) { const u32x4 g = gq[m][bj], z = zq[m][bj];
                    const f32x4 v0 = acc[ai][bj][m][0] * (f32x4){bflo(g.x), bfhi(g.x), bflo(g.y), bfhi(g.y)} + (f32x4){bflo(z.x), bfhi(z.x), bflo(z.y), bfhi(z.y)};
                    const f32x4 v1 = acc[ai][bj][m][1] * (f32x4){bflo(g.z), bfhi(g.z), bflo(g.w), bfhi(g.w)} + (f32x4){bflo(z.z), bfhi(z.z), bflo(z.w), bfhi(z.w)};
                    u32x4 w; w.x = cvt_pk_bf16(v0[0], v0[1]); w.y = cvt_pk_bf16(v0[2], v0[3]); w.z = cvt_pk_bf16(v1[0], v1[1]); w.w = cvt_pk_bf16(v1[2], v1[3]);
                    *(u32x4*)(zp + bj * HALF) = w; } }
        }
    }
};
struct EpiWo {
    static constexpr bool PERM = true;
    const float* x; u16* R; const float* g1;
    DI void operator()(const f32x4 (&acc)[2][2][4][2], const Unit& u, int wr, int wc, int fr, int fq) const {
        const int row0 = u.pm * BM + wr * 64 + fr, col0 = u.pn * BM + wc * 32 + 8 * fq;
        f32x4 gv[2][2];
#pragma unroll
        for (int bj = 0; bj < 2; ++bj)
#pragma unroll
            for (int n = 0; n < 2; ++n) gv[bj][n] = *(const f32x4*)(g1 + col0 + bj * HALF + 4 * n);
#pragma unroll
        for (int ai = 0; ai < 2; ++ai) {
            f32x4 xs[4][2][2];
#pragma unroll
            for (int m = 0; m < 4; ++m) { const size_t off = (size_t)(row0 + ai * HALF + m * 16) * 2048 + col0;
#pragma unroll
                for (int bj = 0; bj < 2; ++bj)
#pragma unroll
                    for (int n = 0; n < 2; ++n) xs[m][bj][n] = *(const f32x4*)(x + off + bj * HALF + 4 * n); }
#pragma unroll
            for (int m = 0; m < 4; ++m) { const size_t off = (size_t)(row0 + ai * HALF + m * 16) * 2048 + col0;
#pragma unroll
                for (int bj = 0; bj < 2; ++bj) { const f32x4 v0 = xs[m][bj][0] * ALPHA + gv[bj][0] * acc[ai][bj][m][0], v1 = xs[m][bj][1] * ALPHA + gv[bj][1] * acc[ai][bj][m][1];
                    u32x4 w; w.x = cvt_pk_bf16(v0[0], v0[1]); w.y = cvt_pk_bf16(v0[2], v0[3]); w.z = cvt_pk_bf16(v1[0], v1[1]); w.w = cvt_pk_bf16(v1[2], v1[3]);
                    *(u32x4*)(R + off + bj * HALF) = w; } }
        }
    }
};
struct EpiMoeUp {
    static constexpr bool PERM = true;
    u16* H;
    DI void operator()(const f32x4 (&acc)[2][2][4][2], const Unit& u, int wr, int wc, int fr, int fq) const {
        const int row0 = u.pm * BM + wr * 64 + fr, col0 = u.pn * HALF + wc * 32 + 8 * fq;
#pragma unroll
        for (int ai = 0; ai < 2; ++ai)
#pragma unroll
            for (int m = 0; m < 4; ++m) { u16* hp = H + (size_t)(row0 + ai * HALF + m * 16) * DE + col0; f32x4 o[2];
#pragma unroll
                for (int n = 0; n < 2; ++n)
#pragma unroll
                    for (int j = 0; j < 4; ++j) { const float a = acc[ai][0][m][n][j]; o[n][j] = a * sigmoid_fast(a) * acc[ai][1][m][n][j]; }
                u32x4 w; w.x = cvt_pk_bf16(o[0][0], o[0][1]); w.y = cvt_pk_bf16(o[0][2], o[0][3]); w.z = cvt_pk_bf16(o[1][0], o[1][1]); w.w = cvt_pk_bf16(o[1][2], o[1][3]);
                *(u32x4*)hp = w; }
    }
};
struct EpiMoeDown {
    static constexpr bool PERM = true;
    u16* Y;
    DI void operator()(const f32x4 (&acc)[2][2][4][2], const Unit& u, int wr, int wc, int fr, int fq) const {
        const int row0 = u.pm * BM + wr * 64 + fr, col0 = u.pn * BM + wc * 32 + 8 * fq;
#pragma unroll
        for (int ai = 0; ai < 2; ++ai)
#pragma unroll
            for (int m = 0; m < 4; ++m) { u16* yp = Y + (size_t)(row0 + ai * HALF + m * 16) * 2048 + col0;
#pragma unroll
                for (int bj = 0; bj < 2; ++bj) { const f32x4 v0 = acc[ai][bj][m][0], v1 = acc[ai][bj][m][1];
                    u32x4 w; w.x = cvt_pk_bf16(v0[0], v0[1]); w.y = cvt_pk_bf16(v0[2], v0[3]); w.z = cvt_pk_bf16(v1[0], v1[1]); w.w = cvt_pk_bf16(v1[2], v1[3]);
                    *(u32x4*)(yp + bj * HALF) = w; } }
    }
};
}

#define XB_TMO      128
#define XB_XCNT(j)  (256  + 64 * (j))
#define XB_XSUB(j)  (1280 + 64 * (j))
#define XB_XGEN(j)  (2304 + 64 * (j))
#define XB_TOP      3328
#define XB_TOPGEN   3392
#define XCD_BAR_WORDS 3456
#define XB_SPIN_CAP (1u << 18)
__device__ __forceinline__ unsigned xb_ld(unsigned* p)              { return __hip_atomic_load(p, __ATOMIC_RELAXED, __HIP_MEMORY_SCOPE_AGENT); }
__device__ __forceinline__ unsigned xb_add(unsigned* p, unsigned v) { return __hip_atomic_fetch_add(p, v, __ATOMIC_RELAXED, __HIP_MEMORY_SCOPE_AGENT); }
__device__ __forceinline__ unsigned xb_xcc_id() { return (unsigned)__builtin_amdgcn_s_getreg((3 << 11) | 20) & 0xFu; }
#define XB_SPIN(cond, bar) do { unsigned _sp = 0; while (cond) { __builtin_amdgcn_s_sleep(1); \
    if ((++_sp & 255u) == 0u) { if (xb_ld(&(bar)[XB_TMO])) break; if (_sp > XB_SPIN_CAP) { atomicAdd(&(bar)[XB_TMO], 1u); break; } } } } while (0)
struct XcdBarrier { unsigned* bar; unsigned x; volatile LAS unsigned* st; };
__device__ __forceinline__ XcdBarrier xcd_barrier_post(unsigned* bar, volatile LAS unsigned* st) {
    XcdBarrier b; b.bar = bar; b.x = xb_xcc_id(); b.st = st;
    if (threadIdx.x == 0) (void)xb_add(&bar[XB_XCNT(b.x)], 1u);
    return b;
}
__device__ __forceinline__ void xcd_barrier_complete(unsigned* bar, unsigned x, unsigned& nloc, unsigned& nx) {
    const unsigned G = gridDim.x * gridDim.y * gridDim.z;
    unsigned sum, cnt, mine, sp = 0u;
    for (;;) {
        sum = 0u; cnt = 0u; mine = 0u;
#pragma unroll
        for (unsigned j = 0; j < 16; ++j) { const unsigned c = xb_ld(&bar[XB_XCNT(j)]); sum += c; cnt += (c > 0u) ? 1u : 0u; mine = (j == x) ? c : mine; }
        if (sum == G) break;
        __builtin_amdgcn_s_sleep(1);
        if ((++sp & 255u) == 0u) { if (xb_ld(&bar[XB_TMO])) break; if (sp > XB_SPIN_CAP) { atomicAdd(&bar[XB_TMO], 1u); break; } }
    }
    nloc = mine > 0u ? mine : 1u; nx = cnt > 0u ? cnt : 1u;
}
__device__ __forceinline__ void xcd_barrier(const XcdBarrier& b) {
    asm volatile("s_waitcnt vmcnt(0)" ::: "memory");
    __syncthreads();
    if (threadIdx.x == 0) {
        unsigned* bar = b.bar;
        __builtin_amdgcn_s_waitcnt(0);
        unsigned nloc = b.st[0], nx = b.st[1];
        if (nloc == 0u) { xcd_barrier_complete(bar, b.x, nloc, nx); b.st[0] = nloc; b.st[1] = nx; }
        const unsigned old = xb_add(&bar[XB_XSUB(b.x)], 1u);
        const unsigned gen = old / nloc;
        if (old + 1u == (gen + 1u) * nloc) {
            __builtin_amdgcn_fence(__ATOMIC_RELEASE, "agent");
            asm volatile("s_waitcnt vmcnt(0)" ::: "memory");
            const unsigned og = xb_add(&bar[XB_TOP], 1u);
            const unsigned tg = og / nx;
            if (og + 1u == (tg + 1u) * nx) xb_add(&bar[XB_TOPGEN], 1u);
            else XB_SPIN(xb_ld(&bar[XB_TOPGEN]) == tg, bar);
            __builtin_amdgcn_fence(__ATOMIC_ACQUIRE, "agent");
            xb_add(&bar[XB_XGEN(b.x)], 1u);
            asm volatile("s_waitcnt vmcnt(0)" ::: "memory");
        } else {
            XB_SPIN(xb_ld(&bar[XB_XGEN(b.x)]) == gen, bar);
            __builtin_amdgcn_fence(__ATOMIC_ACQUIRE, "agent");
            asm volatile("s_waitcnt vmcnt(0)" ::: "memory");
        }
    }
    __syncthreads();
}

struct Args { const float* in[32]; float* outp; unsigned char* ws; int ph_lo, ph_hi; };
struct Frame {
    LAS unsigned char* lds;
    int tid, lane, wave, bid, G;
    const Args* a; unsigned char* ws;
    DI const float* in(int i) const { asm("" : "+s"(i)); return a->in[i]; }
    DI const float* x() const { return in(0); }
    DI const float* c() const { return in(1); }
    DI const float* ctx() const { return in(2); }
    DI const float* c_ctx() const { return in(3); }
    DI const float* w_ada() const { return in(4); }
    DI const float* b_ada() const { return in(5); }
    DI const float* w_in() const { return in(6); }
    DI const float* b_in() const { return in(7); }
    DI const float* w_s() const { return in(8); }
    DI const float* b_s() const { return in(9); }
    DI const float* sgu_g() const { return in(10); }
    DI const float* sgu_b() const { return in(11); }
    DI const float* conv_w() const { return in(12); }
    DI const float* conv_b() const { return in(13); }
    DI const float* w_q() const { return in(14); }
    DI const float* w_k() const { return in(15); }
    DI const float* mh_g() const { return in(16); }
    DI const float* skip() const { return in(17); }
    DI const float* p_a() const { return in(18); }
    DI const float* p_b() const { return in(19); }
    DI const float* w_o() const { return in(20); }
    DI const float* ln1_g() const { return in(21); }
    DI const float* ln1_b() const { return in(22); }
    DI const float* w_rg() const { return in(23); }
    DI const float* b_rg() const { return in(24); }
    DI const float* w_re() const { return in(25); }
    DI const float* b_re() const { return in(26); }
    DI const float* w1() const { return in(27); }
    DI const float* w3() const { return in(28); }
    DI const float* w2() const { return in(29); }
    DI const float* ln2_g() const { return in(30); }
    DI const float* ln2_b() const { return in(31); }
    DI unsigned* ctl() const { return (unsigned*)(ws + WS_CTL); }
    DI float* MOD() const { return (float*)(ws + WS_MOD); }
    DI float* WRT() const { return (float*)(ws + WS_WRT); }
    DI float* GB() const { return (float*)(ws + WS_GB); }
    DI float* NL() const { return (float*)(ws + WS_NL); }
    DI float* SC() const { return (float*)(ws + WS_SC); }
    DI float* TOKW() const { return (float*)(ws + WS_TOKW); }
    DI float* GATES() const { return (float*)(ws + WS_GATES); }
    DI int* TOKE() const { return (int*)(ws + WS_TOKE); }
    DI int* TOKS() const { return (int*)(ws + WS_TOKS); }
    DI int* TOKP() const { return (int*)(ws + WS_TOKP); }
    DI u16* WQK() const { return (u16*)(ws + WS_WQK); }
    DI u16* WSB() const { return (u16*)(ws + WS_WSB); }
    DI u16* WIN() const { return (u16*)(ws + WS_WIN); }
    DI u16* PAB() const { return (u16*)(ws + WS_PAB); }
    DI u16* WO() const { return (u16*)(ws + WS_WO); }
    DI u16* W13() const { return (u16*)(ws + WS_W13); }
    DI u16* W2() const { return (u16*)(ws + WS_W2); }
    DI u16* PROJ() const { return (u16*)(ws + WS_R1); }
    DI u16* XS() const { return (u16*)(ws + WS_XS); }
    DI u16* H() const { return (u16*)(ws + WS_H); }
    DI u16* U() const { return (u16*)(ws + WS_R2); }
    DI u16* Q() const { return (u16*)(ws + WS_R2); }
    DI u16* K() const { return (u16*)(ws + WS_R2) + (size_t)TR * 1024; }
    DI u16* U2() const { return (u16*)(ws + WS_R2); }
    DI u16* XC() const { return (u16*)(ws + WS_R3); }
    DI u16* Z() const { return (u16*)(ws + WS_R3); }
    DI u16* ST() const { return (u16*)(ws + WS_R4); }
    DI u16* AB() const { return (u16*)(ws + WS_R5); }
    DI u16* X1() const { return (u16*)(ws + WS_R5); }
    DI u16* YS() const { return (u16*)(ws + WS_YS); }
    DI float* out() const { return a->outp; }
};

DI bf16x8 ld8(const LAS u16* p) { return *(const LAS bf16x8*)p; }
DI bf16x8 ld8(const GAS u16* p) { return *(const GAS bf16x8*)p; }
template <int NT, class PA, class PB>
DI void wave_mm(f32x4 (&acc)[NT], PA A, int lda, PB B, int ldb, int K, int lane) {
    const int fr = lane & 15, fq = lane >> 4;
#pragma unroll 1
    for (int k0 = 0; k0 < K; k0 += 32) {
        const bf16x8 a = ld8(A + fr * lda + k0 + 8 * fq);
#pragma unroll
        for (int t = 0; t < NT; ++t) { const bf16x8 b = ld8(B + (16 * t + fr) * ldb + k0 + 8 * fq); acc[t] = __builtin_amdgcn_mfma_f32_16x16x32_bf16(b, a, acc[t], 0, 0, 0); }
    }
}
template <int NT> DI void zero_acc(f32x4 (&acc)[NT]) {
#pragma unroll
    for (int t = 0; t < NT; ++t) acc[t] = (f32x4){0.f, 0.f, 0.f, 0.f};
}

DI void p0_gemv(Frame& F, int cb) {
    LAS float* sv = (LAS float*)F.lds;
    LAS float* red = sv + 4096;
    for (int i = F.tid; i < 2048; i += 512) { const float a = F.c()[i], b = F.c_ctx()[i]; sv[i] = a / (1.f + expf(-a)); sv[2048 + i] = b / (1.f + expf(-b)); }
    __syncthreads();
    const int l16 = F.tid & 15, rl = F.tid >> 4;
    f32x4 a1 = (f32x4){0.f, 0.f, 0.f, 0.f}, a2 = a1;
    const float* wp = F.w_ada() + (size_t)rl * 12288 + 64 * cb + 4 * l16;
#pragma unroll 8
    for (int it = 0; it < 64; ++it) { const f32x4 w = *(const GAS f32x4*)(wp + (size_t)it * 32 * 12288); const float s1 = sv[rl + 32 * it], s2 = sv[2048 + rl + 32 * it]; a1 += w * s1; a2 += w * s2; }
    *(LAS f32x4*)(red + (rl * 16 + l16) * 8) = a1; *(LAS f32x4*)(red + (rl * 16 + l16) * 8 + 4) = a2;
    __syncthreads();
    if (F.tid < 128) { const int v = F.tid >> 6, col = F.tid & 63, q16 = col >> 2, j = col & 3; float s = 0.f;
        for (int r = 0; r < 32; ++r) s += red[(r * 16 + q16) * 8 + v * 4 + j];
        F.MOD()[v * 12288 + 64 * cb + col] = s + F.b_ada()[64 * cb + col]; }
    __syncthreads();
}
struct TrItem { const float* src; u16* dst; int ldn, ldk; bool ok; };
DI void tr_load(const TrItem& t, f32x4 (&v)[8], int lane) {
#pragma unroll
    for (int i = 0; i < 8; ++i) { const int kk = 8 * i + (lane >> 3); v[i] = t.ok ? *(const GAS f32x4*)(t.src + (size_t)kk * t.ldn + 4 * (lane & 7)) : (f32x4){0.f, 0.f, 0.f, 0.f}; }
}
DI void tr_store(const TrItem& t, const f32x4 (&v)[8], LAS float* scr, int lane) {
#pragma unroll
    for (int i = 0; i < 8; ++i) { const int kk = 8 * i + (lane >> 3); LAS float* d = scr + kk * 33 + 4 * (lane & 7); d[0] = v[i][0]; d[1] = v[i][1]; d[2] = v[i][2]; d[3] = v[i][3]; }
    LDS_WAIT(); asm volatile("" ::: "memory");
    const int c = lane & 7;
#pragma unroll
    for (int j = 0; j < 4; ++j) { const int nn = (lane >> 3) + 8 * j; const LAS float* s = scr + (8 * c) * 33 + nn;
        u32x4 o; o.x = cvt_pk_bf16(s[0 * 33], s[1 * 33]); o.y = cvt_pk_bf16(s[2 * 33], s[3 * 33]); o.z = cvt_pk_bf16(s[4 * 33], s[5 * 33]); o.w = cvt_pk_bf16(s[6 * 33], s[7 * 33]);
        *(GAS u32x4*)(t.dst + (size_t)nn * t.ldk + 8 * c) = o; }
    LDS_WAIT(); asm volatile("" ::: "memory");
}
constexpr int I_IN = 32 * (NPAD / 32), I_PA = 16 * 64, I_WO = 32 * 64, I_W1 = 32 * 1024, I_W2 = 32 * 1024, I_QK = 8 * 8;
constexpr int NITEMS = I_IN + 2 * I_PA + I_WO + 2 * I_W1 + I_W2 + 2 * I_QK;
DI TrItem tr_decode(Frame& F, int it) {
    TrItem t; t.ok = true; int r = it;
    if (r < I_IN) { const int nb = r % (NPAD / 32), kb = r / (NPAD / 32); t.ok = 32 * nb < DIN; t.src = F.w_in() + (size_t)(64 * kb) * DIN + 32 * nb; t.ldn = DIN; t.dst = F.WIN() + (size_t)(32 * nb) * 2048 + 64 * kb; t.ldk = 2048; return t; } r -= I_IN;
    if (r < I_PA) { const int nb = r % 64, kb = r / 64; t.src = F.p_a() + (size_t)(64 * kb) * 2048 + 32 * nb; t.ldn = 2048; t.dst = F.PAB() + (size_t)(32 * nb) * 2048 + 64 * kb; t.ldk = 2048; return t; } r -= I_PA;
    if (r < I_PA) { const int nb = r % 64, kb = r / 64; t.src = F.p_b() + (size_t)(64 * kb) * 2048 + 32 * nb; t.ldn = 2048; t.dst = F.PAB() + (size_t)(32 * nb) * 2048 + 1024 + 64 * kb; t.ldk = 2048; return t; } r -= I_PA;
    if (r < I_WO) { const int nb = r % 64, kb = r / 64; t.src = F.w_o() + (size_t)(64 * kb) * 2048 + 32 * nb; t.ldn = 2048; t.dst = F.WO() + (size_t)(32 * nb) * 2048 + 64 * kb; t.ldk = 2048; return t; } r -= I_WO;
    if (r < I_W1) { const int e = r >> 10, rr = r & 1023, nb = rr & 31, kb = rr >> 5, n0 = 32 * nb;
        t.src = F.w1() + (size_t)e * 2048 * 1024 + (size_t)(64 * kb) * 1024 + n0; t.ldn = 1024; t.dst = F.W13() + (size_t)e * 2048 * 2048 + (size_t)(256 * (n0 >> 7) + (n0 & 127)) * 2048 + 64 * kb; t.ldk = 2048; return t; } r -= I_W1;
    if (r < I_W1) { const int e = r >> 10, rr = r & 1023, nb = rr & 31, kb = rr >> 5, n0 = 32 * nb;
        t.src = F.w3() + (size_t)e * 2048 * 1024 + (size_t)(64 * kb) * 1024 + n0; t.ldn = 1024; t.dst = F.W13() + (size_t)e * 2048 * 2048 + (size_t)(256 * (n0 >> 7) + 128 + (n0 & 127)) * 2048 + 64 * kb; t.ldk = 2048; return t; } r -= I_W1;
    if (r < I_W2) { const int e = r >> 10, rr = r & 1023, nb = rr & 63, kb = rr >> 6;
        t.src = F.w2() + (size_t)e * 1024 * 2048 + (size_t)(64 * kb) * 2048 + 32 * nb; t.ldn = 2048; t.dst = F.W2() + (size_t)e * 2048 * 1024 + (size_t)(32 * nb) * 1024 + 64 * kb; t.ldk = 1024; return t; } r -= I_W2;
    if (r < I_QK) { const int h = r >> 3, rr = r & 7, nb = rr & 3, kb = rr >> 2;
        t.src = F.w_q() + (size_t)h * 16384 + (size_t)(64 * kb) * 128 + 32 * nb; t.ldn = 128; t.dst = F.WQK() + (size_t)h * 32768 + (size_t)(32 * nb) * 128 + 64 * kb; t.ldk = 128; return t; } r -= I_QK;
    { const int h = r >> 3, rr = r & 7, nb = rr & 3, kb = rr >> 2;
        t.src = F.w_k() + (size_t)h * 16384 + (size_t)(64 * kb) * 128 + 32 * nb; t.ldn = 128; t.dst = F.WQK() + (size_t)h * 32768 + (size_t)(128 + 32 * nb) * 128 + 64 * kb; t.ldk = 128; return t; }
}
DI void p0_prologue(Frame& F) {
    for (int cb = F.bid; cb < 192; cb += F.G) p0_gemv(F, cb);
    LAS float* scr = (LAS float*)(F.lds + F.wave * 16384);
    const int gw = F.bid * 8 + F.wave, NGW = F.G * 8;
    if (gw < NITEMS) {
        TrItem cur = tr_decode(F, gw); f32x4 v[8]; tr_load(cur, v, F.lane);
#pragma unroll 1
        for (int it = gw; it < NITEMS; it += NGW) {
            const bool hn = it + NGW < NITEMS; TrItem nxt = cur; f32x4 vn[8];
            if (hn) { nxt = tr_decode(F, it + NGW); tr_load(nxt, vn, F.lane); }
            tr_store(cur, v, scr, F.lane);
            if (hn) {
#pragma unroll
                for (int i = 0; i < 8; ++i) v[i] = vn[i];
                cur = nxt; }
        }
    }
    const int gt = F.bid * 512 + F.tid, NGT = F.G * 512;
    for (int i = gt; i < 48 * 2048; i += NGT) { const int j = i >> 11, k = i & 2047; const float w = (j < 4) ? F.w_rg()[k * 4 + j] : (j < 36 ? F.w_re()[k * 32 + (j - 4)] : 0.f);
        const unsigned hi = f2bf(w); const unsigned lo = f2bf(w - __uint_as_float(hi << 16)); u16* wr = (u16*)F.WRT(); wr[i] = (u16)hi; wr[48 * 2048 + i] = (u16)lo; }
    for (int i = gt; i < 8 * 16384; i += NGT) F.WSB()[i] = (u16)f2bf(F.w_s()[i]);
}

DI void p1_rows(Frame& F) {
    const int gw = F.bid * 8 + F.wave, NGW = F.G * 8;
    for (int rr = gw; rr < TR; rr += 2 * NGW) {
        f32x4 v[2][8]; bool ok[2]; int rw[2];
#pragma unroll
        for (int q = 0; q < 2; ++q) { const int r = rr + q * NGW; ok[q] = r < TR; rw[q] = ok[q] ? r : rr;
            const float* src = rw[q] < T ? F.x() + (size_t)rw[q] * D : F.ctx() + (size_t)(rw[q] - T) * D; const GAS f32x4* xr = (const GAS f32x4*)src + F.lane;
#pragma unroll
            for (int j = 0; j < 8; ++j) v[q][j] = xr[64 * j]; }
#pragma unroll
        for (int q = 0; q < 2; ++q) { if (!ok[q]) continue;
            const float* mod = F.MOD() + (rw[q] < T ? 0 : 12288);
            float s = 0.f;
#pragma unroll
            for (int j = 0; j < 8; ++j) s += (v[q][j][0] + v[q][j][1]) + (v[q][j][2] + v[q][j][3]);
            const float mean = wave_sum(s) * (1.f / D); float s2 = 0.f;
#pragma unroll
            for (int j = 0; j < 8; ++j) { v[q][j] = v[q][j] - mean; s2 += (v[q][j][0] * v[q][j][0] + v[q][j][1] * v[q][j][1]) + (v[q][j][2] * v[q][j][2] + v[q][j][3] * v[q][j][3]); }
            const float rstd = 1.f / sqrtf(wave_sum(s2) * (1.f / D) + LN_EPS);
            GAS u32x2* o = (GAS u32x2*)(F.U() + (size_t)rw[q] * D) + F.lane;
#pragma unroll
            for (int j = 0; j < 8; ++j) { const f32x4 sh = *(const f32x4*)(mod + 4 * F.lane + 256 * j), sc = *(const f32x4*)(mod + 2048 + 4 * F.lane + 256 * j);
                o[64 * j] = pack4(v[q][j] * rstd * (sc + 1.f) + sh); } }
    }
}

template <int NT, class PA, class PB>
DI void wave_mm128(f32x4 (&acc)[NT], PA A, int lda, PB B, int ldb, int lane) {
    const int fr = lane & 15, fq = lane >> 4;
    bf16x8 a[4];
#pragma unroll
    for (int ks = 0; ks < 4; ++ks) a[ks] = ld8(A + fr * lda + 32 * ks + 8 * fq);
#pragma unroll
    for (int kp = 0; kp < 2; ++kp) {
        bf16x8 b[2][NT];
#pragma unroll
        for (int kk = 0; kk < 2; ++kk)
#pragma unroll
            for (int t = 0; t < NT; ++t) b[kk][t] = ld8(B + (16 * t + fr) * ldb + 32 * (2 * kp + kk) + 8 * fq);
#pragma unroll
        for (int kk = 0; kk < 2; ++kk)
#pragma unroll
            for (int t = 0; t < NT; ++t) acc[t] = __builtin_amdgcn_mfma_f32_16x16x32_bf16(b[kk][t], a[2 * kp + kk], acc[t], 0, 0, 0);
        __builtin_amdgcn_sched_barrier(0);
    }
}
template <int NT, class PB>
DI void wave_mm128_areg(f32x4 (&acc)[NT], const bf16x8 (&a)[4], PB B, int ldb, int lane) {
    const int fr = lane & 15, fq = lane >> 4;
#pragma unroll
    for (int kp = 0; kp < 2; ++kp) {
        bf16x8 b[2][NT];
#pragma unroll
        for (int kk = 0; kk < 2; ++kk)
#pragma unroll
            for (int t = 0; t < NT; ++t) b[kk][t] = ld8(B + (16 * t + fr) * ldb + 32 * (2 * kp + kk) + 8 * fq);
#pragma unroll
        for (int kk = 0; kk < 2; ++kk)
#pragma unroll
            for (int t = 0; t < NT; ++t) acc[t] = __builtin_amdgcn_mfma_f32_16x16x32_bf16(b[kk][t], a[2 * kp + kk], acc[t], 0, 0, 0);
        __builtin_amdgcn_sched_barrier(0);
    }
}
DI float wave_incl_scan(float v, int lane) {
#pragma unroll
    for (int o = 1; o < 64; o <<= 1) { const float t = __shfl_up(v, o); v = (lane >= o) ? v + t : v; }
    return v;
}
DI float fexp(float x) { return __builtin_amdgcn_exp2f(x * 1.4426950408889634f); }

DI void gmlp_unit(Frame& F, int c, int g, int& cur_g) {
    LAS float* MU = (LAS float*)(F.lds + 140288); LAS float* RS = MU + 128;
    LAS u16* VNT = (LAS u16*)F.lds;
    LAS u16* WSs = (LAS u16*)(F.lds + 34816);
    if (g != cur_g) { cur_g = g;
#pragma unroll
        for (int i = 0; i < 4; ++i) { const int idx = F.tid + 512 * i; *(LAS u32x4*)(WSs + (idx >> 4) * 136 + 8 * (idx & 15)) = *(const GAS u32x4*)(F.WSB() + g * 16384 + (idx >> 4) * 128 + 8 * (idx & 15)); } }
    const int r0 = 128 * c, fr = F.lane & 15, fq = F.lane >> 4;
    if (F.tid < 128) {
        const GAS f32x4* sp = (const GAS f32x4*)((const float*)(F.ws + WS_STATP) + (size_t)(r0 + F.tid) * 32); float sa = 0.f, qa = 0.f;
#pragma unroll
        for (int i = 0; i < 8; ++i) { const f32x4 v = sp[i]; sa += v[0] + v[2]; qa += v[1] + v[3]; }
        const float mean = sa * (1.f / 1024.f), var = fmaxf(qa * (1.f / 1024.f) - mean * mean, 0.f);
        MU[F.tid] = mean; RS[F.tid] = 1.f / sqrtf(var + LN_EPS); }
    __syncthreads();
    {
        const int c8 = F.tid & 15;
        u32x4 vq[4];
#pragma unroll
        for (int i = 0; i < 4; ++i) vq[i] = *(const GAS u32x4*)(F.PROJ() + (size_t)(r0 + ((F.tid + 512 * i) >> 4)) * NPJ + OFF_VA + 128 * g + 8 * c8);
        const f32x4 g0 = *(const f32x4*)(F.sgu_g() + 128 * g + 8 * c8), g1 = *(const f32x4*)(F.sgu_g() + 128 * g + 8 * c8 + 4), b0 = *(const f32x4*)(F.sgu_b() + 128 * g + 8 * c8), b1 = *(const f32x4*)(F.sgu_b() + 128 * g + 8 * c8 + 4);
        const float gg[8] = {g0[0], g0[1], g0[2], g0[3], g1[0], g1[1], g1[2], g1[3]}, bb[8] = {b0[0], b0[1], b0[2], b0[3], b1[0], b1[1], b1[2], b1[3]};
#pragma unroll
        for (int i = 0; i < 4; ++i) { const int p = (F.tid + 512 * i) >> 4; const u32x4 v = vq[i]; const float mu = MU[p], rs = RS[p];
            const float x[8] = {bflo(v.x), bfhi(v.x), bflo(v.y), bfhi(v.y), bflo(v.z), bfhi(v.z), bflo(v.w), bfhi(v.w)};
#pragma unroll
            for (int j = 0; j < 8; ++j) VNT[(8 * c8 + j) * 136 + p] = (u16)f2bf((x[j] - mu) * rs * gg[j] + bb[j]); }
    }
    __syncthreads();
    const int q = 16 * F.wave + fr; const float bsq = F.b_s()[g * 128 + q];
    u32x2 uaq[8];
#pragma unroll
    for (int t = 0; t < 8; ++t) uaq[t] = *(const GAS u32x2*)(F.PROJ() + (size_t)(r0 + q) * NPJ + OFF_UA + 128 * g + 16 * t + 4 * fq);
    f32x4 acc[8]; zero_acc<8>(acc);
    wave_mm128<8>(acc, (const LAS u16*)(WSs + 16 * F.wave * 136), 136, (const LAS u16*)VNT, 136, F.lane);
#pragma unroll
    for (int t = 0; t < 8; ++t) *(GAS u32x2*)(F.AB() + (size_t)(r0 + q) * 2048 + 128 * g + 16 * t + 4 * fq) = pack4(unpack4(uaq[t]) * (acc[t] + bsq));
    __syncthreads();
}

DI void mprep_unit(Frame& F, int c, int h, int& cur_h) {
    const int r0 = (c < 2) ? T + 128 * c : 128 * (c - 2);
    const int seq_lo = (c < 2) ? T : 0, seq_hi = (c < 2) ? TR - 1 : T - 1;
    LAS u16* XCs = (LAS u16*)F.lds;
    LAS u16* KT = (LAS u16*)(F.lds + 34816);
    LAS u16* WQs = (LAS u16*)(F.lds + 2 * 34816);
    LAS float* GS = (LAS float*)(F.lds + 4 * 34816);
    const int fr = F.lane & 15, fq = F.lane >> 4;
    if (h != cur_h) { cur_h = h;
#pragma unroll
        for (int i = 0; i < 8; ++i) { const int idx = F.tid + 512 * i; *(LAS u32x4*)(WQs + (idx >> 4) * 136 + 8 * (idx & 15)) = *(const GAS u32x4*)(F.WQK() + (size_t)h * 32768 + (idx >> 4) * 128 + 8 * (idx & 15)); } }
    u32x4 vtq[4];
#pragma unroll
    for (int i = 0; i < 4; ++i) { const int idx = F.tid + 512 * i; vtq[i] = *(const GAS u32x4*)(F.PROJ() + (size_t)(r0 + (idx >> 4)) * NPJ + OFF_VB + 128 * h + 8 * (idx & 15)); }
    if (F.wave < 2) {
        const int dir = F.wave; const int s0 = dir ? 127 - 2 * F.lane : 2 * F.lane, s1 = dir ? 126 - 2 * F.lane : 2 * F.lane + 1;
        const float* g0 = F.GATES() + (size_t)(r0 + s0) * 32 + 16 * dir + h; const float* g1 = F.GATES() + (size_t)(r0 + s1) * 32 + 16 * dir + h;
        const float li0 = g0[0], lf0 = logsig(g0[8]), li1 = g1[0], lf1 = logsig(g1[8]);
        const float incl = wave_incl_scan(lf0 + lf1, F.lane);
        const float b1 = incl, b0 = incl - lf1;
        const float bs = __shfl(incl, 63);
        const float l0 = bs - b0 + li0, l1 = bs - b1 + li1;
        const float ml = wave_max(fmaxf(l0, l1));
        GS[128 * dir + s0] = expf(l0 - ml); GS[128 * dir + s1] = expf(l1 - ml);
        if (F.lane == 0) { float* sc = F.SC() + (size_t)((dir * 8 + h) * NCH + c) * 4; sc[0] = ml; sc[1] = bs; }
        float* gb0 = F.GB() + ((size_t)h * TR + r0 + s0) * 4 + 2 * dir; float* gb1 = F.GB() + ((size_t)h * TR + r0 + s1) * 4 + 2 * dir;
        *(f32x2*)gb0 = (f32x2){li0, b0}; *(f32x2*)gb1 = (f32x2){li1, b1};
    }
    const int cch = 128 * h + 8 * (F.tid & 15);
    f32x4 cw0[2], cw1[2], cw2[2], cbb[2];
#pragma unroll
    for (int hh = 0; hh < 2; ++hh) { cw0[hh] = *(const f32x4*)(F.conv_w() + cch + 4 * hh); cw1[hh] = *(const f32x4*)(F.conv_w() + 1024 + cch + 4 * hh); cw2[hh] = *(const f32x4*)(F.conv_w() + 2048 + cch + 4 * hh); cbb[hh] = *(const f32x4*)(F.conv_b() + cch + 4 * hh); }
    u32x4 xmq[4], xpq[4], xnq[4];
#pragma unroll
    for (int i = 0; i < 4; ++i) { const int row = r0 + ((F.tid + 512 * i) >> 4); const GAS u16* p = (const GAS u16*)(F.PROJ() + (size_t)row * NPJ + OFF_XM + cch); const u32x4 z4 = (u32x4){0u, 0u, 0u, 0u};
        xmq[i] = *(const GAS u32x4*)p; xpq[i] = (row > seq_lo) ? *(const GAS u32x4*)(p - NPJ) : z4; xnq[i] = (row < seq_hi) ? *(const GAS u32x4*)(p + NPJ) : z4; }
#pragma unroll
    for (int i = 0; i < 4; ++i) { const int idx = F.tid + 512 * i, s = idx >> 4, c8 = idx & 15, row = r0 + s, ch = 128 * h + 8 * c8;
        const u32x4 xm = xmq[i], xp = xpq[i], xn = xnq[i];
        float y[8];
#pragma unroll
        for (int hh = 0; hh < 2; ++hh) { const f32x4 w0 = cw0[hh], w1 = cw1[hh], w2 = cw2[hh], cb = cbb[hh];
            const unsigned a0 = hh ? xp.z : xp.x, a1 = hh ? xp.w : xp.y, m0 = hh ? xm.z : xm.x, m1 = hh ? xm.w : xm.y, n0 = hh ? xn.z : xn.x, n1 = hh ? xn.w : xn.y;
            y[4 * hh + 0] = w0[0] * bflo(a0) + w1[0] * bflo(m0) + w2[0] * bflo(n0) + cb[0];
            y[4 * hh + 1] = w0[1] * bfhi(a0) + w1[1] * bfhi(m0) + w2[1] * bfhi(n0) + cb[1];
            y[4 * hh + 2] = w0[2] * bflo(a1) + w1[2] * bflo(m1) + w2[2] * bflo(n1) + cb[2];
            y[4 * hh + 3] = w0[3] * bfhi(a1) + w1[3] * bfhi(m1) + w2[3] * bfhi(n1) + cb[3]; }
#pragma unroll
        for (int j = 0; j < 8; ++j) y[j] = y[j] * sigmoid_fast(y[j]);
        u32x4 o; o.x = cvt_pk_bf16(y[0], y[1]); o.y = cvt_pk_bf16(y[2], y[3]); o.z = cvt_pk_bf16(y[4], y[5]); o.w = cvt_pk_bf16(y[6], y[7]);
        *(LAS u32x4*)(XCs + s * 136 + 8 * c8) = o; *(GAS u32x4*)(F.XC() + (size_t)row * 1024 + ch) = o; }
    __syncthreads();
    {
        f32x4 aq[8]; zero_acc<8>(aq);
        wave_mm128<8>(aq, (const LAS u16*)(XCs + 16 * F.wave * 136), 136, (const LAS u16*)WQs, 136, F.lane);
        const int s = 16 * F.wave + fr;
#pragma unroll
        for (int t = 0; t < 8; ++t) *(GAS u32x2*)(F.Q() + (size_t)(r0 + s) * 1024 + 128 * h + 16 * t + 4 * fq) = pack4(aq[t]);
        zero_acc<8>(aq);
        wave_mm128<8>(aq, (const LAS u16*)(XCs + 16 * F.wave * 136), 136, (const LAS u16*)(WQs + 128 * 136), 136, F.lane);
#pragma unroll
        for (int t = 0; t < 8; ++t) *(GAS u32x2*)(F.K() + (size_t)(r0 + s) * 1024 + 128 * h + 16 * t + 4 * fq) = pack4(aq[t] * 0.08838834764831845f);
        zero_acc<8>(aq);
        wave_mm128<8>(aq, (const LAS u16*)(WQs + (128 + 16 * F.wave) * 136), 136, (const LAS u16*)XCs, 136, F.lane);
        const int d = 16 * F.wave + fr;
#pragma unroll
        for (int t = 0; t < 8; ++t) *(LAS u32x2*)(KT + d * 136 + 16 * t + 4 * fq) = pack4(aq[t] * 0.08838834764831845f);
    }
    __syncthreads();
#pragma unroll
    for (int i = 0; i < 4; ++i) { const int idx = F.tid + 512 * i, s = idx >> 4, c8 = idx & 15;
        const unsigned w[4] = {vtq[i].x, vtq[i].y, vtq[i].z, vtq[i].w};
#pragma unroll
        for (int j = 0; j < 4; ++j) { XCs[(8 * c8 + 2 * j) * 136 + s] = (u16)(w[j] & 0xffffu); XCs[(8 * c8 + 2 * j + 1) * 136 + s] = (u16)(w[j] >> 16); } }
    __syncthreads();
#pragma unroll
    for (int dir = 0; dir < 2; ++dir) {
        f32x4 cf[8]; zero_acc<8>(cf);
#pragma unroll
        for (int ks = 0; ks < 4; ++ks) {
            const u32x4 av = *(const LAS u32x4*)(XCs + (16 * F.wave + fr) * 136 + 32 * ks + 8 * fq);
            const f32x4 w0 = *(const LAS f32x4*)(GS + 128 * dir + 32 * ks + 8 * fq), w1 = *(const LAS f32x4*)(GS + 128 * dir + 32 * ks + 8 * fq + 4);
            u32x4 sv; sv.x = cvt_pk_bf16(bflo(av.x) * w0[0], bfhi(av.x) * w0[1]); sv.y = cvt_pk_bf16(bflo(av.y) * w0[2], bfhi(av.y) * w0[3]);
            sv.z = cvt_pk_bf16(bflo(av.z) * w1[0], bfhi(av.z) * w1[1]); sv.w = cvt_pk_bf16(bflo(av.w) * w1[2], bfhi(av.w) * w1[3]);
            const bf16x8 a = __builtin_bit_cast(bf16x8, sv);
#pragma unroll
            for (int t = 0; t < 8; ++t) { const bf16x8 b = ld8((const LAS u16*)(KT + (16 * t + fr) * 136 + 32 * ks + 8 * fq)); cf[t] = __builtin_amdgcn_mfma_f32_16x16x32_bf16(b, a, cf[t], 0, 0, 0); }
        }
        u16* st = F.ST() + ((size_t)((dir * 8 + h) * NCH + c) * 16384) + (16 * F.wave + fr) * 128;
#pragma unroll
        for (int t = 0; t < 8; ++t) *(GAS u32x2*)(st + 16 * t + 4 * fq) = pack4(cf[t]);
    }
    if (F.tid < 256) { const int dir = F.tid >> 7, d = F.tid & 127; const LAS u16* kt = KT + d * 136; const LAS float* w = GS + 128 * dir; float s = 0.f;
#pragma unroll
        for (int i = 0; i < 16; ++i) { const u32x4 v = *(const LAS u32x4*)(kt + 8 * i); const f32x4 w0 = *(const LAS f32x4*)(w + 8 * i), w1 = *(const LAS f32x4*)(w + 8 * i + 4);
            s += ((bflo(v.x) * w0[0] + bfhi(v.x) * w0[1]) + (bflo(v.y) * w0[2] + bfhi(v.y) * w0[3])) + ((bflo(v.z) * w1[0] + bfhi(v.z) * w1[1]) + (bflo(v.w) * w1[2] + bfhi(v.w) * w1[3])); }
        F.NL()[(size_t)((dir * 8 + h) * NCH + c) * 128 + d] = s; }
    __syncthreads();
}

DI int scan_order(int dir, int j) { return dir == 0 ? j : (j == 0 ? 1 : (j == 1 ? 0 : 131 - j)); }
DI void scan_item(Frame& F, int dh, int blk) {
    const int dir = dh >> 3;
    LAS float* ML = (LAS float*)F.lds; LAS float* BS = ML + 136; LAS float* DEC = ML + 272; LAS float* SCL = ML + 408; LAS float* MB = ML + 544;
    if (F.tid < NCH) { const int cj = scan_order(dir, F.tid); const float* sc = F.SC() + (size_t)(dh * NCH + cj) * 4; ML[F.tid] = sc[0]; BS[F.tid] = sc[1]; }
    __syncthreads();
    if (F.tid == 0) { float m = NEGF; for (int j = 0; j < NCH; ++j) { MB[j] = m; const float mn = fmaxf(BS[j] + m, ML[j]); DEC[j] = fexp(BS[j] + m - mn); SCL[j] = fexp(ML[j] - mn); m = mn; } }
    __syncthreads();
    GAS unsigned* base = (GAS unsigned*)(F.ST() + (size_t)dh * NCH * 16384) + blk * 512 + F.tid;
    float c0 = 0.f, c1 = 0.f;
#pragma unroll 1
    for (int j0 = 0; j0 < NCH; j0 += 26) {
        unsigned kv[26];
#pragma unroll
        for (int jj = 0; jj < 26; ++jj) kv[jj] = base[(size_t)scan_order(dir, j0 + jj) * 8192];
#pragma unroll
        for (int jj = 0; jj < 26; ++jj) { base[(size_t)scan_order(dir, j0 + jj) * 8192] = cvt_pk_bf16(c0, c1);
            const float de = DEC[j0 + jj], sc = SCL[j0 + jj]; c0 = de * c0 + sc * bflo(kv[jj]); c1 = de * c1 + sc * bfhi(kv[jj]); }
    }
    if (blk == 0) {
        if (F.tid < 128) { float n = 0.f; GAS float* nl = (GAS float*)(F.NL() + (size_t)dh * NCH * 128 + F.tid);
#pragma unroll 1
            for (int j0 = 0; j0 < NCH; j0 += 26) { float nv[26];
#pragma unroll
                for (int jj = 0; jj < 26; ++jj) nv[jj] = nl[scan_order(dir, j0 + jj) * 128];
#pragma unroll
                for (int jj = 0; jj < 26; ++jj) { nl[scan_order(dir, j0 + jj) * 128] = n; n = DEC[j0 + jj] * n + SCL[j0 + jj] * nv[jj]; } } }
        if (F.tid >= 256 && F.tid < 256 + NCH) { const int j = F.tid - 256; F.SC()[(size_t)(dh * NCH + scan_order(dir, j)) * 4 + 2] = MB[j]; }
    }
    __syncthreads();
}

DI void x3_unit(Frame& F, int lc, int h) {
    const int c = lc + 2, r0 = 128 * lc, fr = F.lane & 15, fq = F.lane >> 4;
    LAS u16* VT = (LAS u16*)F.lds;
    LAS u16* KS = (LAS u16*)(F.lds + 34816);
    LAS u16* PW = KS + F.wave * 16 * 136;
    LAS u16* SF = (LAS u16*)(F.lds + 2 * 34816);
    LAS u16* SB = (LAS u16*)(F.lds + 3 * 34816);
    LAS float* GS = (LAS float*)(F.lds + 4 * 34816);
    const int ql = 16 * F.wave + fr;
    bf16x8 qa[4];
#pragma unroll
    for (int ks = 0; ks < 4; ++ks) qa[ks] = ld8((const GAS u16*)(F.Q() + (size_t)(r0 + ql) * 1024 + 128 * h + 32 * ks + 8 * fq));
    if (F.tid < 128) { const f32x4 g = *(const GAS f32x4*)(F.GB() + ((size_t)h * TR + r0 + F.tid) * 4); GS[F.tid] = g[0]; GS[128 + F.tid] = g[1]; GS[256 + F.tid] = g[2]; GS[384 + F.tid] = g[3]; }
    else if (F.tid < 384) { const int i = F.tid - 128, dir = i >> 7, d = i & 127; GS[512 + i] = F.NL()[(size_t)((dir * 8 + h) * NCH + c) * 128 + d]; }
    const float mf = F.SC()[(size_t)(h * NCH + c) * 4 + 2], mb = F.SC()[(size_t)((8 + h) * NCH + c) * 4 + 2];
    {
        u32x4 vv[4], s0[4], s1[4], kq[4];
        const GAS u16* stf = (const GAS u16*)(F.ST() + (size_t)(h * NCH + c) * 16384); const GAS u16* stb = (const GAS u16*)(F.ST() + (size_t)((8 + h) * NCH + c) * 16384);
#pragma unroll
        for (int i = 0; i < 4; ++i) { const int idx = F.tid + 512 * i, s = idx >> 4, c8 = idx & 15;
            vv[i] = *(const GAS u32x4*)(F.PROJ() + (size_t)(r0 + s) * NPJ + OFF_VB + 128 * h + 8 * c8); s0[i] = *(const GAS u32x4*)(stf + s * 128 + 8 * c8); s1[i] = *(const GAS u32x4*)(stb + s * 128 + 8 * c8);
            kq[i] = *(const GAS u32x4*)(F.K() + (size_t)(r0 + s) * 1024 + 128 * h + 8 * c8); }
#pragma unroll
        for (int i = 0; i < 4; ++i) { const int idx = F.tid + 512 * i, s = idx >> 4, c8 = idx & 15;
            *(LAS u32x4*)(SF + s * 136 + 8 * c8) = s0[i]; *(LAS u32x4*)(SB + s * 136 + 8 * c8) = s1[i]; *(LAS u32x4*)(KS + s * 136 + 8 * c8) = kq[i];
            const unsigned w[4] = {vv[i].x, vv[i].y, vv[i].z, vv[i].w};
#pragma unroll
            for (int j = 0; j < 4; ++j) { VT[(8 * c8 + 2 * j) * 136 + s] = (u16)(w[j] & 0xffffu); VT[(8 * c8 + 2 * j + 1) * 136 + s] = (u16)(w[j] >> 16); } }
    }
    __syncthreads();
    f32x4 sf[8], sb[8]; zero_acc<8>(sf);
    wave_mm128_areg<8>(sf, qa, (const LAS u16*)KS, 136, F.lane);
    __syncthreads();
    const float bqf = GS[128 + ql], bqb = GS[384 + ql];
    float mxf = -3.0e38f, mxb = -3.0e38f;
#pragma unroll
    for (int t = 0; t < 8; ++t)
#pragma unroll
        for (int r = 0; r < 4; ++r) { const int s = 16 * t + 4 * fq + r; const float df = bqf - GS[128 + s] + GS[s], db = bqb - GS[384 + s] + GS[256 + s];
            mxf = (s <= ql) ? fmaxf(mxf, df) : mxf; mxb = (s >= ql) ? fmaxf(mxb, db) : mxb; }
    mxf = fmaxf(mxf, __shfl_xor(mxf, 16)); mxf = fmaxf(mxf, __shfl_xor(mxf, 32)); mxb = fmaxf(mxb, __shfl_xor(mxb, 16)); mxb = fmaxf(mxb, __shfl_xor(mxb, 32));
    const float mrf = fmaxf(bqf + mf, mxf), mrb = fmaxf(bqb + mb, mxb);
    float rsf = 0.f, rsb = 0.f;
#pragma unroll
    for (int t = 0; t < 8; ++t)
#pragma unroll
        for (int r = 0; r < 4; ++r) { const int s = 16 * t + 4 * fq + r; const float df = bqf - GS[128 + s] + GS[s], db = bqb - GS[384 + s] + GS[256 + s];
            const float ef = (s <= ql) ? fexp(df - mrf) : 0.f, eb = (s >= ql) ? fexp(db - mrb) : 0.f; const float s0 = sf[t][r];
            sf[t][r] = s0 * ef; sb[t][r] = s0 * eb; rsf += sf[t][r]; rsb += sb[t][r]; }
    rsf += __shfl_xor(rsf, 16); rsf += __shfl_xor(rsf, 32); rsb += __shfl_xor(rsb, 16); rsb += __shfl_xor(rsb, 32);
    float qnf = 0.f, qnb = 0.f;
#pragma unroll
    for (int i = 0; i < 4; ++i) { const u32x4 qv = __builtin_bit_cast(u32x4, qa[i]); const int d0 = 32 * i + 8 * fq;
        const float qq[8] = {bflo(qv.x), bfhi(qv.x), bflo(qv.y), bfhi(qv.y), bflo(qv.z), bfhi(qv.z), bflo(qv.w), bfhi(qv.w)};
#pragma unroll
        for (int j = 0; j < 8; ++j) { qnf += qq[j] * GS[512 + d0 + j]; qnb += qq[j] * GS[640 + d0 + j]; } }
    qnf += __shfl_xor(qnf, 16); qnf += __shfl_xor(qnf, 32); qnb += __shfl_xor(qnb, 16); qnb += __shfl_xor(qnb, 32);
    const float af = fexp(bqf + mf - mrf), ab = fexp(bqb + mb - mrb);
    const float dnf = fmaxf(fabsf(af * qnf + rsf), fexp(-mrf)), dnb = fmaxf(fabsf(ab * qnb + rsb), fexp(-mrb));
    const float ivf = 1.f / dnf, ivb = 1.f / dnb, rf = af * ivf, rb = ab * ivb;
#pragma unroll
    for (int t = 0; t < 8; ++t) *(LAS u32x2*)(PW + fr * 136 + 16 * t + 4 * fq) = pack4(sf[t] * ivf + sb[t] * ivb);
    LDS_WAIT(); asm volatile("" ::: "memory");
    f32x4 hv[8]; zero_acc<8>(hv);
    wave_mm<8>(hv, (const LAS u16*)PW, 136, (const LAS u16*)VT, 136, 128, F.lane);
    zero_acc<8>(sf);
    wave_mm128_areg<8>(sf, qa, (const LAS u16*)SF, 136, F.lane);
#pragma unroll
    for (int t = 0; t < 8; ++t) hv[t] += sf[t] * rf;
    zero_acc<8>(sb);
    wave_mm128_areg<8>(sb, qa, (const LAS u16*)SB, 136, F.lane);
    float s1 = 0.f;
#pragma unroll
    for (int t = 0; t < 8; ++t) { hv[t] += sb[t] * rb; s1 += (hv[t][0] + hv[t][1]) + (hv[t][2] + hv[t][3]); }
    s1 += __shfl_xor(s1, 16); s1 += __shfl_xor(s1, 32);
    const float mean = s1 * (1.f / 128.f); float s2 = 0.f;
#pragma unroll
    for (int t = 0; t < 8; ++t) { hv[t] = hv[t] - mean; s2 += (hv[t][0] * hv[t][0] + hv[t][1] * hv[t][1]) + (hv[t][2] * hv[t][2] + hv[t][3] * hv[t][3]); }
    s2 += __shfl_xor(s2, 16); s2 += __shfl_xor(s2, 32);
    const float rstd = 1.f / sqrtf(s2 * (1.f / 128.f) + LN_EPS);
    const size_t row = (size_t)(r0 + ql);
#pragma unroll
    for (int hb = 0; hb < 2; ++hb) {
        f32x4 mg[4], sk[4]; u32x2 xcq[4], soq[4];
#pragma unroll
        for (int tt = 0; tt < 4; ++tt) { const int e0 = 128 * h + 16 * (4 * hb + tt) + 4 * fq;
            mg[tt] = *(const f32x4*)(F.mh_g() + e0); sk[tt] = *(const f32x4*)(F.skip() + e0); xcq[tt] = *(const GAS u32x2*)(F.XC() + row * 1024 + e0); soq[tt] = *(const GAS u32x2*)(F.PROJ() + row * NPJ + OFF_OB + e0); }
#pragma unroll
        for (int tt = 0; tt < 4; ++tt) { const int e0 = 128 * h + 16 * (4 * hb + tt) + 4 * fq;
            *(GAS u32x2*)(F.AB() + row * 2048 + 1024 + e0) = pack4(unpack4(soq[tt]) * (hv[4 * hb + tt] * rstd * mg[tt] + sk[tt] * unpack4(xcq[tt]))); }
    }
    __syncthreads();
}

DI void p8_rows(Frame& F) {
    LAS int* HC = (LAS int*)F.lds; LAS int* HB = HC + 32;
    LAS float* ST2 = (LAS float*)(F.lds + 256);
    LAS float* SCP = (LAS float*)(F.lds + 1024);
    LAS float* SHP = SCP + 2048;
    LAS float* LGP = SHP + 2048;
    const float* mod = F.MOD();
    const int fr = F.lane & 15, fq = F.lane >> 4;
    for (int i = F.tid; i < 2048; i += 512) { SCP[i] = 1.f + mod[4 * 2048 + i]; SHP[i] = mod[3 * 2048 + i]; }
    const u16* WRH = (const u16*)F.WRT(); const u16* WRL = WRH + 48 * 2048;
    for (int rb = F.bid; rb < T / 64; rb += F.G) {
        if (F.tid < 32) HC[F.tid] = 0;
#pragma unroll 1
        for (int ih = 0; ih < 8; ih += 4) {
            u32x2 raw[4][8];
#pragma unroll
            for (int q = 0; q < 4; ++q) { const GAS u32x2* xr = (const GAS u32x2*)(F.X1() + (size_t)(64 * rb + 8 * F.wave + ih + q) * D) + F.lane;
#pragma unroll
                for (int j = 0; j < 8; ++j) raw[q][j] = xr[64 * j]; }
#pragma unroll
            for (int q = 0; q < 4; ++q) {
                const int rl = 8 * F.wave + ih + q, r = 64 * rb + rl;
                GAS u32x2* xr = (GAS u32x2*)(F.X1() + (size_t)r * D) + F.lane;
                f32x4 v[8]; float s = 0.f;
#pragma unroll
                for (int j = 0; j < 8; ++j) { v[j] = unpack4(raw[q][j]); s += (v[j][0] + v[j][1]) + (v[j][2] + v[j][3]); }
                float mean = wave_sum(s) * (1.f / D), s2 = 0.f;
#pragma unroll
                for (int j = 0; j < 8; ++j) { v[j] = v[j] - mean; s2 += (v[j][0] * v[j][0] + v[j][1] * v[j][1]) + (v[j][2] * v[j][2] + v[j][3] * v[j][3]); }
                float rstd = 1.f / sqrtf(wave_sum(s2) * (1.f / D) + LN_EPS);
                s = 0.f;
#pragma unroll
                for (int j = 0; j < 8; ++j) { const f32x4 g = *(const f32x4*)(F.ln1_g() + 4 * F.lane + 256 * j), b = *(const f32x4*)(F.ln1_b() + 4 * F.lane + 256 * j);
                    const u32x2 pk = pack4(v[j] * rstd * g + b); xr[64 * j] = pk; v[j] = unpack4(pk); s += (v[j][0] + v[j][1]) + (v[j][2] + v[j][3]); }
                mean = wave_sum(s) * (1.f / D); s2 = 0.f;
#pragma unroll
                for (int j = 0; j < 8; ++j) { const f32x4 d = v[j] - mean; s2 += (d[0] * d[0] + d[1] * d[1]) + (d[2] * d[2] + d[3] * d[3]); }
                rstd = 1.f / sqrtf(wave_sum(s2) * (1.f / D) + LN_EPS);
                if (F.lane == 0) { ST2[2 * rl] = mean; ST2[2 * rl + 1] = rstd; }
            }
        }
        asm volatile("s_waitcnt vmcnt(0)" ::: "memory");
        __syncthreads();
        {
            float mean2[4], rstd2[4];
#pragma unroll
            for (int t4 = 0; t4 < 4; ++t4) { mean2[t4] = ST2[2 * (16 * t4 + fr)]; rstd2[t4] = ST2[2 * (16 * t4 + fr) + 1]; }
            f32x4 acc[4][3];
#pragma unroll
            for (int t4 = 0; t4 < 4; ++t4) zero_acc<3>(acc[t4]);
#pragma unroll 2
            for (int ks = 0; ks < 8; ++ks) {
                const int k = 256 * F.wave + 32 * ks + 8 * fq;
                bf16x8 bh[3], bl[3]; u32x4 ax[4];
#pragma unroll
                for (int t = 0; t < 3; ++t) { bh[t] = ld8((const GAS u16*)(WRH + (16 * t + fr) * 2048 + k)); bl[t] = ld8((const GAS u16*)(WRL + (16 * t + fr) * 2048 + k)); }
#pragma unroll
                for (int t4 = 0; t4 < 4; ++t4) ax[t4] = *(const GAS u32x4*)(F.X1() + (size_t)(64 * rb + 16 * t4 + fr) * D + k);
                const f32x4 sc0 = *(const LAS f32x4*)(SCP + k), sc1 = *(const LAS f32x4*)(SCP + k + 4), sh0 = *(const LAS f32x4*)(SHP + k), sh1 = *(const LAS f32x4*)(SHP + k + 4);
#pragma unroll
                for (int t4 = 0; t4 < 4; ++t4) {
                    const f32x4 a0 = (f32x4){bflo(ax[t4].x), bfhi(ax[t4].x), bflo(ax[t4].y), bfhi(ax[t4].y)}, a1 = (f32x4){bflo(ax[t4].z), bfhi(ax[t4].z), bflo(ax[t4].w), bfhi(ax[t4].w)};
                    const f32x4 u0 = (a0 - mean2[t4]) * rstd2[t4] * sc0 + sh0, u1 = (a1 - mean2[t4]) * rstd2[t4] * sc1 + sh1;
                    u32x4 hi; hi.x = cvt_pk_bf16(u0[0], u0[1]); hi.y = cvt_pk_bf16(u0[2], u0[3]); hi.z = cvt_pk_bf16(u1[0], u1[1]); hi.w = cvt_pk_bf16(u1[2], u1[3]);
                    u32x4 lo; lo.x = cvt_pk_bf16(u0[0] - bflo(hi.x), u0[1] - bfhi(hi.x)); lo.y = cvt_pk_bf16(u0[2] - bflo(hi.y), u0[3] - bfhi(hi.y));
                    lo.z = cvt_pk_bf16(u1[0] - bflo(hi.z), u1[1] - bfhi(hi.z)); lo.w = cvt_pk_bf16(u1[2] - bflo(hi.w), u1[3] - bfhi(hi.w));
                    *(GAS u32x4*)(F.U2() + (size_t)(64 * rb + 16 * t4 + fr) * D + k) = hi;
                    const bf16x8 ah = __builtin_bit_cast(bf16x8, hi), al = __builtin_bit_cast(bf16x8, lo);
#pragma unroll
                    for (int t = 0; t < 3; ++t) {
                        acc[t4][t] = __builtin_amdgcn_mfma_f32_16x16x32_bf16(bh[t], ah, acc[t4][t], 0, 0, 0);
                        acc[t4][t] = __builtin_amdgcn_mfma_f32_16x16x32_bf16(bh[t], al, acc[t4][t], 0, 0, 0);
                        acc[t4][t] = __builtin_amdgcn_mfma_f32_16x16x32_bf16(bl[t], ah, acc[t4][t], 0, 0, 0); }
                }
            }
#pragma unroll
            for (int t4 = 0; t4 < 4; ++t4)
#pragma unroll
                for (int t = 0; t < 3; ++t) *(LAS f32x4*)(LGP + (F.wave * 64 + 16 * t4 + fr) * 48 + 16 * t + 4 * fq) = acc[t4][t];
        }
        __syncthreads();
        if (F.tid < 64) {
            const int rl = F.tid, r = 64 * rb + rl; const LAS float* l0 = LGP + rl * 48;
            float gl[4];
#pragma unroll
            for (int g = 0; g < 4; ++g) { float a = F.b_rg()[g];
#pragma unroll
                for (int w = 0; w < 8; ++w) a += l0[w * 64 * 48 + g];
                gl[g] = a; }
            int gs = 0; float gm = gl[0];
#pragma unroll
            for (int g = 1; g < 4; ++g) if (gl[g] > gm) { gm = gl[g]; gs = g; }
            float gsum = 0.f;
#pragma unroll
            for (int g = 0; g < 4; ++g) gsum += expf(gl[g] - gm);
            const float pg = 1.f / gsum;
            float el[8];
#pragma unroll
            for (int j = 0; j < 8; ++j) { float a = F.b_re()[8 * gs + j];
#pragma unroll
                for (int w = 0; w < 8; ++w) a += l0[w * 64 * 48 + 4 + 8 * gs + j];
                el[j] = a; }
            int i0 = 0; float m0 = el[0];
#pragma unroll
            for (int j = 1; j < 8; ++j) if (el[j] > m0) { m0 = el[j]; i0 = j; }
            int i1 = -1; float m1 = -3.0e38f;
#pragma unroll
            for (int j = 0; j < 8; ++j) if (j != i0 && el[j] > m1) { m1 = el[j]; i1 = j; }
            const float x1 = expf(m1 - m0), w0 = pg / (1.f + x1), w1 = pg * x1 / (1.f + x1);
            const int e0 = gs * 8 + i0, e1 = gs * 8 + i1;
            const int sl0 = __hip_atomic_fetch_add(&HC[e0], 1, __ATOMIC_RELAXED, __HIP_MEMORY_SCOPE_WORKGROUP), sl1 = __hip_atomic_fetch_add(&HC[e1], 1, __ATOMIC_RELAXED, __HIP_MEMORY_SCOPE_WORKGROUP);
            F.TOKE()[2 * r] = e0; F.TOKE()[2 * r + 1] = e1; F.TOKW()[2 * r] = w0; F.TOKW()[2 * r + 1] = w1; F.TOKS()[2 * r] = sl0; F.TOKS()[2 * r + 1] = sl1;
        }
        __syncthreads();
        if (F.tid < 32) HB[F.tid] = (int)__hip_atomic_fetch_add(F.ctl() + CW_CNT + F.tid, (unsigned)HC[F.tid], __ATOMIC_RELAXED, __HIP_MEMORY_SCOPE_AGENT);
        __syncthreads();
        if (F.tid < 64) { const int r = 64 * rb + F.tid; F.TOKS()[2 * r] += HB[F.TOKE()[2 * r]]; F.TOKS()[2 * r + 1] += HB[F.TOKE()[2 * r + 1]]; }
        __syncthreads();
    }
}

DI int moe_tables(Frame& F) {
    LAS int* TE = (LAS int*)(F.lds + TILEE_OFF); LAS int* RB = TE + XS_TILES; LAS int* NTp = RB + 32;
    __syncthreads();
    if (F.tid == 0) { int tb = 0; for (int e = 0; e < NE; ++e) { const int cnt = (int)__hip_atomic_load(F.ctl() + CW_CNT + e, __ATOMIC_RELAXED, __HIP_MEMORY_SCOPE_AGENT); int nt = (cnt + 255) >> 8; if (tb + nt > XS_TILES) nt = XS_TILES - tb;
            RB[e] = tb * 256; for (int i = 0; i < nt; ++i) TE[tb + i] = e; tb += nt; } NTp[0] = tb; }
    __syncthreads();
    return NTp[0];
}
DI void p9_gather(Frame& F) {
    (void)moe_tables(F);
    const LAS int* RB = (const LAS int*)(F.lds + TILEE_OFF) + XS_TILES;
    const int gw = F.bid * 8 + F.wave, NGW = F.G * 8;
    for (int a0 = gw; a0 < 2 * T; a0 += 4 * NGW) {
        int pos[4]; u32x4 d[4][4];
#pragma unroll
        for (int q = 0; q < 4; ++q) { const int a = a0 + q * NGW; const bool ok = a < 2 * T; const int aa = ok ? a : a0; pos[q] = ok ? RB[F.TOKE()[aa]] + F.TOKS()[aa] : -1; }
#pragma unroll
        for (int q = 0; q < 4; ++q) { const int a = (a0 + q * NGW) < 2 * T ? a0 + q * NGW : a0; const GAS u32x4* src = (const GAS u32x4*)(F.U2() + (size_t)(a >> 1) * D) + F.lane;
#pragma unroll
            for (int j = 0; j < 4; ++j) d[q][j] = src[64 * j]; }
#pragma unroll
        for (int q = 0; q < 4; ++q) { if (pos[q] < 0) continue; if (F.lane == 0) F.TOKP()[a0 + q * NGW] = pos[q];
            GAS u32x4* dst = (GAS u32x4*)(F.XS() + (size_t)pos[q] * D) + F.lane;
#pragma unroll
            for (int j = 0; j < 4; ++j) dst[64 * j] = d[q][j]; }
    }
}
DI void p12_rows(Frame& F) {
    const int gw = F.bid * 8 + F.wave, NGW = F.G * 8; const float* g2 = F.MOD() + 5 * 2048;
    for (int rr = gw; rr < T; rr += 2 * NGW) {
        u32x2 xq[2][8], ya[2][8], yb[2][8]; f32x4 v[2][8]; float w0[2], w1[2]; bool ok[2]; int rw[2];
#pragma unroll
        for (int q = 0; q < 2; ++q) { const int r = rr + q * NGW; ok[q] = r < T; rw[q] = ok[q] ? r : rr;
            const int p0 = F.TOKP()[2 * rw[q]], p1 = F.TOKP()[2 * rw[q] + 1]; w0[q] = F.TOKW()[2 * rw[q]]; w1[q] = F.TOKW()[2 * rw[q] + 1];
            const GAS u32x2* xr = (const GAS u32x2*)(F.X1() + (size_t)rw[q] * D) + F.lane;
            const GAS u32x2* y0 = (const GAS u32x2*)(F.YS() + (size_t)p0 * D) + F.lane; const GAS u32x2* y1 = (const GAS u32x2*)(F.YS() + (size_t)p1 * D) + F.lane;
#pragma unroll
            for (int j = 0; j < 8; ++j) { xq[q][j] = xr[64 * j]; ya[q][j] = y0[64 * j]; yb[q][j] = y1[64 * j]; } }
#pragma unroll
        for (int q = 0; q < 2; ++q) { if (!ok[q]) continue;
            float s = 0.f;
#pragma unroll
            for (int j = 0; j < 8; ++j) { const f32x4 f = unpack4(ya[q][j]) * w0[q] + unpack4(yb[q][j]) * w1[q]; const f32x4 g = *(const f32x4*)(g2 + 4 * F.lane + 256 * j);
                v[q][j] = unpack4(xq[q][j]) * ALPHA + g * f; s += (v[q][j][0] + v[q][j][1]) + (v[q][j][2] + v[q][j][3]); }
            const float mean = wave_sum(s) * (1.f / D); float s2 = 0.f;
#pragma unroll
            for (int j = 0; j < 8; ++j) { v[q][j] = v[q][j] - mean; s2 += (v[q][j][0] * v[q][j][0] + v[q][j][1] * v[q][j][1]) + (v[q][j][2] * v[q][j][2] + v[q][j][3] * v[q][j][3]); }
            const float rstd = 1.f / sqrtf(wave_sum(s2) * (1.f / D) + LN_EPS);
            GAS f32x4* xo = (GAS f32x4*)(F.out() + (size_t)rw[q] * D) + F.lane;
#pragma unroll
            for (int j = 0; j < 8; ++j) { const f32x4 g = *(const f32x4*)(F.ln2_g() + 4 * F.lane + 256 * j), b = *(const f32x4*)(F.ln2_b() + 4 * F.lane + 256 * j); xo[64 * j] = v[q][j] * rstd * g + b; } }
    }
}

__global__ void __launch_bounds__(512, 2) mk_fwd(Args args) {
    extern __shared__ __attribute__((aligned(16))) unsigned char lds[];
    Frame F;
    F.lds = (LAS unsigned char*)lds;
    F.tid = threadIdx.x; F.lane = F.tid & 63; F.wave = __builtin_amdgcn_readfirstlane(F.tid >> 6); F.bid = blockIdx.x; F.G = gridDim.x;
    F.a = &args; F.ws = args.ws;
    for (int u = F.tid; u < (LDS_BYTES - LDSCTL_OFF) / 4; u += 512) ((LAS unsigned*)(F.lds + LDSCTL_OFF))[u] = 0u;
    __syncthreads();
    const int lo = args.ph_lo, hi = args.ph_hi;
    const bool fused = (hi - lo) > 1;
    XcdBarrier bar; bar.bar = F.ctl() + CW_BAR; bar.x = 0; bar.st = nullptr;
    if (fused) bar = xcd_barrier_post(F.ctl() + CW_BAR, (volatile LAS unsigned*)(F.lds + MISC_OFF));
#ifndef PH_MASK
#define PH_MASK 0x1fff
#endif
#define IN(k) (((PH_MASK >> (k)) & 1) && lo <= (k) && (k) < hi)
#define SEAM(k) do { if (IN(k) && IN((k) + 1)) xcd_barrier(bar); PEND(k); PSTART((k) + 1); } while (0)
#ifdef PROBE_MASK
    unsigned long long p_t = __builtin_amdgcn_s_memrealtime(), p_acc = 0;
#define PSTART(k) do { if ((PROBE_MASK >> (k)) & 1) p_t = __builtin_amdgcn_s_memrealtime(); } while (0)
#define PEND(k) do { if ((PROBE_MASK >> (k)) & 1) p_acc += __builtin_amdgcn_s_memrealtime() - p_t; } while (0)
#else
#define PSTART(k) do { } while (0)
#define PEND(k) do { } while (0)
#endif

    if (IN(0)) { p0_prologue(F); } SEAM(0);
    if (IN(1)) { p1_rows(F); } SEAM(1);
    if (IN(2)) {
        pg8::SchedGrid<0> S; S.nM = TR / 256; S.nN = NPAD / 256; S.nwg = S.nM * S.nN; S.G = F.G; S.c = F.bid; S.A = (const char*)F.U(); S.B = (const char*)F.WIN(); S.a_tile = (size_t)256 * 2048 * 2; S.b_tile = (size_t)256 * 2048 * 2; S.a_split = 0; S.b_split = 0;
        pg8::EpiProj E{F.PROJ(), F.GATES(), F.b_in(), (float*)(F.ws + WS_STATP)};
        pg8::gemm_phase<pg8::EpiProj, pg8::SchedGrid<0>, true>(F.lds, 2048, 2048, 2048, S, E);
    } SEAM(2);
    if (IN(3)) {
        int cur_g = -1, cur_h = -1;
        const int ng = (F.G > 16 && (F.G - 16) % 8 == 0) ? F.G - 16 : F.G, g0 = (ng == F.G) ? 0 : 16;
        if (F.bid >= g0) for (int u = F.bid - g0; u < 1024; u += ng) { PSTART(13); gmlp_unit(F, u >> 3, u & 7, cur_g); PEND(13); }
        for (int v = F.bid; v < NCH * 8; v += F.G) { PSTART(14); mprep_unit(F, v >> 3, v & 7, cur_h); PEND(14); }
    } SEAM(3);
    if (IN(4)) { for (int u = F.bid; u < 256; u += F.G) scan_item(F, u >> 4, u & 15); } SEAM(4);
    if (IN(5)) { for (int u = F.bid; u < 1024; u += F.G) x3_unit(F, u >> 3, u & 7); } SEAM(5);
    if (IN(6)) {
        pg8::SchedGrid<1> S; S.nM = T / 256; S.nN = 8; S.nwg = S.nM * S.nN; S.G = F.G; S.c = F.bid; S.A = (const char*)F.AB(); S.B = (const char*)F.PAB(); S.a_tile = (size_t)256 * 2048 * 2; S.b_tile = (size_t)256 * 2048 * 2; S.a_split = 2048; S.b_split = 2048;
        pg8::EpiMerge E{F.Z(), F.PROJ()};
        pg8::gemm_phase<pg8::EpiMerge, pg8::SchedGrid<1>, true>(F.lds, 1024, 2048, 2048, S, E);
    } SEAM(6);
    if (IN(7)) {
        pg8::SchedGrid<0> S; S.nM = T / 256; S.nN = 8; S.nwg = S.nM * S.nN; S.G = F.G; S.c = F.bid; S.A = (const char*)F.Z(); S.B = (const char*)F.WO(); S.a_tile = (size_t)256 * 2048 * 2; S.b_tile = (size_t)256 * 2048 * 2; S.a_split = 0; S.b_split = 0;
        pg8::EpiWo E{F.x(), F.X1(), F.MOD() + 2 * 2048};
        pg8::gemm_phase<pg8::EpiWo, pg8::SchedGrid<0>, true>(F.lds, 2048, 2048, 2048, S, E);
    } SEAM(7);
    if (IN(8)) { p8_rows(F); } SEAM(8);
    if (IN(9)) { p9_gather(F); } SEAM(9);
    if (IN(10)) {
        const int NT = moe_tables(F);
        pg8::SchedMoe S; S.nwg = NT * 8; S.G = F.G; S.c = F.bid; S.tile_e = (const LAS int*)(F.lds + TILEE_OFF); S.A = (const char*)F.XS(); S.B = (const char*)F.W13(); S.a_tile = (size_t)256 * 2048 * 2; S.b_exp = (size_t)2048 * 2048 * 2; S.b_tile = (size_t)256 * 2048 * 2;
        pg8::EpiMoeUp E{F.H()};
        pg8::gemm_phase<pg8::EpiMoeUp, pg8::SchedMoe, true>(F.lds, 2048, 2048, 2048, S, E);
    } SEAM(10);
    if (IN(11)) {
        const int NT = moe_tables(F);
        pg8::SchedMoe S; S.nwg = NT * 8; S.G = F.G; S.c = F.bid; S.tile_e = (const LAS int*)(F.lds + TILEE_OFF); S.A = (const char*)F.H(); S.B = (const char*)F.W2(); S.a_tile = (size_t)256 * 1024 * 2; S.b_exp = (size_t)2048 * 1024 * 2; S.b_tile = (size_t)256 * 1024 * 2;
        pg8::EpiMoeDown E{F.YS()};
        pg8::gemm_phase<pg8::EpiMoeDown, pg8::SchedMoe, true>(F.lds, 1024, 1024, 1024, S, E);
    } SEAM(11);
    if (IN(12)) { p12_rows(F); }
    PEND(12);
#ifdef PROBE_MASK
    if (fused) xcd_barrier(bar);
    if (F.bid == 0 && F.tid == 0) { const unsigned long long t0 = __builtin_amdgcn_s_memrealtime(); while (__builtin_amdgcn_s_memrealtime() - t0 < p_acc * PROBE_MUL) __builtin_amdgcn_s_sleep(8); }
#endif
#undef IN
#undef SEAM
}

extern "C" void kernel_launch(void* const* d_in, const int* in_sizes, int n_in, void* d_out, int out_size, void* d_ws, size_t ws_size, hipStream_t stream) {
    static int grid = 0;
    if (grid == 0) {
        if (n_in != 32 || out_size != T * D || ws_size < WS_END) { fprintf(stderr, "kernel_launch: unexpected shapes (n_in %d, out %d, ws %zu; need ws >= %zu); nothing launched\n", n_in, out_size, ws_size, (size_t)WS_END); grid = -1; return; }
        int dev = 0, cus = 0, per_cu = 0;
        if (hipGetDevice(&dev) != hipSuccess || hipDeviceGetAttribute(&cus, hipDeviceAttributeMultiprocessorCount, dev) != hipSuccess) { grid = -1; return; }
        if (hipFuncSetAttribute((const void*)mk_fwd, hipFuncAttributeMaxDynamicSharedMemorySize, LDS_BYTES) != hipSuccess) { fprintf(stderr, "kernel_launch: hipFuncSetAttribute failed\n"); grid = -1; return; }
        if (hipOccupancyMaxActiveBlocksPerMultiprocessor(&per_cu, (const void*)mk_fwd, 512, LDS_BYTES) != hipSuccess || per_cu < 1) { fprintf(stderr, "kernel_launch: occupancy query reports %d\n", per_cu); }
        (void)hipGetLastError();
        grid = cus;
    }
    if (grid < 0) return;
    (void)hipMemsetAsync((char*)d_ws + WS_CTL, 0, CTL_ZERO_BYTES, stream);
    Args a{};
    for (int i = 0; i < 32; ++i) a.in[i] = (const float*)d_in[i];
    a.outp = (float*)d_out; a.ws = (unsigned char*)d_ws;
    if (MK_N_LAUNCHES == 1) { a.ph_lo = 0; a.ph_hi = NPHASE; hipLaunchKernelGGL(mk_fwd, dim3(grid), dim3(512), LDS_BYTES, stream, a); }
    else for (int p = 0; p < NPHASE; ++p) { a.ph_lo = p; a.ph_hi = p + 1; hipLaunchKernelGGL(mk_fwd, dim3(grid), dim3(512), LDS_BYTES, stream, a); }
}
```
